# Optimizing an MI355X kernel written in HIP

```python
import jax
import jax.numpy as jnp
from jax import lax
import numpy as np

D_MODEL = 1024
BATCH = 4
SEQ = 4096
DEPTH = 2

GRID_W = 64
CTX_LEN = 256
HEAD_DIM = 64
NORM_EPS = 1e-6
L2_EPS = 1e-12
N_EVEN = (DEPTH + 1) // 2
N_ODD = DEPTH // 2

GLA_DV = 64
GLA_DK = 32
GLA_HEADS = (D_MODEL // 2) // GLA_DV
GLA_LOWRANK = 16
GLA_TAU = 16.0
GLA_CHUNK = 64

ATT_HEADS = (D_MODEL // 2) // HEAD_DIM
ATT_KV_HEADS = ATT_HEADS // 4
WINDOW = 128
ATT_BLOCK = 128
ROPE_THETA = 10000.0

FOURIER_GROUP_DIM = 64
FOURIER_WIDTH = D_MODEL // 4
FOURIER_GROUPS = FOURIER_WIDTH // FOURIER_GROUP_DIM

RWKV_DIM = D_MODEL - FOURIER_WIDTH
RWKV_HEADS = RWKV_DIM // HEAD_DIM
RWKV_W_RANK = 64
RWKV_A_RANK = 64
RWKV_G_RANK = 128
RWKV_GN_EPS = 64e-5

N_EXPERTS = 16
N_GROUPS = 4
TOP_K = 2
D_EXPERT = 512

EVEN_SPLIT = (GLA_HEADS * GLA_DK, GLA_HEADS * GLA_DK, GLA_HEADS * GLA_DV, GLA_HEADS * GLA_DV,
              2 * GLA_LOWRANK, ATT_HEADS * HEAD_DIM, ATT_KV_HEADS * HEAD_DIM, ATT_KV_HEADS * HEAD_DIM)
EVEN_COLS = sum(EVEN_SPLIT)
RWKV_SPLIT = (RWKV_DIM, RWKV_DIM, RWKV_DIM, 2 * RWKV_W_RANK, 2 * RWKV_A_RANK, RWKV_G_RANK)
RWKV_COLS = sum(RWKV_SPLIT)
ODD_COLS = FOURIER_WIDTH + RWKV_COLS

kernel_name = "hybrid_gla_swa_fourier_rwkv7_moe_prefix_dit"


def rms_norm(x, gain, eps=NORM_EPS):
    xf = x.astype(jnp.float32)
    y = xf * lax.rsqrt(jnp.mean(xf * xf, axis=-1, keepdims=True) + eps)
    return (y * gain.astype(jnp.float32)).astype(x.dtype)


def modulate(x, gain, shift, scale):
    return rms_norm(x, gain) * (1.0 + scale) + shift


def split_cols(z, sizes):
    return jnp.split(z, np.cumsum(sizes)[:-1].tolist(), axis=-1)


def _ident(t):
    return t


def _flip(t):
    return jnp.flip(t, axis=1)


def axial_rope_tables(n_lat):
    rows = n_lat // GRID_W
    row = jnp.repeat(jnp.arange(rows, dtype=jnp.float32), GRID_W)
    col = jnp.tile(jnp.arange(GRID_W, dtype=jnp.float32), rows)
    n_freq = HEAD_DIM // 4
    inv_freq = ROPE_THETA ** (-jnp.arange(n_freq, dtype=jnp.float32) / n_freq)
    ang = jnp.concatenate([row[:, None] * inv_freq, col[:, None] * inv_freq], axis=-1)
    return jnp.cos(ang), jnp.sin(ang)


def apply_rope(t, cos, sin):
    half = t.shape[-1] // 2
    t1, t2 = t[..., :half], t[..., half:]
    c, s = cos[None, :, None, :], sin[None, :, None, :]
    return jnp.concatenate([t1 * c - t2 * s, t1 * s + t2 * c], axis=-1).astype(t.dtype)


def gla_log_decay(z_dec, dec_w, dec_b, direction):
    B, L, _ = z_dec.shape
    zd = z_dec[..., direction * GLA_LOWRANK:(direction + 1) * GLA_LOWRANK].astype(jnp.float32)
    la = jax.nn.log_sigmoid(zd @ dec_w[direction].astype(jnp.float32)
                            + dec_b[direction].astype(jnp.float32)) / GLA_TAU
    return la.reshape(B, L, GLA_HEADS, GLA_DK)


def gla_chunk_scan(k, v, log_a, s0, q=None):
    B, L, H, _ = k.shape
    dv = v.shape[-1]
    C = GLA_CHUNK
    nc = L // C
    emit = q is not None

    def chunks(t):
        return jnp.moveaxis(t.reshape(B, nc, C, H, t.shape[-1]), 1, 0)

    causal = jnp.tril(jnp.ones((C, C), dtype=bool))[None, :, :, None, None]

    def step(S, inp):
        k_c, v_c, g_c = inp[0], inp[1], inp[2]
        b = jnp.cumsum(g_c, axis=1)
        b_last = b[:, -1]
        S_new = (jnp.exp(b_last)[..., None] * S
                 + jnp.einsum('bjhd,bjhe->bhde', k_c * jnp.exp(b_last[:, None] - b), v_c))
        if not emit:
            return S_new, None
        q_c = inp[3]
        diff = jnp.where(causal, b[:, :, None] - b[:, None], -jnp.inf)
        att = jnp.einsum('bihd,bjhd,bijhd->bhij', q_c, k_c, jnp.exp(diff))
        o = (jnp.einsum('bhij,bjhe->bihe', att, v_c)
             + jnp.einsum('bihd,bhde->bihe', q_c * jnp.exp(b), S))
        return S_new, o

    xs = (chunks(k), chunks(v), chunks(log_a)) + ((chunks(q),) if emit else ())
    S, o = lax.scan(step, s0, xs)
    o = jnp.moveaxis(o, 0, 1).reshape(B, L, H, dv) if emit else None
    return o, S


def gla_bidirectional(ctx_t, lat_t, need_ctx):
    qc, kc, vc, dc = ctx_t
    ql, kl, vl, dl = lat_t
    B = kl.shape[0]
    s0 = jnp.zeros((B, GLA_HEADS, GLA_DK, GLA_DV), jnp.float32)
    o_lat, o_ctx = 0.0, 0.0
    for d in range(2):
        f = _ident if d == 0 else _flip
        oc, s_ctx = gla_chunk_scan(f(kc), f(vc), f(dc[d]), s0, f(qc) if need_ctx else None)
        ol, _ = gla_chunk_scan(f(kl), f(vl), f(dl[d]), s_ctx, f(ql))
        o_lat = o_lat + f(ol)
        if need_ctx:
            o_ctx = o_ctx + f(oc)
    return o_lat, (o_ctx if need_ctx else None)


def window_attention(q, k, v, k_ctx, v_ctx, sink):
    B, N, Hq, hd = q.shape
    G = Hq // ATT_KV_HEADS
    nb = N // ATT_BLOCK
    scale = hd ** -0.5
    qb = q.reshape(B, nb, ATT_BLOCK, ATT_KV_HEADS, G, hd)

    def windows(t):
        tp = jnp.pad(t, ((0, 0), (ATT_BLOCK, ATT_BLOCK), (0, 0), (0, 0)))
        tp = tp.reshape(B, nb + 2, ATT_BLOCK, ATT_KV_HEADS, hd)
        return jnp.concatenate([tp[:, :-2], tp[:, 1:-1], tp[:, 2:]], axis=2)

    kw, vw = windows(k), windows(v)
    s_loc = jnp.einsum('bnqkgd,bnjkd->bnkgqj', qb, kw).astype(jnp.float32) * scale
    s_ctx = jnp.einsum('bnqkgd,bckd->bnkgqc', qb, k_ctx).astype(jnp.float32) * scale
    blk = jnp.arange(nb)[:, None, None] * ATT_BLOCK
    qpos = blk + jnp.arange(ATT_BLOCK)[None, :, None]
    kpos = blk - ATT_BLOCK + jnp.arange(3 * ATT_BLOCK)[None, None, :]
    valid = (jnp.abs(kpos - qpos) <= WINDOW) & (kpos >= 0) & (kpos < N)
    s_loc = jnp.where(valid[None, :, None, None], s_loc, -jnp.inf)
    sk = sink.reshape(ATT_KV_HEADS, G).astype(jnp.float32)[None, None, :, :, None, None]
    m = jnp.maximum(jnp.maximum(s_loc.max(-1, keepdims=True), s_ctx.max(-1, keepdims=True)), sk)
    p_loc = jnp.exp(s_loc - m)
    p_ctx = jnp.exp(s_ctx - m)
    denom = p_loc.sum(-1) + p_ctx.sum(-1) + jnp.exp(sk - m)[..., 0]
    o = (jnp.einsum('bnkgqj,bnjkd->bnqkgd', p_loc, vw.astype(jnp.float32))
         + jnp.einsum('bnkgqc,bckd->bnqkgd', p_ctx, v_ctx.astype(jnp.float32)))
    o = o * jnp.transpose(1.0 / denom, (0, 1, 4, 2, 3))[..., None]
    return o.reshape(B, N, Hq * hd)


def context_attention(q, k, v, sink):
    B, Lc, Hq, hd = q.shape
    G = Hq // ATT_KV_HEADS
    qc = q.reshape(B, Lc, ATT_KV_HEADS, G, hd)
    s = jnp.einsum('bqkgd,bckd->bkgqc', qc, k).astype(jnp.float32) * hd ** -0.5
    sk = sink.reshape(ATT_KV_HEADS, G).astype(jnp.float32)[None, :, :, None, None]
    m = jnp.maximum(s.max(-1, keepdims=True), sk)
    p = jnp.exp(s - m)
    p = p / (p.sum(-1, keepdims=True) + jnp.exp(sk - m))
    o = jnp.einsum('bkgqc,bckd->bqkgd', p, v.astype(jnp.float32))
    return o.reshape(B, Lc, Hq * hd)


def even_mixer(h_ctx, h_lat, cos, sin, w_in, w_out, dec_w, dec_b, out_norm,
               q_norm, k_norm, sink, need_ctx):
    def project(h):
        B, L, _ = h.shape
        gq, gk, gv, gg, gdec, aq, ak, av = split_cols(h @ w_in, EVEN_SPLIT)
        hf = lambda t: t.reshape(B, L, GLA_HEADS, -1).astype(jnp.float32)
        gla = (hf(gq) * GLA_DK ** -0.5, hf(gk), hf(gv),
               tuple(gla_log_decay(gdec, dec_w, dec_b, d) for d in range(2)))
        att = (rms_norm(aq.reshape(B, L, ATT_HEADS, HEAD_DIM), q_norm),
               rms_norm(ak.reshape(B, L, ATT_KV_HEADS, HEAD_DIM), k_norm),
               av.reshape(B, L, ATT_KV_HEADS, HEAD_DIM))
        return gla, att, gg

    gla_c, att_c, gg_c = project(h_ctx)
    gla_l, att_l, gg_l = project(h_lat)
    q_l = apply_rope(att_l[0], cos, sin)
    k_l = apply_rope(att_l[1], cos, sin)
    o_gla_l, o_gla_c = gla_bidirectional(gla_c, gla_l, need_ctx)

    def merge(o_gla, gg, o_att, dtype):
        B, L = gg.shape[:2]
        g = rms_norm(o_gla, out_norm).reshape(B, L, -1) * jax.nn.silu(gg.astype(jnp.float32))
        return jnp.concatenate([g, o_att], axis=-1).astype(dtype) @ w_out

    o_att_l = window_attention(q_l, k_l, att_l[2], att_c[1], att_c[2], sink)
    out_lat = merge(o_gla_l, gg_l, o_att_l, h_lat.dtype)
    out_ctx = None
    if need_ctx:
        o_att_c = context_attention(att_c[0], att_c[1], att_c[2], sink)
        out_ctx = merge(o_gla_c, gg_c, o_att_c, h_ctx.dtype)
    return out_lat, out_ctx


def fourier_mix(z):
    B, L, _ = z.shape
    zg = z.astype(jnp.float32).reshape(B, L, FOURIER_GROUPS, FOURIER_GROUP_DIM)
    y = jnp.real(jnp.fft.fft2(zg, axes=(1, 3), norm='ortho'))
    return y.reshape(B, L, FOURIER_WIDTH)


def centred_shift(z, mu):
    zp = jnp.pad(z, ((0, 0), (1, 1), (0, 0)))
    return z + mu * (0.5 * (zp[:, :-2] + zp[:, 2:]) - z)


def rwkv_prepare(z, mu, w0, w2, a0, a2, kk_scale, k_a):
    B, L, _ = z.shape
    z = centred_shift(z.astype(jnp.float32), mu)
    r, k, v, zw, za, zg = split_cols(z, RWKV_SPLIT)
    heads = lambda t: t.reshape(B, L, RWKV_HEADS, HEAD_DIM)
    kk = heads(k * kk_scale)
    kk = kk * lax.rsqrt(jnp.sum(kk * kk, axis=-1, keepdims=True) + L2_EPS)
    per_dir = []
    for d in range(2):
        zw_d = zw[..., d * RWKV_W_RANK:(d + 1) * RWKV_W_RANK]
        za_d = za[..., d * RWKV_A_RANK:(d + 1) * RWKV_A_RANK]
        w_log = -jax.nn.softplus(-(w0[d] + jnp.tanh(zw_d) @ w2[d])) - 0.5
        decay = jnp.exp(-jnp.exp(w_log))
        a = jax.nn.sigmoid(a0[d] + za_d @ a2[d])
        k_d = k * (1.0 + (a - 1.0) * k_a)
        per_dir.append((heads(decay), heads(k_d), heads(a)))
    return heads(r), heads(v), kk, zg, per_dir


def rwkv_scan(decay, k, v, kk, a, s0, r=None):
    emit = r is not None
    xs = (decay, k, v, kk, a) + ((r,) if emit else ())
    xs = tuple(jnp.moveaxis(t, 1, 0) for t in xs)

    def step(S, inp):
        w_t, k_t, v_t, kk_t, a_t = inp[:5]
        S = (S * w_t[:, :, None, :]
             - jnp.einsum('bhvk,bhk->bhv', S, kk_t)[..., None] * (kk_t * a_t)[:, :, None, :]
             + v_t[..., None] * k_t[:, :, None, :])
        y = jnp.einsum('bhvk,bhk->bhv', S, inp[5]) if emit else None
        return S, y

    S, ys = lax.scan(step, s0, xs)
    return (jnp.moveaxis(ys, 0, 1) if emit else None), S


def rwkv_bonus(r, k, v, r_k):
    return jnp.sum(r * k * r_k, axis=-1, keepdims=True) * v


def rwkv_bidirectional(ctx_p, lat_p, r_k, need_ctx):
    rc, vc, kkc, _, dirs_c = ctx_p
    rl, vl, kkl, _, dirs_l = lat_p
    B = rl.shape[0]
    s0 = jnp.zeros((B, RWKV_HEADS, HEAD_DIM, HEAD_DIM), jnp.float32)
    y_lat, y_ctx = 0.0, 0.0
    for d in range(2):
        f = _ident if d == 0 else _flip
        dec_c, k_c, a_c = dirs_c[d]
        dec_l, k_l, a_l = dirs_l[d]
        yc, s_ctx = rwkv_scan(f(dec_c), f(k_c), f(vc), f(kkc), f(a_c), s0,
                              f(rc) if need_ctx else None)
        yl, _ = rwkv_scan(f(dec_l), f(k_l), f(vl), f(kkl), f(a_l), s_ctx, f(rl))
        y_lat = y_lat + f(yl) + rwkv_bonus(rl, k_l, vl, r_k)
        if need_ctx:
            y_ctx = y_ctx + f(yc) + rwkv_bonus(rc, k_c, vc, r_k)
    return y_lat, (y_ctx if need_ctx else None)


def rwkv_output(y, zg, g2, ln_g, ln_b):
    B, L = y.shape[:2]
    mean = jnp.mean(y, axis=-1, keepdims=True)
    var = jnp.mean(jnp.square(y - mean), axis=-1, keepdims=True)
    yn = ((y - mean) * lax.rsqrt(var + RWKV_GN_EPS)).reshape(B, L, RWKV_DIM)
    return (yn * ln_g + ln_b) * (jax.nn.sigmoid(zg) @ g2)


def odd_mixer(h_ctx, h_lat, w_in, w_out, mu, w0, w2, a0, a2, g2, kk_scale, k_a, r_k,
              ln_g, ln_b, need_ctx):
    f32 = lambda t: t.astype(jnp.float32)
    mu, w0, w2, a0, a2, g2 = f32(mu), f32(w0), f32(w2), f32(a0), f32(a2), f32(g2)
    kk_scale, k_a, r_k, ln_g, ln_b = f32(kk_scale), f32(k_a), f32(r_k), f32(ln_g), f32(ln_b)
    z_ctx, z_lat = h_ctx @ w_in, h_lat @ w_in
    prep = lambda z: rwkv_prepare(z[..., FOURIER_WIDTH:], mu, w0, w2, a0, a2, kk_scale, k_a)
    p_ctx, p_lat = prep(z_ctx), prep(z_lat)
    y_lat, y_ctx = rwkv_bidirectional(p_ctx, p_lat, r_k, need_ctx)

    def merge(z, p, y, dtype):
        rw = rwkv_output(y, p[3], g2, ln_g, ln_b)
        cat = jnp.concatenate([fourier_mix(z[..., :FOURIER_WIDTH]), rw], axis=-1)
        return cat.astype(dtype) @ w_out

    out_lat = merge(z_lat, p_lat, y_lat, h_lat.dtype)
    out_ctx = merge(z_ctx, p_ctx, y_ctx, h_ctx.dtype) if need_ctx else None
    return out_lat, out_ctx


def routed_moe(h, router_w, router_b, w_gate, w_up, w_down):
    logits = jnp.einsum('bld,de->ble', h, router_w).astype(jnp.float32)
    scores = jax.nn.sigmoid(logits)
    sel = scores + router_b.astype(jnp.float32)
    B, L, E = sel.shape
    per_group = E // N_GROUPS
    grp_score = lax.top_k(sel.reshape(B, L, N_GROUPS, per_group), TOP_K)[0].sum(-1)
    best = jnp.argmax(grp_score, axis=-1)
    in_group = (jnp.arange(E) // per_group)[None, None, :] == best[..., None]
    _, idx = lax.top_k(jnp.where(in_group, sel, -jnp.inf), TOP_K)
    w = jnp.take_along_axis(scores, idx, axis=-1)
    w = w / jnp.sum(w, axis=-1, keepdims=True)
    gates = jnp.sum(jax.nn.one_hot(idx, E, dtype=jnp.float32) * w[..., None], axis=-2)
    out = jnp.zeros(h.shape, jnp.float32)
    for e in range(N_EXPERTS):
        he = (jax.nn.silu(h @ w_gate[e]) * (h @ w_up[e])) @ w_down[e]
        out = out + gates[..., e:e + 1] * he
    return out.astype(h.dtype)


def setup_inputs(seed: int = 0) -> dict:
    key = jax.random.key(seed)
    ks = iter(jax.random.split(key, 40))
    D = D_MODEL

    def nrm(shape, s):
        return jax.random.normal(next(ks), shape, jnp.float32) * s

    def gain(shape):
        return 1.0 + nrm(shape, 0.05)

    w0_base = jnp.tile(jnp.linspace(-6.0, -1.0, HEAD_DIM), RWKV_HEADS)[None, None, :]
    return {
        'x': nrm((BATCH, SEQ, D), 1.0),
        'c': nrm((BATCH, D), 1.0),
        'ctx': nrm((BATCH, CTX_LEN, D), 1.0),
        'c_ctx': nrm((D,), 1.0),
        'ada_w': nrm((DEPTH, D, 6 * D), 0.5 * D ** -0.5),
        'ada_b': nrm((DEPTH, 6 * D), 0.02),
        'norm_mix': gain((DEPTH, D)),
        'norm_ffn': gain((DEPTH, D)),
        'even_w_in': nrm((N_EVEN, D, EVEN_COLS), D ** -0.5),
        'even_w_out': nrm((N_EVEN, D, D), D ** -0.5),
        'gla_dec_w': nrm((N_EVEN, 2, GLA_LOWRANK, GLA_HEADS * GLA_DK), GLA_LOWRANK ** -0.5),
        'gla_dec_b': 1.0 + nrm((N_EVEN, 2, GLA_HEADS * GLA_DK), 0.5),
        'gla_out_norm': gain((N_EVEN, GLA_DV)),
        'att_q_norm': gain((N_EVEN, HEAD_DIM)),
        'att_k_norm': gain((N_EVEN, HEAD_DIM)),
        'att_sink': nrm((N_EVEN, ATT_HEADS), 0.5),
        'odd_w_in': nrm((N_ODD, D, ODD_COLS), D ** -0.5),
        'odd_w_out': nrm((N_ODD, D, D), D ** -0.5),
        'rwkv_mu': jax.random.uniform(next(ks), (N_ODD, RWKV_COLS), jnp.float32),
        'rwkv_w0': w0_base + nrm((N_ODD, 2, RWKV_DIM), 0.1),
        'rwkv_w2': nrm((N_ODD, 2, RWKV_W_RANK, RWKV_DIM), RWKV_W_RANK ** -0.5),
        'rwkv_a0': nrm((N_ODD, 2, RWKV_DIM), 0.1),
        'rwkv_a2': nrm((N_ODD, 2, RWKV_A_RANK, RWKV_DIM), RWKV_A_RANK ** -0.5),
        'rwkv_g2': nrm((N_ODD, RWKV_G_RANK, RWKV_DIM), RWKV_G_RANK ** -0.5),
        'rwkv_kk_scale': 0.85 + nrm((N_ODD, RWKV_DIM), 0.05),
        'rwkv_k_a': gain((N_ODD, RWKV_DIM)),
        'rwkv_r_k': nrm((N_ODD, RWKV_HEADS, HEAD_DIM), 0.1),
        'rwkv_ln_g': gain((N_ODD, RWKV_DIM)),
        'rwkv_ln_b': nrm((N_ODD, RWKV_DIM), 0.02),
        'router_w': nrm((D, N_EXPERTS), D ** -0.5),
        'router_b': nrm((N_EXPERTS,), 0.01),
        'moe_w_gate': nrm((DEPTH, N_EXPERTS, D, D_EXPERT), D ** -0.5),
        'moe_w_up': nrm((DEPTH, N_EXPERTS, D, D_EXPERT), D ** -0.5),
        'moe_w_down': nrm((DEPTH, N_EXPERTS, D_EXPERT, D), D_EXPERT ** -0.5),
    }


def reference(x, c, ctx, c_ctx, ada_w, ada_b, norm_mix, norm_ffn,
              even_w_in, even_w_out, gla_dec_w, gla_dec_b, gla_out_norm,
              att_q_norm, att_k_norm, att_sink,
              odd_w_in, odd_w_out, rwkv_mu, rwkv_w0, rwkv_w2, rwkv_a0, rwkv_a2,
              rwkv_g2, rwkv_kk_scale, rwkv_k_a, rwkv_r_k, rwkv_ln_g, rwkv_ln_b,
              router_w, router_b, moe_w_gate, moe_w_up, moe_w_down):
    n_lat = x.shape[1]
    lc = ctx.shape[1]
    cos, sin = axial_rope_tables(n_lat)
    silu_c = jax.nn.silu(c)
    silu_cc = jax.nn.silu(c_ctx)
    x_lat, x_ctx = x, ctx
    for layer in range(DEPTH):
        need_ctx = layer < DEPTH - 1
        mod_l = jnp.split((silu_c @ ada_w[layer] + ada_b[layer])[:, None, :], 6, axis=-1)
        mod_c = jnp.split((silu_cc @ ada_w[layer] + ada_b[layer])[None, None, :], 6, axis=-1)
        h_lat = modulate(x_lat, norm_mix[layer], mod_l[0], mod_l[1])
        h_ctx = modulate(x_ctx, norm_mix[layer], mod_c[0], mod_c[1])
        i = layer // 2
        if layer % 2 == 0:
            o_lat, o_ctx = even_mixer(h_ctx, h_lat, cos, sin, even_w_in[i], even_w_out[i],
                                      gla_dec_w[i], gla_dec_b[i], gla_out_norm[i],
                                      att_q_norm[i], att_k_norm[i], att_sink[i], need_ctx)
        else:
            o_lat, o_ctx = odd_mixer(h_ctx, h_lat, odd_w_in[i], odd_w_out[i], rwkv_mu[i],
                                     rwkv_w0[i], rwkv_w2[i], rwkv_a0[i], rwkv_a2[i], rwkv_g2[i],
                                     rwkv_kk_scale[i], rwkv_k_a[i], rwkv_r_k[i],
                                     rwkv_ln_g[i], rwkv_ln_b[i], need_ctx)
        x_lat = x_lat + mod_l[2] * o_lat
        h_lat = modulate(x_lat, norm_ffn[layer], mod_l[3], mod_l[4])
        if need_ctx:
            x_ctx = x_ctx + mod_c[2] * o_ctx
            h_ctx = modulate(x_ctx, norm_ffn[layer], mod_c[3], mod_c[4])
            y = routed_moe(jnp.concatenate([h_ctx, h_lat], axis=1), router_w, router_b,
                           moe_w_gate[layer], moe_w_up[layer], moe_w_down[layer])
            x_ctx = x_ctx + mod_c[5] * y[:, :lc]
            x_lat = x_lat + mod_l[5] * y[:, lc:]
        else:
            x_lat = x_lat + mod_l[5] * routed_moe(h_lat, router_w, router_b, moe_w_gate[layer],
                                                  moe_w_up[layer], moe_w_down[layer])
    return x_lat
```

```cpp
#include <hip/hip_runtime.h>
#include <cstdio>
#include <cstring>
#include <math.h>
#include <stdint.h>
#ifdef HOST_TEST
#define HD
#define FAST_SIN sinf
#define FAST_COS cosf
#define MEMBAR()
#else
#define HD __host__ __device__ __forceinline__
#define FAST_SIN __sinf
#define FAST_COS __cosf
#define MEMBAR() asm volatile("" ::: "memory")
#endif

struct NP {
  int B, L, LC, S, T, D, GW;
  int GH, GC, AH, AKV, FW, FG, RD, RH, DE, E;
  int EC, OC, RC, NZ;
  int e_gq, e_gk, e_gv, e_gg, e_gdec, e_aq, e_ak, e_av;
  int layer, b0, dir, which, pad0;
  const float *x, *c, *ctx, *c_ctx, *ada_w, *ada_b, *norm_mix, *norm_ffn, *even_w_in, *even_w_out, *gla_dec_w, *gla_dec_b,
      *gla_out_norm, *att_q_norm, *att_k_norm, *att_sink, *odd_w_in, *odd_w_out, *rwkv_mu, *rwkv_w0, *rwkv_w2, *rwkv_a0,
      *rwkv_a2, *rwkv_g2, *rwkv_kk_scale, *rwkv_k_a, *rwkv_r_k, *rwkv_ln_g, *rwkv_ln_b, *router_w, *router_b, *moe_w_gate,
      *moe_w_up, *moe_w_down;
  float *out;
  float *xc;
  float *mod;
  float *rinv;
  float *hbuf;
  float *zb;
  float *lad;
  float *ogla;
  float *kkb;
  float *rsb, *vsb;
  float *decb, *ab, *kdb;
  float *yb;
  float *fa, *fb;
  float *cosT, *sinT;
  int *re;
  float *rw;
  float *act;
};

HD float sigm(float x) { return 1.f / (1.f + expf(-x)); }
HD float siluf_(float x) { return x * sigm(x); }
HD float softplusf_(float x) { return x > 0.f ? x + log1pf(expf(-x)) : log1pf(expf(x)); }
HD float logsigm(float x) { return -softplusf_(-x); }
HD float* xs_row(const NP& p, int t) { int b = t / p.S, s = t % p.S; return s < p.LC ? p.xc + ((size_t)b * p.LC + s) * p.D : p.out + ((size_t)b * p.L + (s - p.LC)) * p.D; }
HD const float* modrow(const NP& p, int layer, int t) { int b = t / p.S, s = t % p.S; int r = s < p.LC ? p.B : b; return p.mod + ((size_t)layer * (p.B + 1) + r) * 6 * p.D; }
HD float zs_at(const NP& p, int s, int c) {
  const float* z = p.zb + (size_t)s * p.NZ + p.FW + c;
  int seg0 = s < p.LC ? 0 : p.LC, seg1 = s < p.LC ? p.LC : p.S;
  float zc = z[0], pv = s > seg0 ? z[-p.NZ] : 0.f, nx = s < seg1 - 1 ? z[p.NZ] : 0.f;
  return zc + p.rwkv_mu[c] * (0.5f * (pv + nx) - zc);
}

enum { ST_MOD, ST_INIT, ST_TAB, ST_RMS, ST_HMOD, ST_GEMM_IN, ST_GLA_DECAY, ST_ATT_PREP, ST_GLA_SCAN, ST_ATT_LAT, ST_ATT_CTX, ST_GLA_MERGE,
       ST_OUTPROJ, ST_ROUTER, ST_MOE_GU, ST_MOE_DOWN, ST_RWKV_KK, ST_RWKV_WA, ST_RWKV_SCAN, ST_RWKV_OUT, ST_FOUR1, ST_FOUR2 };

template <int ST> HD void stage_body(const NP& p, long idx);

template <> HD void stage_body<ST_MOD>(const NP& p, long idx) {
  int D6 = 6 * p.D; int j = idx % D6; int r = (idx / D6) % (p.B + 1); int layer = idx / ((long)D6 * (p.B + 1));
  const float* cv = r < p.B ? p.c + (size_t)r * p.D : p.c_ctx;
  float acc = p.ada_b[layer * D6 + j];
  for (int k = 0; k < p.D; ++k) acc += siluf_(cv[k]) * p.ada_w[((size_t)layer * p.D + k) * D6 + j];
  p.mod[idx] = acc;
}
template <> HD void stage_body<ST_INIT>(const NP& p, long idx) {
  long nl = (long)p.B * p.L * p.D;
  if (idx < nl) p.out[idx] = p.x[idx]; else p.xc[idx - nl] = p.ctx[idx - nl];
}
template <> HD void stage_body<ST_TAB>(const NP& p, long idx) {
  double a = 2.0 * 3.14159265358979323846 * (double)idx / (double)p.L; p.cosT[idx] = (float)cos(a); p.sinT[idx] = (float)sin(a);
}
template <> HD void stage_body<ST_RMS>(const NP& p, long idx) {
  const float* xr = xs_row(p, (int)idx); float s = 0.f;
  for (int d = 0; d < p.D; ++d) s += xr[d] * xr[d];
  p.rinv[idx] = 1.f / sqrtf(s / p.D + 1e-6f);
}
template <> HD void stage_body<ST_HMOD>(const NP& p, long idx) {
  int d = idx % p.D, t = idx / p.D; const float* m = modrow(p, p.layer, t);
  float sh = m[(p.which ? 3 : 0) * p.D + d], sc = m[(p.which ? 4 : 1) * p.D + d];
  float g = (p.which ? p.norm_ffn : p.norm_mix)[p.layer * p.D + d];
  p.hbuf[idx] = xs_row(p, t)[d] * p.rinv[t] * g * (1.f + sc) + sh;
}
template <> HD void stage_body<ST_GEMM_IN>(const NP& p, long idx) {
  int N = p.layer == 0 ? p.EC : p.OC; const float* W = p.layer == 0 ? p.even_w_in : p.odd_w_in;
  int n = idx % N, s = idx / N; const float* a = p.hbuf + ((size_t)p.b0 * p.S + s) * p.D; float acc = 0.f;
  for (int k = 0; k < p.D; ++k) acc += a[k] * W[(size_t)k * N + n];
  p.zb[(size_t)s * p.NZ + n] = acc;
}
template <> HD void stage_body<ST_GLA_DECAY>(const NP& p, long idx) {
  int c = idx % p.GC, dir = (idx / p.GC) % 2, s = idx / (2 * p.GC);
  const float* zd = p.zb + (size_t)s * p.NZ + p.e_gdec + dir * 16; float acc = p.gla_dec_b[dir * p.GC + c];
  for (int r = 0; r < 16; ++r) acc += zd[r] * p.gla_dec_w[(dir * 16 + r) * p.GC + c];
  p.lad[idx] = logsigm(acc) * (1.f / 16.f);
}
template <> HD void stage_body<ST_ATT_PREP>(const NP& p, long idx) {
  int nh = p.AH + p.AKV; int hh = idx % nh, s = idx / nh;
  float* src = p.zb + (size_t)s * p.NZ + (hh < p.AH ? p.e_aq + hh * 64 : p.e_ak + (hh - p.AH) * 64);
  const float* g = hh < p.AH ? p.att_q_norm : p.att_k_norm;
  float v[64]; float ss = 0.f;
#pragma unroll
  for (int e = 0; e < 64; ++e) { v[e] = src[e]; ss += v[e] * v[e]; }
  float ri = 1.f / sqrtf(ss / 64.f + 1e-6f);
#pragma unroll
  for (int e = 0; e < 64; ++e) v[e] = v[e] * ri * g[e];
  if (s >= p.LC) {
    int pos = s - p.LC; float row = (float)(pos / p.GW), col = (float)(pos % p.GW);
#pragma unroll
    for (int j = 0; j < 32; ++j) {
      float inv = exp2f(-(float)(j & 15) * 0.8304820237218406f); float ang = (j < 16 ? row : col) * inv; float cs = FAST_COS(ang), sn = FAST_SIN(ang);
      float t1 = v[j], t2 = v[32 + j]; v[j] = t1 * cs - t2 * sn; v[32 + j] = t1 * sn + t2 * cs;
    }
  }
#pragma unroll
  for (int e = 0; e < 64; ++e) src[e] = v[e];
}
HD int scan_pos(const NP& p, int dir, int step) { return dir == 0 ? step : (step < p.LC ? p.LC - 1 - step : p.S - 1 - (step - p.LC)); }
template <> HD void stage_body<ST_GLA_SCAN>(const NP& p, long idx) {
  int e = idx % 64, dir = (idx / 64) % 2, hh = idx / 128;
  float S[32];
#pragma unroll
  for (int d = 0; d < 32; ++d) S[d] = 0.f;
  const float qs = 0.17677669529663687f;
  for (int step = 0; step < p.S; ++step) {
    int s = scan_pos(p, dir, step); const float* z = p.zb + (size_t)s * p.NZ; const float* la = p.lad + ((size_t)s * 2 + dir) * p.GC + hh * 32;
    float v = z[p.e_gv + hh * 64 + e], o = 0.f;
#pragma unroll
    for (int d = 0; d < 32; ++d) { S[d] = expf(la[d]) * S[d] + z[p.e_gk + hh * 32 + d] * v; o += z[p.e_gq + hh * 32 + d] * qs * S[d]; }
    p.ogla[((size_t)dir * p.S + s) * (p.GH * 64) + hh * 64 + e] = o;
  }
}
template <> HD void stage_body<ST_ATT_LAT>(const NP& p, long idx) {
  int hq = idx % p.AH, pos = idx / p.AH; int G = p.AH / p.AKV, kvh = hq / G; int s = p.LC + pos;
  const float* q = p.zb + (size_t)s * p.NZ + p.e_aq + hq * 64;
  float qv[64], o[64];
#pragma unroll
  for (int e = 0; e < 64; ++e) { qv[e] = q[e]; o[e] = 0.f; }
  float m = p.att_sink[hq], l = 1.f;
  int j0 = pos - 128 < 0 ? 0 : pos - 128, j1 = pos + 128 > p.L - 1 ? p.L - 1 : pos + 128;
  int nk = (j1 - j0 + 1) + p.LC;
  for (int i = 0; i < nk; ++i) {
    int sk = i < (j1 - j0 + 1) ? p.LC + j0 + i : i - (j1 - j0 + 1);
    const float* k = p.zb + (size_t)sk * p.NZ + p.e_ak + kvh * 64; const float* v = p.zb + (size_t)sk * p.NZ + p.e_av + kvh * 64;
    float sc = 0.f;
#pragma unroll
    for (int e = 0; e < 64; ++e) sc += qv[e] * k[e];
    sc *= 0.125f; float mn = sc > m ? sc : m; float f = expf(m - mn), pe = expf(sc - mn); l = l * f + pe; m = mn;
#pragma unroll
    for (int e = 0; e < 64; ++e) o[e] = o[e] * f + pe * v[e];
  }
  float* dst = p.hbuf + ((size_t)p.b0 * p.S + s) * p.D + p.GH * 64 + hq * 64;
#pragma unroll
  for (int e = 0; e < 64; ++e) dst[e] = o[e] / l;
}
template <> HD void stage_body<ST_ATT_CTX>(const NP& p, long idx) {
  int hq = idx % p.AH, s = idx / p.AH; int G = p.AH / p.AKV, kvh = hq / G;
  const float* q = p.zb + (size_t)s * p.NZ + p.e_aq + hq * 64;
  float qv[64], o[64];
#pragma unroll
  for (int e = 0; e < 64; ++e) { qv[e] = q[e]; o[e] = 0.f; }
  float m = p.att_sink[hq], l = 1.f;
  for (int sk = 0; sk < p.LC; ++sk) {
    const float* k = p.zb + (size_t)sk * p.NZ + p.e_ak + kvh * 64; const float* v = p.zb + (size_t)sk * p.NZ + p.e_av + kvh * 64;
    float sc = 0.f;
#pragma unroll
    for (int e = 0; e < 64; ++e) sc += qv[e] * k[e];
    sc *= 0.125f; float mn = sc > m ? sc : m; float f = expf(m - mn), pe = expf(sc - mn); l = l * f + pe; m = mn;
#pragma unroll
    for (int e = 0; e < 64; ++e) o[e] = o[e] * f + pe * v[e];
  }
  float* dst = p.hbuf + ((size_t)p.b0 * p.S + s) * p.D + p.GH * 64 + hq * 64;
#pragma unroll
  for (int e = 0; e < 64; ++e) dst[e] = o[e] / l;
}
template <> HD void stage_body<ST_GLA_MERGE>(const NP& p, long idx) {
  int hh = idx % p.GH, s = idx / p.GH; int W = p.GH * 64;
  const float* o0 = p.ogla + (size_t)s * W + hh * 64; const float* o1 = p.ogla + ((size_t)p.S + s) * W + hh * 64;
  float v[64]; float ss = 0.f;
#pragma unroll
  for (int e = 0; e < 64; ++e) { v[e] = o0[e] + o1[e]; ss += v[e] * v[e]; }
  float ri = 1.f / sqrtf(ss / 64.f + 1e-6f);
  const float* gg = p.zb + (size_t)s * p.NZ + p.e_gg + hh * 64; float* dst = p.hbuf + ((size_t)p.b0 * p.S + s) * p.D + hh * 64;
#pragma unroll
  for (int e = 0; e < 64; ++e) dst[e] = v[e] * ri * p.gla_out_norm[e] * siluf_(gg[e]);
}
template <> HD void stage_body<ST_OUTPROJ>(const NP& p, long idx) {
  int n = idx % p.D, t = idx / p.D; if (p.layer == 1 && (t % p.S) < p.LC) return;
  const float* W = p.layer == 0 ? p.even_w_out : p.odd_w_out; const float* a = p.hbuf + (size_t)t * p.D; float acc = 0.f;
  for (int k = 0; k < p.D; ++k) acc += a[k] * W[(size_t)k * p.D + n];
  xs_row(p, t)[n] += modrow(p, p.layer, t)[2 * p.D + n] * acc;
}
template <> HD void stage_body<ST_ROUTER>(const NP& p, long idx) {
  int t = idx; if (p.layer == 1 && (t % p.S) < p.LC) return;
  float lg[16];
#pragma unroll
  for (int e = 0; e < 16; ++e) lg[e] = 0.f;
  const float* h = p.hbuf + (size_t)t * p.D;
  for (int k = 0; k < p.D; ++k) { float hv = h[k];
#pragma unroll
    for (int e = 0; e < 16; ++e) lg[e] += hv * p.router_w[k * 16 + e]; }
  float sc[16], sel[16];
#pragma unroll
  for (int e = 0; e < 16; ++e) { sc[e] = sigm(lg[e]); sel[e] = sc[e] + p.router_b[e]; }
  int best = 0; float bests = -1e30f;
#pragma unroll
  for (int g = 0; g < 4; ++g) {
    float m1 = -1e30f, m2 = -1e30f;
#pragma unroll
    for (int i = 0; i < 4; ++i) { float v = sel[g * 4 + i]; if (v > m1) { m2 = m1; m1 = v; } else if (v > m2) m2 = v; }
    float gs = m1 + m2; if (gs > bests) { bests = gs; best = g; }
  }
  int i0 = -1, i1 = -1; float v0 = -1e30f, v1 = -1e30f, s0 = 0.f, s1 = 0.f;
#pragma unroll
  for (int e = 0; e < 16; ++e) {
    if ((e >> 2) == best) { float v = sel[e];
      if (v > v0) { v1 = v0; i1 = i0; s1 = s0; v0 = v; i0 = e; s0 = sc[e]; } else if (v > v1) { v1 = v; i1 = e; s1 = sc[e]; } }
  }
  float sum = s0 + s1; p.re[t * 2] = i0; p.re[t * 2 + 1] = i1; p.rw[t * 2] = s0 / sum; p.rw[t * 2 + 1] = s1 / sum;
}
template <> HD void stage_body<ST_MOE_GU>(const NP& p, long idx) {
  int j = idx % p.DE, slot = (idx / p.DE) % 2, t = idx / (2 * p.DE); if (p.layer == 1 && (t % p.S) < p.LC) return;
  int e = p.re[t * 2 + slot]; const float* h = p.hbuf + (size_t)t * p.D;
  const float* wg = p.moe_w_gate + ((size_t)(p.layer * p.E + e) * p.D) * p.DE + j; const float* wu = p.moe_w_up + ((size_t)(p.layer * p.E + e) * p.D) * p.DE + j;
  float g = 0.f, u = 0.f;
  for (int k = 0; k < p.D; ++k) { g += h[k] * wg[(size_t)k * p.DE]; u += h[k] * wu[(size_t)k * p.DE]; }
  p.act[idx] = siluf_(g) * u;
}
template <> HD void stage_body<ST_MOE_DOWN>(const NP& p, long idx) {
  int n = idx % p.D, t = idx / p.D; if (p.layer == 1 && (t % p.S) < p.LC) return;
  float y = 0.f;
  for (int slot = 0; slot < 2; ++slot) {
    int e = p.re[t * 2 + slot]; const float* a = p.act + ((size_t)t * 2 + slot) * p.DE; const float* wd = p.moe_w_down + ((size_t)(p.layer * p.E + e) * p.DE) * p.D + n;
    float acc = 0.f; for (int k = 0; k < p.DE; ++k) acc += a[k] * wd[(size_t)k * p.D];
    y += p.rw[t * 2 + slot] * acc;
  }
  xs_row(p, t)[n] += modrow(p, p.layer, t)[5 * p.D + n] * y;
}
template <> HD void stage_body<ST_RWKV_KK>(const NP& p, long idx) {
  int hh = idx % p.RH, s = idx / p.RH; float v[64]; float ss = 0.f;
#pragma unroll
  for (int e = 0; e < 64; ++e) { v[e] = zs_at(p, s, p.RD + hh * 64 + e) * p.rwkv_kk_scale[hh * 64 + e]; ss += v[e] * v[e]; }
  float ri = 1.f / sqrtf(ss + 1e-12f);
#pragma unroll
  for (int e = 0; e < 64; ++e) { size_t o = (size_t)s * p.RD + hh * 64 + e; p.kkb[o] = v[e] * ri; p.rsb[o] = zs_at(p, s, hh * 64 + e); p.vsb[o] = zs_at(p, s, 2 * p.RD + hh * 64 + e); }
}
template <> HD void stage_body<ST_RWKV_WA>(const NP& p, long idx) {
  int c = idx % p.RD, s = (idx / p.RD) % p.S, dir = idx / ((long)p.RD * p.S);
  float aw = p.rwkv_w0[dir * p.RD + c], aa = p.rwkv_a0[dir * p.RD + c];
  for (int j = 0; j < 64; ++j) {
    aw += tanhf(zs_at(p, s, 3 * p.RD + dir * 64 + j)) * p.rwkv_w2[(size_t)(dir * 64 + j) * p.RD + c];
    aa += zs_at(p, s, 3 * p.RD + 128 + dir * 64 + j) * p.rwkv_a2[(size_t)(dir * 64 + j) * p.RD + c];
  }
  float wl = -softplusf_(-aw) - 0.5f; float dec = expf(-expf(wl)); float a = sigm(aa);
  float k = zs_at(p, s, p.RD + c);
  p.decb[idx] = dec; p.ab[idx] = a; p.kdb[idx] = k * (1.f + (a - 1.f) * p.rwkv_k_a[c]);
}
template <> HD void stage_body<ST_RWKV_SCAN>(const NP& p, long idx) {
  int v = idx % 64, dir = (idx / 64) % 2, hh = idx / 128;
  float S[64];
#pragma unroll
  for (int k = 0; k < 64; ++k) S[k] = 0.f;
#pragma clang loop unroll(disable)
  for (int step = 0; step < p.S; ++step) {
    int s = scan_pos(p, dir, step); size_t o = ((size_t)dir * p.S + s) * p.RD + hh * 64; size_t o1 = (size_t)s * p.RD + hh * 64;
    const float* w = p.decb + o; const float* a = p.ab + o; const float* kd = p.kdb + o; const float* kk = p.kkb + o1; const float* r = p.rsb + o1;
    float vt = p.vsb[o1 + v]; float dk = 0.f;
#pragma unroll
    for (int k = 0; k < 64; ++k) dk += S[k] * kk[k];
    MEMBAR();
    float y = 0.f;
#pragma unroll
    for (int k0 = 0; k0 < 64; k0 += 8) {
#pragma unroll
      for (int k = k0; k < k0 + 8; ++k) { S[k] = S[k] * w[k] - dk * (kk[k] * a[k]) + vt * kd[k]; y += S[k] * r[k]; }
      MEMBAR();
    }
    p.yb[o + v] = y;
  }
}
template <> HD void stage_body<ST_RWKV_OUT>(const NP& p, long idx) {
  int hh = idx % p.RH, pos = idx / p.RH, s = p.LC + pos;
  float bon = 0.f;
  for (int dir = 0; dir < 2; ++dir) for (int k = 0; k < 64; ++k) bon += zs_at(p, s, hh * 64 + k) * p.kdb[((size_t)dir * p.S + s) * p.RD + hh * 64 + k] * p.rwkv_r_k[hh * 64 + k];
  float y[64]; float mean = 0.f;
#pragma unroll
  for (int v = 0; v < 64; ++v) { y[v] = p.yb[(size_t)s * p.RD + hh * 64 + v] + p.yb[((size_t)p.S + s) * p.RD + hh * 64 + v] + bon * zs_at(p, s, 2 * p.RD + hh * 64 + v); mean += y[v]; }
  mean /= 64.f; float var = 0.f;
#pragma unroll
  for (int v = 0; v < 64; ++v) { float d = y[v] - mean; var += d * d; }
  var /= 64.f; float ri = 1.f / sqrtf(var + 64e-5f);
  float* dst = p.hbuf + ((size_t)p.b0 * p.S + s) * p.D + p.FW + hh * 64;
#pragma unroll
  for (int v = 0; v < 64; ++v) {
    int c = hh * 64 + v; float gate = 0.f;
    for (int j = 0; j < 128; ++j) gate += sigm(zs_at(p, s, 3 * p.RD + 256 + j)) * p.rwkv_g2[(size_t)j * p.RD + c];
    dst[v] = ((y[v] - mean) * ri * p.rwkv_ln_g[c] + p.rwkv_ln_b[c]) * gate;
  }
}
template <> HD void stage_body<ST_FOUR1>(const NP& p, long idx) {
  int col = idx % p.FW, pos = idx / p.FW; int g = col / 64, m = col % 64; const float* z = p.zb + (size_t)(p.LC + pos) * p.NZ + g * 64;
  float a = 0.f, b = 0.f;
  for (int c = 0; c < 64; ++c) { float ang = 6.283185307179586f * (float)((m * c) & 63) / 64.f; a += z[c] * cosf(ang); b += z[c] * sinf(ang); }
  p.fa[idx] = a; p.fb[idx] = b;
}
template <> HD void stage_body<ST_FOUR2>(const NP& p, long idx) {
  int col = idx % p.FW, kp = idx / p.FW; float acc = 0.f;
  for (int l = 0; l < p.L; ++l) { int ti = (int)(((long)kp * l) % p.L); acc += p.cosT[ti] * p.fa[(size_t)l * p.FW + col] - p.sinT[ti] * p.fb[(size_t)l * p.FW + col]; }
  p.hbuf[((size_t)p.b0 * p.S + p.LC + kp) * p.D + col] = acc / sqrtf((float)p.L * 64.f);
}

static inline void np_set_dims(NP& p, int B, int L, int LC, int D) {
  p.B = B; p.L = L; p.LC = LC; p.S = L + LC; p.T = B * p.S; p.D = D; p.GW = 64;
  p.GH = (D / 2) / 64; p.GC = p.GH * 32; p.AH = (D / 2) / 64; p.AKV = p.AH / 4; p.FW = D / 4; p.FG = p.FW / 64; p.RD = D - p.FW; p.RH = p.RD / 64;
  p.DE = D == 1024 ? 512 : D / 2; p.E = 16;
  p.e_gq = 0; p.e_gk = p.e_gq + p.GH * 32; p.e_gv = p.e_gk + p.GH * 32; p.e_gg = p.e_gv + p.GH * 64; p.e_gdec = p.e_gg + p.GH * 64; p.e_aq = p.e_gdec + 32;
  p.e_ak = p.e_aq + p.AH * 64; p.e_av = p.e_ak + p.AKV * 64; p.EC = p.e_av + p.AKV * 64;
  p.RC = 3 * p.RD + 128 + 128 + 128; p.OC = p.FW + p.RC; p.NZ = p.OC > p.EC ? p.OC : p.EC;
}
static inline size_t np_carve(NP& p, char* base) {
  size_t off = 0; auto take = [&](size_t bytes) { char* r = base ? base + off : nullptr; off += (bytes + 255) & ~(size_t)255; return r; };
  p.xc = (float*)take((size_t)p.B * p.LC * p.D * 4); p.mod = (float*)take((size_t)2 * (p.B + 1) * 6 * p.D * 4); p.rinv = (float*)take((size_t)p.T * 4);
  p.hbuf = (float*)take((size_t)p.T * p.D * 4); p.zb = (float*)take((size_t)p.S * p.NZ * 4);
  p.cosT = (float*)take((size_t)p.L * 4); p.sinT = (float*)take((size_t)p.L * 4);
  p.re = (int*)take((size_t)p.T * 2 * 4); p.rw = (float*)take((size_t)p.T * 2 * 4);
  size_t mark = off;
  p.lad = (float*)take((size_t)p.S * 2 * p.GC * 4); p.ogla = (float*)take((size_t)2 * p.S * p.GH * 64 * 4);
  size_t end0 = off; off = mark;
  p.kkb = (float*)take((size_t)p.S * p.RD * 4); p.rsb = (float*)take((size_t)p.S * p.RD * 4); p.vsb = (float*)take((size_t)p.S * p.RD * 4); p.decb = (float*)take((size_t)2 * p.S * p.RD * 4); p.ab = (float*)take((size_t)2 * p.S * p.RD * 4); p.kdb = (float*)take((size_t)2 * p.S * p.RD * 4);
  p.yb = (float*)take((size_t)2 * p.S * p.RD * 4); p.fa = (float*)take((size_t)p.L * p.FW * 4); p.fb = (float*)take((size_t)p.L * p.FW * 4);
  size_t end1 = off; off = mark;
  p.act = (float*)take((size_t)p.T * 2 * p.DE * 4);
  size_t end2 = off; off = end0 > end1 ? end0 : end1; off = off > end2 ? off : end2;
  return off;
}
static inline void np_set_inputs(NP& p, void* const* d_in) {
  const float** f = (const float**)&p.x; for (int i = 0; i < 34; ++i) f[i] = (const float*)d_in[i];
}

#define NAIVE_FORWARD(p)                                                                                                    \
  do {                                                                                                                      \
    RUN(ST_MOD, (long)2 * (p.B + 1) * 6 * p.D); RUN(ST_INIT, (long)p.T * p.D); RUN(ST_TAB, (long)p.L);                       \
    for (int layer = 0; layer < 2; ++layer) {                                                                               \
      p.layer = layer; p.which = 0; RUN(ST_RMS, (long)p.T); RUN(ST_HMOD, (long)p.T * p.D);                                   \
      for (int b = 0; b < p.B; ++b) {                                                                                       \
        p.b0 = b; RUN(ST_GEMM_IN, (long)p.S * (layer == 0 ? p.EC : p.OC));                                                   \
        if (layer == 0) {                                                                                                   \
          RUN(ST_GLA_DECAY, (long)p.S * 2 * p.GC); RUN(ST_ATT_PREP, (long)p.S * (p.AH + p.AKV)); RUN(ST_GLA_SCAN, (long)p.GH * 128); \
        } else {                                                                                                            \
          RUN(ST_RWKV_KK, (long)p.S * p.RH); RUN(ST_RWKV_WA, (long)2 * p.S * p.RD); RUN(ST_RWKV_SCAN, (long)p.RH * 128);       \
          RUN(ST_FOUR1, (long)p.L * p.FW);                                                                                   \
        }                                                                                                                   \
                   \
        if (layer == 0) { RUN(ST_ATT_LAT, (long)p.L * p.AH); RUN(ST_ATT_CTX, (long)p.LC * p.AH); RUN(ST_GLA_MERGE, (long)p.S * p.GH); } \
        else { RUN(ST_RWKV_OUT, (long)p.L * p.RH); RUN(ST_FOUR2, (long)p.L * p.FW); }                                         \
      }                                                                                                                     \
      RUN(ST_OUTPROJ, (long)p.T * p.D);                                                                                      \
      p.which = 1; RUN(ST_RMS, (long)p.T); RUN(ST_HMOD, (long)p.T * p.D);                                                    \
      RUN(ST_ROUTER, (long)p.T); RUN(ST_MOE_GU, (long)p.T * 2 * p.DE); RUN(ST_MOE_DOWN, (long)p.T * p.D);                     \
    }                                                                                                                       \
  } while (0)
template <int ST, int BS> __global__ void __launch_bounds__(BS) naive_k(NP p, long n) {
  for (long i = blockIdx.x * (long)BS + threadIdx.x; i < n; i += (long)gridDim.x * BS) stage_body<ST>(p, i);
}
template <int ST> static void naive_run(const NP& p, long nn, hipStream_t stream) {
  constexpr int BS = (ST == ST_RWKV_SCAN || ST == ST_GLA_SCAN) ? 64 : 256;
  long g = (nn + BS - 1) / BS; if (g > (1 << 20)) g = 1 << 20;
  hipLaunchKernelGGL((naive_k<ST, BS>), dim3((unsigned)g), dim3(BS), 0, stream, p, nn);
}
static void naive_forward(NP p, hipStream_t stream) {
#define RUN(ST, n_) naive_run<ST>(p, (long)(n_), stream)
  NAIVE_FORWARD(p);
#undef RUN
}
extern "C" void kernel_launch(void* const* d_in, const int* in_sizes, int n_in, void* d_out, int out_size, void* d_ws, size_t ws_size, hipStream_t stream) {
  NP p; memset(&p, 0, sizeof(p)); np_set_dims(p, 4, 4096, 256, 1024);
  if (n_in != 34 || out_size != 4 * 4096 * 1024) { fprintf(stderr, "kernel_launch: unexpected n_in %d / out_size %d\n", n_in, out_size); return; }
  np_set_inputs(p, d_in); p.out = (float*)d_out;
  size_t need = np_carve(p, nullptr);
  if (need > ws_size) { fprintf(stderr, "kernel_launch: ws too small: need %zu have %zu\n", need, ws_size); return; }
  np_carve(p, (char*)d_ws);
  naive_forward(p, stream);
}
```

```cpp
#include <hip/hip_runtime.h>
#include <cstdio>
#include <cstring>
#include <math.h>
#include <stdint.h>
#ifdef HOST_TEST
#define HD
#define FAST_SIN sinf
#define FAST_COS cosf
#define MEMBAR()
#else
#define HD __host__ __device__ __forceinline__
#define FAST_SIN __sinf
#define FAST_COS __cosf
#define MEMBAR() asm volatile("" ::: "memory")
#endif

struct NP {
  int B, L, LC, S, T, D, GW;
  int GH, GC, AH, AKV, FW, FG, RD, RH, DE, E;
  int EC, OC, RC, NZ;
  int e_gq, e_gk, e_gv, e_gg, e_gdec, e_aq, e_ak, e_av;
  int layer, b0, dir, which, pad0;
  const float *x, *c, *ctx, *c_ctx, *ada_w, *ada_b, *norm_mix, *norm_ffn, *even_w_in, *even_w_out, *gla_dec_w, *gla_dec_b,
      *gla_out_norm, *att_q_norm, *att_k_norm, *att_sink, *odd_w_in, *odd_w_out, *rwkv_mu, *rwkv_w0, *rwkv_w2, *rwkv_a0,
      *rwkv_a2, *rwkv_g2, *rwkv_kk_scale, *rwkv_k_a, *rwkv_r_k, *rwkv_ln_g, *rwkv_ln_b, *router_w, *router_b, *moe_w_gate,
      *moe_w_up, *moe_w_down;
  float *out;
  float *xc;
  float *mod;
  float *rinv;
  float *hbuf;
  float *zb;
  float *lad;
  float *ogla;
  float *kkb;
  float *rsb, *vsb;
  float *decb, *ab, *kdb;
  float *yb;
  float *fa, *fb;
  float *cosT, *sinT;
  int *re;
  float *rw;
  float *act;
};

HD float sigm(float x) { return 1.f / (1.f + expf(-x)); }
HD float siluf_(float x) { return x * sigm(x); }
HD float softplusf_(float x) { return x > 0.f ? x + log1pf(expf(-x)) : log1pf(expf(x)); }
HD float logsigm(float x) { return -softplusf_(-x); }
HD float* xs_row(const NP& p, int t) { int b = t / p.S, s = t % p.S; return s < p.LC ? p.xc + ((size_t)b * p.LC + s) * p.D : p.out + ((size_t)b * p.L + (s - p.LC)) * p.D; }
HD const float* modrow(const NP& p, int layer, int t) { int b = t / p.S, s = t % p.S; int r = s < p.LC ? p.B : b; return p.mod + ((size_t)layer * (p.B + 1) + r) * 6 * p.D; }
HD float zs_at(const NP& p, int s, int c) {
  const float* z = p.zb + (size_t)s * p.NZ + p.FW + c;
  int seg0 = s < p.LC ? 0 : p.LC, seg1 = s < p.LC ? p.LC : p.S;
  float zc = z[0], pv = s > seg0 ? z[-p.NZ] : 0.f, nx = s < seg1 - 1 ? z[p.NZ] : 0.f;
  return zc + p.rwkv_mu[c] * (0.5f * (pv + nx) - zc);
}

enum { ST_MOD, ST_INIT, ST_TAB, ST_RMS, ST_HMOD, ST_GEMM_IN, ST_GLA_DECAY, ST_ATT_PREP, ST_GLA_SCAN, ST_ATT_LAT, ST_ATT_CTX, ST_GLA_MERGE,
       ST_OUTPROJ, ST_ROUTER, ST_MOE_GU, ST_MOE_DOWN, ST_RWKV_KK, ST_RWKV_WA, ST_RWKV_SCAN, ST_RWKV_OUT, ST_FOUR1, ST_FOUR2 };

template <int ST> HD void stage_body(const NP& p, long idx);

template <> HD void stage_body<ST_MOD>(const NP& p, long idx) {
  int D6 = 6 * p.D; int j = idx % D6; int r = (idx / D6) % (p.B + 1); int layer = idx / ((long)D6 * (p.B + 1));
  const float* cv = r < p.B ? p.c + (size_t)r * p.D : p.c_ctx;
  float acc = p.ada_b[layer * D6 + j];
  for (int k = 0; k < p.D; ++k) acc += siluf_(cv[k]) * p.ada_w[((size_t)layer * p.D + k) * D6 + j];
  p.mod[idx] = acc;
}
template <> HD void stage_body<ST_INIT>(const NP& p, long idx) {
  long nl = (long)p.B * p.L * p.D;
  if (idx < nl) p.out[idx] = p.x[idx]; else p.xc[idx - nl] = p.ctx[idx - nl];
}
template <> HD void stage_body<ST_TAB>(const NP& p, long idx) {
  double a = 2.0 * 3.14159265358979323846 * (double)idx / (double)p.L; p.cosT[idx] = (float)cos(a); p.sinT[idx] = (float)sin(a);
}
template <> HD void stage_body<ST_RMS>(const NP& p, long idx) {
  const float* xr = xs_row(p, (int)idx); float s = 0.f;
  for (int d = 0; d < p.D; ++d) s += xr[d] * xr[d];
  p.rinv[idx] = 1.f / sqrtf(s / p.D + 1e-6f);
}
template <> HD void stage_body<ST_HMOD>(const NP& p, long idx) {
  int d = idx % p.D, t = idx / p.D; const float* m = modrow(p, p.layer, t);
  float sh = m[(p.which ? 3 : 0) * p.D + d], sc = m[(p.which ? 4 : 1) * p.D + d];
  float g = (p.which ? p.norm_ffn : p.norm_mix)[p.layer * p.D + d];
  p.hbuf[idx] = xs_row(p, t)[d] * p.rinv[t] * g * (1.f + sc) + sh;
}
template <> HD void stage_body<ST_GEMM_IN>(const NP& p, long idx) {
  int N = p.layer == 0 ? p.EC : p.OC; const float* W = p.layer == 0 ? p.even_w_in : p.odd_w_in;
  int n = idx % N, s = idx / N; const float* a = p.hbuf + ((size_t)p.b0 * p.S + s) * p.D; float acc = 0.f;
  for (int k = 0; k < p.D; ++k) acc += a[k] * W[(size_t)k * N + n];
  p.zb[(size_t)s * p.NZ + n] = acc;
}
template <> HD void stage_body<ST_GLA_DECAY>(const NP& p, long idx) {
  int c = idx % p.GC, dir = (idx / p.GC) % 2, s = idx / (2 * p.GC);
  const float* zd = p.zb + (size_t)s * p.NZ + p.e_gdec + dir * 16; float acc = p.gla_dec_b[dir * p.GC + c];
  for (int r = 0; r < 16; ++r) acc += zd[r] * p.gla_dec_w[(dir * 16 + r) * p.GC + c];
  p.lad[idx] = logsigm(acc) * (1.f / 16.f);
}
template <> HD void stage_body<ST_ATT_PREP>(const NP& p, long idx) {
  int nh = p.AH + p.AKV; int hh = idx % nh, s = idx / nh;
  float* src = p.zb + (size_t)s * p.NZ + (hh < p.AH ? p.e_aq + hh * 64 : p.e_ak + (hh - p.AH) * 64);
  const float* g = hh < p.AH ? p.att_q_norm : p.att_k_norm;
  float v[64]; float ss = 0.f;
#pragma unroll
  for (int e = 0; e < 64; ++e) { v[e] = src[e]; ss += v[e] * v[e]; }
  float ri = 1.f / sqrtf(ss / 64.f + 1e-6f);
#pragma unroll
  for (int e = 0; e < 64; ++e) v[e] = v[e] * ri * g[e];
  if (s >= p.LC) {
    int pos = s - p.LC; float row = (float)(pos / p.GW), col = (float)(pos % p.GW);
#pragma unroll
    for (int j = 0; j < 32; ++j) {
      float inv = exp2f(-(float)(j & 15) * 0.8304820237218406f); float ang = (j < 16 ? row : col) * inv; float cs = FAST_COS(ang), sn = FAST_SIN(ang);
      float t1 = v[j], t2 = v[32 + j]; v[j] = t1 * cs - t2 * sn; v[32 + j] = t1 * sn + t2 * cs;
    }
  }
#pragma unroll
  for (int e = 0; e < 64; ++e) src[e] = v[e];
}
HD int scan_pos(const NP& p, int dir, int step) { return dir == 0 ? step : (step < p.LC ? p.LC - 1 - step : p.S - 1 - (step - p.LC)); }
template <> HD void stage_body<ST_GLA_SCAN>(const NP& p, long idx) {
  int e = idx % 64, dir = (idx / 64) % 2, hh = idx / 128;
  float S[32];
#pragma unroll
  for (int d = 0; d < 32; ++d) S[d] = 0.f;
  const float qs = 0.17677669529663687f;
  for (int step = 0; step < p.S; ++step) {
    int s = scan_pos(p, dir, step); const float* z = p.zb + (size_t)s * p.NZ; const float* la = p.lad + ((size_t)s * 2 + dir) * p.GC + hh * 32;
    float v = z[p.e_gv + hh * 64 + e], o = 0.f;
#pragma unroll
    for (int d = 0; d < 32; ++d) { S[d] = expf(la[d]) * S[d] + z[p.e_gk + hh * 32 + d] * v; o += z[p.e_gq + hh * 32 + d] * qs * S[d]; }
    p.ogla[((size_t)dir * p.S + s) * (p.GH * 64) + hh * 64 + e] = o;
  }
}
template <> HD void stage_body<ST_ATT_LAT>(const NP& p, long idx) {
  int hq = idx % p.AH, pos = idx / p.AH; int G = p.AH / p.AKV, kvh = hq / G; int s = p.LC + pos;
  const float* q = p.zb + (size_t)s * p.NZ + p.e_aq + hq * 64;
  float qv[64], o[64];
#pragma unroll
  for (int e = 0; e < 64; ++e) { qv[e] = q[e]; o[e] = 0.f; }
  float m = p.att_sink[hq], l = 1.f;
  int j0 = pos - 128 < 0 ? 0 : pos - 128, j1 = pos + 128 > p.L - 1 ? p.L - 1 : pos + 128;
  int nk = (j1 - j0 + 1) + p.LC;
  for (int i = 0; i < nk; ++i) {
    int sk = i < (j1 - j0 + 1) ? p.LC + j0 + i : i - (j1 - j0 + 1);
    const float* k = p.zb + (size_t)sk * p.NZ + p.e_ak + kvh * 64; const float* v = p.zb + (size_t)sk * p.NZ + p.e_av + kvh * 64;
    float sc = 0.f;
#pragma unroll
    for (int e = 0; e < 64; ++e) sc += qv[e] * k[e];
    sc *= 0.125f; float mn = sc > m ? sc : m; float f = expf(m - mn), pe = expf(sc - mn); l = l * f + pe; m = mn;
#pragma unroll
    for (int e = 0; e < 64; ++e) o[e] = o[e] * f + pe * v[e];
  }
  float* dst = p.hbuf + ((size_t)p.b0 * p.S + s) * p.D + p.GH * 64 + hq * 64;
#pragma unroll
  for (int e = 0; e < 64; ++e) dst[e] = o[e] / l;
}
template <> HD void stage_body<ST_ATT_CTX>(const NP& p, long idx) {
  int hq = idx % p.AH, s = idx / p.AH; int G = p.AH / p.AKV, kvh = hq / G;
  const float* q = p.zb + (size_t)s * p.NZ + p.e_aq + hq * 64;
  float qv[64], o[64];
#pragma unroll
  for (int e = 0; e < 64; ++e) { qv[e] = q[e]; o[e] = 0.f; }
  float m = p.att_sink[hq], l = 1.f;
  for (int sk = 0; sk < p.LC; ++sk) {
    const float* k = p.zb + (size_t)sk * p.NZ + p.e_ak + kvh * 64; const float* v = p.zb + (size_t)sk * p.NZ + p.e_av + kvh * 64;
    float sc = 0.f;
#pragma unroll
    for (int e = 0; e < 64; ++e) sc += qv[e] * k[e];
    sc *= 0.125f; float mn = sc > m ? sc : m; float f = expf(m - mn), pe = expf(sc - mn); l = l * f + pe; m = mn;
#pragma unroll
    for (int e = 0; e < 64; ++e) o[e] = o[e] * f + pe * v[e];
  }
  float* dst = p.hbuf + ((size_t)p.b0 * p.S + s) * p.D + p.GH * 64 + hq * 64;
#pragma unroll
  for (int e = 0; e < 64; ++e) dst[e] = o[e] / l;
}
template <> HD void stage_body<ST_GLA_MERGE>(const NP& p, long idx) {
  int hh = idx % p.GH, s = idx / p.GH; int W = p.GH * 64;
  const float* o0 = p.ogla + (size_t)s * W + hh * 64; const float* o1 = p.ogla + ((size_t)p.S + s) * W + hh * 64;
  float v[64]; float ss = 0.f;
#pragma unroll
  for (int e = 0; e < 64; ++e) { v[e] = o0[e] + o1[e]; ss += v[e] * v[e]; }
  float ri = 1.f / sqrtf(ss / 64.f + 1e-6f);
  const float* gg = p.zb + (size_t)s * p.NZ + p.e_gg + hh * 64; float* dst = p.hbuf + ((size_t)p.b0 * p.S + s) * p.D + hh * 64;
#pragma unroll
  for (int e = 0; e < 64; ++e) dst[e] = v[e] * ri * p.gla_out_norm[e] * siluf_(gg[e]);
}
template <> HD void stage_body<ST_OUTPROJ>(const NP& p, long idx) {
  int n = idx % p.D, t = idx / p.D; if (p.layer == 1 && (t % p.S) < p.LC) return;
  const float* W = p.layer == 0 ? p.even_w_out : p.odd_w_out; const float* a = p.hbuf + (size_t)t * p.D; float acc = 0.f;
  for (int k = 0; k < p.D; ++k) acc += a[k] * W[(size_t)k * p.D + n];
  xs_row(p, t)[n] += modrow(p, p.layer, t)[2 * p.D + n] * acc;
}
template <> HD void stage_body<ST_ROUTER>(const NP& p, long idx) {
  int t = idx; if (p.layer == 1 && (t % p.S) < p.LC) return;
  float lg[16];
#pragma unroll
  for (int e = 0; e < 16; ++e) lg[e] = 0.f;
  const float* h = p.hbuf + (size_t)t * p.D;
  for (int k = 0; k < p.D; ++k) { float hv = h[k];
#pragma unroll
    for (int e = 0; e < 16; ++e) lg[e] += hv * p.router_w[k * 16 + e]; }
  float sc[16], sel[16];
#pragma unroll
  for (int e = 0; e < 16; ++e) { sc[e] = sigm(lg[e]); sel[e] = sc[e] + p.router_b[e]; }
  int best = 0; float bests = -1e30f;
#pragma unroll
  for (int g = 0; g < 4; ++g) {
    float m1 = -1e30f, m2 = -1e30f;
#pragma unroll
    for (int i = 0; i < 4; ++i) { float v = sel[g * 4 + i]; if (v > m1) { m2 = m1; m1 = v; } else if (v > m2) m2 = v; }
    float gs = m1 + m2; if (gs > bests) { bests = gs; best = g; }
  }
  int i0 = -1, i1 = -1; float v0 = -1e30f, v1 = -1e30f, s0 = 0.f, s1 = 0.f;
#pragma unroll
  for (int e = 0; e < 16; ++e) {
    if ((e >> 2) == best) { float v = sel[e];
      if (v > v0) { v1 = v0; i1 = i0; s1 = s0; v0 = v; i0 = e; s0 = sc[e]; } else if (v > v1) { v1 = v; i1 = e; s1 = sc[e]; } }
  }
  float sum = s0 + s1; p.re[t * 2] = i0; p.re[t * 2 + 1] = i1; p.rw[t * 2] = s0 / sum; p.rw[t * 2 + 1] = s1 / sum;
}
template <> HD void stage_body<ST_MOE_GU>(const NP& p, long idx) {
  int j = idx % p.DE, slot = (idx / p.DE) % 2, t = idx / (2 * p.DE); if (p.layer == 1 && (t % p.S) < p.LC) return;
  int e = p.re[t * 2 + slot]; const float* h = p.hbuf + (size_t)t * p.D;
  const float* wg = p.moe_w_gate + ((size_t)(p.layer * p.E + e) * p.D) * p.DE + j; const float* wu = p.moe_w_up + ((size_t)(p.layer * p.E + e) * p.D) * p.DE + j;
  float g = 0.f, u = 0.f;
  for (int k = 0; k < p.D; ++k) { g += h[k] * wg[(size_t)k * p.DE]; u += h[k] * wu[(size_t)k * p.DE]; }
  p.act[idx] = siluf_(g) * u;
}
template <> HD void stage_body<ST_MOE_DOWN>(const NP& p, long idx) {
  int n = idx % p.D, t = idx / p.D; if (p.layer == 1 && (t % p.S) < p.LC) return;
  float y = 0.f;
  for (int slot = 0; slot < 2; ++slot) {
    int e = p.re[t * 2 + slot]; const float* a = p.act + ((size_t)t * 2 + slot) * p.DE; const float* wd = p.moe_w_down + ((size_t)(p.layer * p.E + e) * p.DE) * p.D + n;
    float acc = 0.f; for (int k = 0; k < p.DE; ++k) acc += a[k] * wd[(size_t)k * p.D];
    y += p.rw[t * 2 + slot] * acc;
  }
  xs_row(p, t)[n] += modrow(p, p.layer, t)[5 * p.D + n] * y;
}
template <> HD void stage_body<ST_RWKV_KK>(const NP& p, long idx) {
  int hh = idx % p.RH, s = idx / p.RH; float v[64]; float ss = 0.f;
#pragma unroll
  for (int e = 0; e < 64; ++e) { v[e] = zs_at(p, s, p.RD + hh * 64 + e) * p.rwkv_kk_scale[hh * 64 + e]; ss += v[e] * v[e]; }
  float ri = 1.f / sqrtf(ss + 1e-12f);
#pragma unroll
  for (int e = 0; e < 64; ++e) { size_t o = (size_t)s * p.RD + hh * 64 + e; p.kkb[o] = v[e] * ri; p.rsb[o] = zs_at(p, s, hh * 64 + e); p.vsb[o] = zs_at(p, s, 2 * p.RD + hh * 64 + e); }
}
template <> HD void stage_body<ST_RWKV_WA>(const NP& p, long idx) {
  int c = idx % p.RD, s = (idx / p.RD) % p.S, dir = idx / ((long)p.RD * p.S);
  float aw = p.rwkv_w0[dir * p.RD + c], aa = p.rwkv_a0[dir * p.RD + c];
  for (int j = 0; j < 64; ++j) {
    aw += tanhf(zs_at(p, s, 3 * p.RD + dir * 64 + j)) * p.rwkv_w2[(size_t)(dir * 64 + j) * p.RD + c];
    aa += zs_at(p, s, 3 * p.RD + 128 + dir * 64 + j) * p.rwkv_a2[(size_t)(dir * 64 + j) * p.RD + c];
  }
  float wl = -softplusf_(-aw) - 0.5f; float dec = expf(-expf(wl)); float a = sigm(aa);
  float k = zs_at(p, s, p.RD + c);
  p.decb[idx] = dec; p.ab[idx] = a; p.kdb[idx] = k * (1.f + (a - 1.f) * p.rwkv_k_a[c]);
}
template <> HD void stage_body<ST_RWKV_SCAN>(const NP& p, long idx) {
  int v = idx % 64, dir = (idx / 64) % 2, hh = idx / 128;
  float S[64];
#pragma unroll
  for (int k = 0; k < 64; ++k) S[k] = 0.f;
#pragma clang loop unroll(disable)
  for (int step = 0; step < p.S; ++step) {
    int s = scan_pos(p, dir, step); size_t o = ((size_t)dir * p.S + s) * p.RD + hh * 64; size_t o1 = (size_t)s * p.RD + hh * 64;
    const float* w = p.decb + o; const float* a = p.ab + o; const float* kd = p.kdb + o; const float* kk = p.kkb + o1; const float* r = p.rsb + o1;
    float vt = p.vsb[o1 + v]; float dk = 0.f;
#pragma unroll
    for (int k = 0; k < 64; ++k) dk += S[k] * kk[k];
    MEMBAR();
    float y = 0.f;
#pragma unroll
    for (int k0 = 0; k0 < 64; k0 += 8) {
#pragma unroll
      for (int k = k0; k < k0 + 8; ++k) { S[k] = S[k] * w[k] - dk * (kk[k] * a[k]) + vt * kd[k]; y += S[k] * r[k]; }
      MEMBAR();
    }
    p.yb[o + v] = y;
  }
}
template <> HD void stage_body<ST_RWKV_OUT>(const NP& p, long idx) {
  int hh = idx % p.RH, pos = idx / p.RH, s = p.LC + pos;
  float bon = 0.f;
  for (int dir = 0; dir < 2; ++dir) for (int k = 0; k < 64; ++k) bon += zs_at(p, s, hh * 64 + k) * p.kdb[((size_t)dir * p.S + s) * p.RD + hh * 64 + k] * p.rwkv_r_k[hh * 64 + k];
  float y[64]; float mean = 0.f;
#pragma unroll
  for (int v = 0; v < 64; ++v) { y[v] = p.yb[(size_t)s * p.RD + hh * 64 + v] + p.yb[((size_t)p.S + s) * p.RD + hh * 64 + v] + bon * zs_at(p, s, 2 * p.RD + hh * 64 + v); mean += y[v]; }
  mean /= 64.f; float var = 0.f;
#pragma unroll
  for (int v = 0; v < 64; ++v) { float d = y[v] - mean; var += d * d; }
  var /= 64.f; float ri = 1.f / sqrtf(var + 64e-5f);
  float* dst = p.hbuf + ((size_t)p.b0 * p.S + s) * p.D + p.FW + hh * 64;
#pragma unroll
  for (int v = 0; v < 64; ++v) {
    int c = hh * 64 + v; float gate = 0.f;
    for (int j = 0; j < 128; ++j) gate += sigm(zs_at(p, s, 3 * p.RD + 256 + j)) * p.rwkv_g2[(size_t)j * p.RD + c];
    dst[v] = ((y[v] - mean) * ri * p.rwkv_ln_g[c] + p.rwkv_ln_b[c]) * gate;
  }
}
template <> HD void stage_body<ST_FOUR1>(const NP& p, long idx) {
  int col = idx % p.FW, pos = idx / p.FW; int g = col / 64, m = col % 64; const float* z = p.zb + (size_t)(p.LC + pos) * p.NZ + g * 64;
  float a = 0.f, b = 0.f;
  for (int c = 0; c < 64; ++c) { float ang = 6.283185307179586f * (float)((m * c) & 63) / 64.f; a += z[c] * cosf(ang); b += z[c] * sinf(ang); }
  p.fa[idx] = a; p.fb[idx] = b;
}
template <> HD void stage_body<ST_FOUR2>(const NP& p, long idx) {
  int col = idx % p.FW, kp = idx / p.FW; float acc = 0.f;
  for (int l = 0; l < p.L; ++l) { int ti = (int)(((long)kp * l) % p.L); acc += p.cosT[ti] * p.fa[(size_t)l * p.FW + col] - p.sinT[ti] * p.fb[(size_t)l * p.FW + col]; }
  p.hbuf[((size_t)p.b0 * p.S + p.LC + kp) * p.D + col] = acc / sqrtf((float)p.L * 64.f);
}

static inline void np_set_dims(NP& p, int B, int L, int LC, int D) {
  p.B = B; p.L = L; p.LC = LC; p.S = L + LC; p.T = B * p.S; p.D = D; p.GW = 64;
  p.GH = (D / 2) / 64; p.GC = p.GH * 32; p.AH = (D / 2) / 64; p.AKV = p.AH / 4; p.FW = D / 4; p.FG = p.FW / 64; p.RD = D - p.FW; p.RH = p.RD / 64;
  p.DE = D == 1024 ? 512 : D / 2; p.E = 16;
  p.e_gq = 0; p.e_gk = p.e_gq + p.GH * 32; p.e_gv = p.e_gk + p.GH * 32; p.e_gg = p.e_gv + p.GH * 64; p.e_gdec = p.e_gg + p.GH * 64; p.e_aq = p.e_gdec + 32;
  p.e_ak = p.e_aq + p.AH * 64; p.e_av = p.e_ak + p.AKV * 64; p.EC = p.e_av + p.AKV * 64;
  p.RC = 3 * p.RD + 128 + 128 + 128; p.OC = p.FW + p.RC; p.NZ = p.OC > p.EC ? p.OC : p.EC;
}
static inline size_t np_carve(NP& p, char* base) {
  size_t off = 0; auto take = [&](size_t bytes) { char* r = base ? base + off : nullptr; off += (bytes + 255) & ~(size_t)255; return r; };
  p.xc = (float*)take((size_t)p.B * p.LC * p.D * 4); p.mod = (float*)take((size_t)2 * (p.B + 1) * 6 * p.D * 4); p.rinv = (float*)take((size_t)p.T * 4);
  p.hbuf = (float*)take((size_t)p.T * p.D * 4); p.zb = (float*)take((size_t)p.S * p.NZ * 4);
  p.cosT = (float*)take((size_t)p.L * 4); p.sinT = (float*)take((size_t)p.L * 4);
  p.re = (int*)take((size_t)p.T * 2 * 4); p.rw = (float*)take((size_t)p.T * 2 * 4);
  size_t mark = off;
  p.lad = (float*)take((size_t)p.S * 2 * p.GC * 4); p.ogla = (float*)take((size_t)2 * p.S * p.GH * 64 * 4);
  size_t end0 = off; off = mark;
  p.kkb = (float*)take((size_t)p.S * p.RD * 4); p.rsb = (float*)take((size_t)p.S * p.RD * 4); p.vsb = (float*)take((size_t)p.S * p.RD * 4); p.decb = (float*)take((size_t)2 * p.S * p.RD * 4); p.ab = (float*)take((size_t)2 * p.S * p.RD * 4); p.kdb = (float*)take((size_t)2 * p.S * p.RD * 4);
  p.yb = (float*)take((size_t)2 * p.S * p.RD * 4); p.fa = (float*)take((size_t)p.L * p.FW * 4); p.fb = (float*)take((size_t)p.L * p.FW * 4);
  size_t end1 = off; off = mark;
  p.act = (float*)take((size_t)p.T * 2 * p.DE * 4);
  size_t end2 = off; off = end0 > end1 ? end0 : end1; off = off > end2 ? off : end2;
  return off;
}
static inline void np_set_inputs(NP& p, void* const* d_in) {
  const float** f = (const float**)&p.x; for (int i = 0; i < 34; ++i) f[i] = (const float*)d_in[i];
}

#define NAIVE_FORWARD(p)                                                                                                    \
  do {                                                                                                                      \
    RUN(ST_MOD, (long)2 * (p.B + 1) * 6 * p.D); RUN(ST_INIT, (long)p.T * p.D); RUN(ST_TAB, (long)p.L);                       \
    for (int layer = 0; layer < 2; ++layer) {                                                                               \
      p.layer = layer; p.which = 0; RUN(ST_RMS, (long)p.T); RUN(ST_HMOD, (long)p.T * p.D);                                   \
      for (int b = 0; b < p.B; ++b) {                                                                                       \
        p.b0 = b; RUN(ST_GEMM_IN, (long)p.S * (layer == 0 ? p.EC : p.OC));                                                   \
        if (layer == 0) {                                                                                                   \
          RUN(ST_GLA_DECAY, (long)p.S * 2 * p.GC); RUN(ST_ATT_PREP, (long)p.S * (p.AH + p.AKV)); RUN(ST_GLA_SCAN, (long)p.GH * 128); \
        } else {                                                                                                            \
          RUN(ST_RWKV_KK, (long)p.S * p.RH); RUN(ST_RWKV_WA, (long)2 * p.S * p.RD); RUN(ST_RWKV_SCAN, (long)p.RH * 128);       \
          RUN(ST_FOUR1, (long)p.L * p.FW);                                                                                   \
        }                                                                                                                   \
                   \
        if (layer == 0) { RUN(ST_ATT_LAT, (long)p.L * p.AH); RUN(ST_ATT_CTX, (long)p.LC * p.AH); RUN(ST_GLA_MERGE, (long)p.S * p.GH); } \
        else { RUN(ST_RWKV_OUT, (long)p.L * p.RH); RUN(ST_FOUR2, (long)p.L * p.FW); }                                         \
      }                                                                                                                     \
      RUN(ST_OUTPROJ, (long)p.T * p.D);                                                                                      \
      p.which = 1; RUN(ST_RMS, (long)p.T); RUN(ST_HMOD, (long)p.T * p.D);                                                    \
      RUN(ST_ROUTER, (long)p.T); RUN(ST_MOE_GU, (long)p.T * 2 * p.DE); RUN(ST_MOE_DOWN, (long)p.T * p.D);                     \
    }                                                                                                                       \
  } while (0)
#include <hip/hip_cooperative_groups.h>
namespace cg = cooperative_groups;
struct ProgEnt { int st, layer, b0, which; long n; };
#define MAX_PROG 80
struct MegaArgs { NP p; int nprog; int pad; ProgEnt prog[MAX_PROG]; };

template <int ST> __device__ __forceinline__ void mega_stage(const NP& p, long n) {
  for (long i = blockIdx.x * (long)blockDim.x + threadIdx.x; i < n; i += (long)gridDim.x * blockDim.x) stage_body<ST>(p, i);
}
__global__ void __launch_bounds__(256) mega_naive_k(MegaArgs a) {
  cg::grid_group grid = cg::this_grid();
  NP p = a.p;
  for (int i = 0; i < a.nprog; ++i) {
    const ProgEnt e = a.prog[i]; p.layer = e.layer; p.b0 = e.b0; p.which = e.which;
    switch (e.st) {
#define CASE(ST) case ST: mega_stage<ST>(p, e.n); break;
      CASE(ST_MOD) CASE(ST_INIT) CASE(ST_TAB) CASE(ST_RMS) CASE(ST_HMOD) CASE(ST_GEMM_IN) CASE(ST_GLA_DECAY) CASE(ST_ATT_PREP) CASE(ST_GLA_SCAN)
      CASE(ST_ATT_LAT) CASE(ST_ATT_CTX) CASE(ST_GLA_MERGE) CASE(ST_OUTPROJ) CASE(ST_ROUTER) CASE(ST_MOE_GU) CASE(ST_MOE_DOWN) CASE(ST_RWKV_KK)
      CASE(ST_RWKV_WA) CASE(ST_RWKV_SCAN) CASE(ST_RWKV_OUT) CASE(ST_FOUR1) CASE(ST_FOUR2)
#undef CASE
      default: break;
    }
    grid.sync();
  }
}
extern "C" void kernel_launch(void* const* d_in, const int* in_sizes, int n_in, void* d_out, int out_size, void* d_ws, size_t ws_size, hipStream_t stream) {
  static MegaArgs a; static int grid_blocks = 0;
  memset(&a, 0, sizeof(a));
  NP& p = a.p; np_set_dims(p, 4, 4096, 256, 1024);
  if (n_in != 34 || out_size != 4 * 4096 * 1024) { fprintf(stderr, "kernel_launch: unexpected n_in %d / out_size %d\n", n_in, out_size); return; }
  np_set_inputs(p, d_in); p.out = (float*)d_out;
  size_t need = np_carve(p, nullptr);
  if (need > ws_size) { fprintf(stderr, "kernel_launch: ws too small: need %zu have %zu\n", need, ws_size); return; }
  np_carve(p, (char*)d_ws);
  int np_ = 0;
#define RUN(ST, n_) do { if (np_ < MAX_PROG) { a.prog[np_].st = ST; a.prog[np_].layer = p.layer; a.prog[np_].b0 = p.b0; a.prog[np_].which = p.which; a.prog[np_].n = (long)(n_); } ++np_; } while (0)
  NAIVE_FORWARD(p);
#undef RUN
  if (np_ > MAX_PROG) { fprintf(stderr, "kernel_launch: program too long (%d)\n", np_); return; }
  a.nprog = np_; p.layer = 0; p.b0 = 0; p.which = 0;
  if (!grid_blocks) {
    int dev = 0, cus = 0, per_cu = 0; hipGetDevice(&dev); hipDeviceGetAttribute(&cus, hipDeviceAttributeMultiprocessorCount, dev);
    hipOccupancyMaxActiveBlocksPerMultiprocessor(&per_cu, mega_naive_k, 256, 0);
    if (per_cu > 2) per_cu = 2;
    grid_blocks = cus * per_cu; fprintf(stderr, "kernel_launch: cus %d per_cu %d grid %d nprog %d\n", cus, per_cu, grid_blocks, np_);
  }
  void* args[] = {&a};
  hipError_t e = hipLaunchCooperativeKernel((void*)mega_naive_k, dim3(grid_blocks), dim3(256), args, 0, stream);
  if (e != hipSuccess) fprintf(stderr, "cooperative launch failed: %s (grid %d)\n", hipGetErrorString(e), grid_blocks);
}
```

```cpp
#include <hip/hip_runtime.h>
#include <cstdio>
#include <cstring>
constexpr int FB = 4, FL = 4096, FLC = 256, FS = 4352, FT = 17408, FD = 1024;
constexpr int Z0_GQ = 0, Z0_GK = 256, Z0_GV = 512, Z0_GG = 1024, Z0_AQ = 1536, Z0_AK = 2048, Z0_AV = 2176, Z0_GDEC = 2304, Z0_N = 2336, Z0_LD = 2432;
constexpr int Z1_N = 2944, Z1_LD = 2944;
constexpr int SRC_GDEC = 1536, SRC_AQ = 1568;
__host__ __device__ __forceinline__ int z0_dst_of_src(int n) { return n < SRC_GDEC ? n : (n < SRC_AQ ? Z0_GDEC + (n - SRC_GDEC) : n - 32); }
__host__ __device__ __forceinline__ int z0_src_of_dst(int d) { return d < Z0_AQ ? d : (d < Z0_GDEC ? d + 32 : (d < Z0_N ? SRC_GDEC + (d - Z0_GDEC) : -1)); }
#include <math.h>
#include <stdint.h>
#ifdef HOST_TEST
#define HD
#define FAST_SIN sinf
#define FAST_COS cosf
#define MEMBAR()
#else
#define HD __host__ __device__ __forceinline__
#define FAST_SIN __sinf
#define FAST_COS __cosf
#define MEMBAR() asm volatile("" ::: "memory")
#endif

struct NP {
  int B, L, LC, S, T, D, GW;
  int GH, GC, AH, AKV, FW, FG, RD, RH, DE, E;
  int EC, OC, RC, NZ;
  int e_gq, e_gk, e_gv, e_gg, e_gdec, e_aq, e_ak, e_av;
  int layer, b0, dir, which, pad0;
  const float *x, *c, *ctx, *c_ctx, *ada_w, *ada_b, *norm_mix, *norm_ffn, *even_w_in, *even_w_out, *gla_dec_w, *gla_dec_b,
      *gla_out_norm, *att_q_norm, *att_k_norm, *att_sink, *odd_w_in, *odd_w_out, *rwkv_mu, *rwkv_w0, *rwkv_w2, *rwkv_a0,
      *rwkv_a2, *rwkv_g2, *rwkv_kk_scale, *rwkv_k_a, *rwkv_r_k, *rwkv_ln_g, *rwkv_ln_b, *router_w, *router_b, *moe_w_gate,
      *moe_w_up, *moe_w_down;
  float *out;
  float *xc;
  float *mod;
  float *rinv;
  float *hbuf;
  float *zb;
  float *lad;
  float *ogla;
  float *kkb;
  float *rsb, *vsb;
  float *decb, *ab, *kdb;
  float *yb;
  float *fa, *fb;
  float *cosT, *sinT;
  int *re;
  float *rw;
  float *act;
};

HD float sigm(float x) { return 1.f / (1.f + expf(-x)); }
HD float siluf_(float x) { return x * sigm(x); }
HD float softplusf_(float x) { return x > 0.f ? x + log1pf(expf(-x)) : log1pf(expf(x)); }
HD float logsigm(float x) { return -softplusf_(-x); }
HD float* xs_row(const NP& p, int t) { int b = t / p.S, s = t % p.S; return s < p.LC ? p.xc + ((size_t)b * p.LC + s) * p.D : p.out + ((size_t)b * p.L + (s - p.LC)) * p.D; }
HD const float* modrow(const NP& p, int layer, int t) { int b = t / p.S, s = t % p.S; int r = s < p.LC ? p.B : b; return p.mod + ((size_t)layer * (p.B + 1) + r) * 6 * p.D; }
HD float zs_at(const NP& p, int s, int c) {
  const float* z = p.zb + (size_t)s * p.NZ + p.FW + c;
  int seg0 = s < p.LC ? 0 : p.LC, seg1 = s < p.LC ? p.LC : p.S;
  float zc = z[0], pv = s > seg0 ? z[-p.NZ] : 0.f, nx = s < seg1 - 1 ? z[p.NZ] : 0.f;
  return zc + p.rwkv_mu[c] * (0.5f * (pv + nx) - zc);
}

static inline void np_set_dims(NP& p, int B, int L, int LC, int D) {
  p.B = B; p.L = L; p.LC = LC; p.S = L + LC; p.T = B * p.S; p.D = D; p.GW = 64;
  p.GH = (D / 2) / 64; p.GC = p.GH * 32; p.AH = (D / 2) / 64; p.AKV = p.AH / 4; p.FW = D / 4; p.FG = p.FW / 64; p.RD = D - p.FW; p.RH = p.RD / 64;
  p.DE = D == 1024 ? 512 : D / 2; p.E = 16;
  p.e_gq = 0; p.e_gk = p.e_gq + p.GH * 32; p.e_gv = p.e_gk + p.GH * 32; p.e_gg = p.e_gv + p.GH * 64; p.e_gdec = p.e_gg + p.GH * 64; p.e_aq = p.e_gdec + 32;
  p.e_ak = p.e_aq + p.AH * 64; p.e_av = p.e_ak + p.AKV * 64; p.EC = p.e_av + p.AKV * 64;
  p.RC = 3 * p.RD + 128 + 128 + 128; p.OC = p.FW + p.RC; p.NZ = p.OC > p.EC ? p.OC : p.EC;
}
static inline void np_set_inputs(NP& p, void* const* d_in) {
  const float** f = (const float**)&p.x; for (int i = 0; i < 34; ++i) f[i] = (const float*)d_in[i];
}
typedef unsigned short bf16_t;
typedef short bf16x8 __attribute__((ext_vector_type(8)));
typedef float f32x4 __attribute__((ext_vector_type(4)));
typedef float f32x2 __attribute__((ext_vector_type(2)));
typedef unsigned u32x4 __attribute__((ext_vector_type(4)));
typedef unsigned u32x2 __attribute__((ext_vector_type(2)));
typedef __bf16 bf16v2 __attribute__((ext_vector_type(2)));
#define NT 512
#define NBLK_MAX 256

__device__ __forceinline__ unsigned pk2(float a, float b) { bf16v2 r = __builtin_convertvector((f32x2){a, b}, bf16v2); return __builtin_bit_cast(unsigned, r); }
__device__ __forceinline__ bf16_t f2bf(float a) { return (bf16_t)(pk2(a, 0.f) & 0xffffu); }
__device__ __forceinline__ float bf2f(bf16_t v) { return __uint_as_float((unsigned)v << 16); }
__device__ __forceinline__ float bflo(unsigned u) { return __uint_as_float(u << 16); }
__device__ __forceinline__ float bfhi(unsigned u) { return __uint_as_float(u & 0xffff0000u); }
__device__ __forceinline__ float wave_sum(float v) {
#pragma unroll
  for (int o = 1; o < 64; o <<= 1) v += __shfl_xor(v, o);
  return v;
}
__device__ __forceinline__ float fsigm(float x) { return 1.f / (1.f + __expf(-x)); }
__device__ __forceinline__ float fsilu(float x) { return x * fsigm(x); }

template <int WM, int WN> struct GemmCfg { static constexpr int BM = WM * 64, BN = WN * 64, STAGE = (BM + BN) * 128, LDS_BYTES = 2 * STAGE; };

template <int WM, int WN, class ARow, class Epi>
__device__ __forceinline__ void gemm_tile(const ARow& arow, const bf16_t* __restrict__ Bt, int ldb, int K, int m0, int n0, char* lds, const Epi& epi) {
  constexpr int BM = WM * 64, BN = WN * 64, STAGE = (BM + BN) * 128;
  const int tid = threadIdx.x, lane = tid & 63, wave = tid >> 6, wm = wave / WN, wn = wave % WN;
  const int crow = tid >> 3, kc = tid & 7;
  const bf16_t* ap[WM]; const bf16_t* bp[WN];
#pragma unroll
  for (int i = 0; i < WM; ++i) ap[i] = arow(m0 + crow + 64 * i) + kc * 8;
#pragma unroll
  for (int i = 0; i < WN; ++i) bp[i] = Bt + (size_t)(n0 + crow + 64 * i) * ldb + kc * 8;
  const int wofs = crow * 128 + ((kc ^ (crow & 7)) << 4);
  u32x4 ra[WM], rb[WN];
  f32x4 acc[4][4];
#pragma unroll
  for (int i = 0; i < 4; ++i)
#pragma unroll
    for (int j = 0; j < 4; ++j) acc[i][j] = (f32x4){0.f, 0.f, 0.f, 0.f};
  const int nk = K / 64;
#pragma unroll
  for (int i = 0; i < WM; ++i) ra[i] = *(const u32x4*)(ap[i]);
#pragma unroll
  for (int i = 0; i < WN; ++i) rb[i] = *(const u32x4*)(bp[i]);
  __syncthreads();
#pragma unroll
  for (int i = 0; i < WM; ++i) *(u32x4*)(lds + wofs + i * 8192) = ra[i];
#pragma unroll
  for (int i = 0; i < WN; ++i) *(u32x4*)(lds + BM * 128 + wofs + i * 8192) = rb[i];
  __syncthreads();
  const int fr = lane & 15, fg = lane >> 4;
  for (int kt = 0; kt < nk; ++kt) {
    char* cur = lds + (kt & 1) * STAGE; char* nxt = lds + ((kt + 1) & 1) * STAGE;
    if (kt + 1 < nk) {
#pragma unroll
      for (int i = 0; i < WM; ++i) ra[i] = *(const u32x4*)(ap[i] + (kt + 1) * 64);
#pragma unroll
      for (int i = 0; i < WN; ++i) rb[i] = *(const u32x4*)(bp[i] + (kt + 1) * 64);
    }
    const char* As = cur + (wm * 64) * 128; const char* Bs = cur + BM * 128 + (wn * 64) * 128;
#pragma unroll
    for (int kh = 0; kh < 2; ++kh) {
      bf16x8 af[4], bfr[4];
      const int ch = kh * 4 + fg;
#pragma unroll
      for (int t = 0; t < 4; ++t) { const int r = t * 16 + fr; const int o = r * 128 + ((ch ^ (r & 7)) << 4); af[t] = *(const bf16x8*)(As + o); bfr[t] = *(const bf16x8*)(Bs + o); }
#pragma unroll
      for (int mt = 0; mt < 4; ++mt)
#pragma unroll
        for (int nt = 0; nt < 4; ++nt) acc[mt][nt] = __builtin_amdgcn_mfma_f32_16x16x32_bf16(bfr[nt], af[mt], acc[mt][nt], 0, 0, 0);
    }
    if (kt + 1 < nk) {
#pragma unroll
      for (int i = 0; i < WM; ++i) *(u32x4*)(nxt + wofs + i * 8192) = ra[i];
#pragma unroll
      for (int i = 0; i < WN; ++i) *(u32x4*)(nxt + BM * 128 + wofs + i * 8192) = rb[i];
    }
    __syncthreads();
  }
  epi(acc, m0 + wm * 64, n0 + wn * 64, lane);
}

template <class RowMap>
__device__ __forceinline__ void prep_tile(const float* __restrict__ W, int K, int N, bf16_t* __restrict__ Wt, int k0, int n0, const RowMap& rm, char* lds) {
  float* tile = (float*)lds; const int tid = threadIdx.x;
  __syncthreads();
  { const int k = tid >> 3, n8 = (tid & 7) * 8; const float* src = W + (size_t)(k0 + k) * N + n0 + n8;
#pragma unroll
    for (int j = 0; j < 8; ++j) tile[k * 65 + n8 + j] = (n0 + n8 + j < N) ? src[j] : 0.f; }
  __syncthreads();
  { const int n = tid >> 3, k8 = (tid & 7) * 8; const int dr = (n0 + n < N) ? rm(n0 + n) : -1;
    if (dr >= 0) { u32x4 o; const float* s = tile + k8 * 65 + n;
      o.x = pk2(s[0], s[65]); o.y = pk2(s[130], s[195]); o.z = pk2(s[260], s[325]); o.w = pk2(s[390], s[455]);
      *(u32x4*)(Wt + (size_t)dr * K + k0 + k8) = o; } }
}
struct RowMapIn0 { __device__ int operator()(int n) const { return z0_dst_of_src(n); } };
struct RowMapId { __device__ int operator()(int n) const { return n; } };
struct ARowPlain { const bf16_t* base; int lda; __device__ const bf16_t* operator()(int m) const { return base + (size_t)m * lda; } };
struct FP {
  NP p;
  bf16_t* hb;
  bf16_t* wt_in;
  bf16_t* wt_out;
  bf16_t* moe_gu;
  bf16_t* moe_d;
  int* cnt;
  int* list;
  int* tok_e;
  int* tok_pos;
  float* tok_w;
  bf16_t* act;
  bf16_t* ymoe;
  bf16_t* zf;
  bf16_t* vT;
  float* gla_b;
  float* gla_s;
  float* gla_dec;
  int layer; int pad1;
};
__device__ __forceinline__ float* f_xs_row(const FP& f, int t) { const int b = t / FS, s = t - b * FS; return s < FLC ? f.p.xc + ((size_t)b * FLC + s) * FD : f.p.out + ((size_t)b * FL + (s - FLC)) * FD; }
__device__ __forceinline__ const float* f_modrow(const FP& f, int layer, int t) { const int b = t / FS, s = t - b * FS; const int r = s < FLC ? FB : b; return f.p.mod + ((size_t)layer * (FB + 1) + r) * 6 * FD; }

struct RowMapGate { __device__ int operator()(int j) const { return (j >> 5) * 64 + (j & 31); } };
struct RowMapUp { __device__ int operator()(int j) const { return (j >> 5) * 64 + 32 + (j & 31); } };
__device__ __forceinline__ void ph_prep_out(const FP& f, int layer, char* lds) {
  const float* W = layer == 0 ? f.p.even_w_out : f.p.odd_w_out;
  for (int t = blockIdx.x; t < 16 * 16; t += gridDim.x) prep_tile(W, FD, FD, f.wt_out, (t & 15) * 64, (t >> 4) * 64, RowMapId(), lds);
}
__device__ __forceinline__ void ph_prep_moe(const FP& f, int layer, char* lds) {
  const int per_e = 128 * 3;
  for (int t = blockIdx.x; t < 16 * per_e; t += gridDim.x) {
    const int e = t / per_e, r = t % per_e, which = r / 128, q = r % 128;
    if (which == 0) prep_tile(f.p.moe_w_gate + (size_t)(layer * 16 + e) * FD * 512, FD, 512, f.moe_gu + (size_t)e * FD * FD, (q & 15) * 64, (q >> 4) * 64, RowMapGate(), lds);
    else if (which == 1) prep_tile(f.p.moe_w_up + (size_t)(layer * 16 + e) * FD * 512, FD, 512, f.moe_gu + (size_t)e * FD * FD, (q & 15) * 64, (q >> 4) * 64, RowMapUp(), lds);
    else prep_tile(f.p.moe_w_down + (size_t)(layer * 16 + e) * 512 * FD, 512, FD, f.moe_d + (size_t)e * FD * 512, (q & 7) * 64, (q >> 3) * 64, RowMapId(), lds);
  }
}
struct EpiOutProj { const FP* f; int layer;
  __device__ void operator()(const f32x4 (&acc)[4][4], int mb, int nb, int lane) const {
    const int fr = lane & 15, fg = lane >> 4;
#pragma unroll
    for (int mt = 0; mt < 4; ++mt) { const int m = mb + mt * 16 + fr; float* xr = f_xs_row(*f, m); const float* md = f_modrow(*f, layer, m) + 2 * FD;
#pragma unroll
      for (int nt = 0; nt < 4; ++nt) { const int c = nb + nt * 16 + fg * 4; f32x4 x = *(f32x4*)(xr + c); const f32x4 g = *(const f32x4*)(md + c); x += g * acc[mt][nt]; *(f32x4*)(xr + c) = x; } }
  } };
__device__ __forceinline__ void ph_outproj(const FP& f, const bf16_t* wt, int layer, char* lds) {
  ARowPlain ar{f.hb, FD}; EpiOutProj ep{&f, layer};
  for (int t = blockIdx.x; t < 68 * 8; t += gridDim.x) { const int tm = t >> 3, tn = t & 7; if (layer == 1 && (tm % 17) == 0) continue; gemm_tile<4, 2>(ar, wt, FD, FD, tm * 256, tn * 128, lds, ep); }
}
__device__ __forceinline__ void ph_ffn_router(const FP& f, int layer) {
  const int lane = threadIdx.x & 63, gw = blockIdx.x * (NT / 64) + (threadIdx.x >> 6), ngw = gridDim.x * (NT / 64);
  for (int t = gw; t < FT; t += ngw) {
    const int b = t / FS, s = t - b * FS; if (layer == 1 && s < FLC) continue;
    const float* xr = f_xs_row(f, t); const float* md = f_modrow(f, layer, t); const float* gn = f.p.norm_ffn + layer * FD;
    f32x4 v[4]; float ss = 0.f;
#pragma unroll
    for (int j = 0; j < 4; ++j) { v[j] = *(const f32x4*)(xr + j * 256 + lane * 4); ss += v[j].x * v[j].x + v[j].y * v[j].y + v[j].z * v[j].z + v[j].w * v[j].w; }
    const float ri = 1.f / sqrtf(wave_sum(ss) * (1.f / FD) + 1e-6f);
    float lg[16];
#pragma unroll
    for (int e = 0; e < 16; ++e) lg[e] = 0.f;
#pragma unroll
    for (int j = 0; j < 4; ++j) { const int c = j * 256 + lane * 4; const f32x4 g = *(const f32x4*)(gn + c), sh = *(const f32x4*)(md + 3 * FD + c), sc = *(const f32x4*)(md + 4 * FD + c);
      f32x4 h = v[j] * ri * g * (sc + 1.f) + sh; u32x2 o; o.x = pk2(h.x, h.y); o.y = pk2(h.z, h.w); *(u32x2*)(f.hb + (size_t)t * FD + c) = o;
#pragma unroll
      for (int i = 0; i < 4; ++i) { const float hv = h[i]; const f32x4* rw = (const f32x4*)(f.p.router_w + (size_t)(c + i) * 16);
#pragma unroll
        for (int q = 0; q < 4; ++q) { const f32x4 w = rw[q]; lg[q * 4 + 0] += hv * w.x; lg[q * 4 + 1] += hv * w.y; lg[q * 4 + 2] += hv * w.z; lg[q * 4 + 3] += hv * w.w; } } }
#pragma unroll
    for (int e = 0; e < 16; ++e) lg[e] = wave_sum(lg[e]);
    if (lane == 0) {
      float sc[16], sel[16];
#pragma unroll
      for (int e = 0; e < 16; ++e) { sc[e] = 1.f / (1.f + expf(-lg[e])); sel[e] = sc[e] + f.p.router_b[e]; }
      int best = 0; float bests = -1e30f;
#pragma unroll
      for (int g = 0; g < 4; ++g) { float m1 = -1e30f, m2 = -1e30f;
#pragma unroll
        for (int i = 0; i < 4; ++i) { const float x = sel[g * 4 + i]; if (x > m1) { m2 = m1; m1 = x; } else if (x > m2) m2 = x; }
        if (m1 + m2 > bests) { bests = m1 + m2; best = g; } }
      int i0 = 0, i1 = 0; float v0 = -1e30f, v1 = -1e30f, s0 = 0.f, s1 = 0.f;
#pragma unroll
      for (int e = 0; e < 16; ++e) if ((e >> 2) == best) { const float x = sel[e];
        if (x > v0) { v1 = v0; i1 = i0; s1 = s0; v0 = x; i0 = e; s0 = sc[e]; } else if (x > v1) { v1 = x; i1 = e; s1 = sc[e]; } }
      const float sum = s0 + s1;
      const int p0 = atomicAdd(f.cnt + i0, 1), p1 = atomicAdd(f.cnt + i1, 1);
      f.list[(size_t)i0 * FT + p0] = t; f.list[(size_t)i1 * FT + p1] = t;
      f.tok_e[t * 2] = i0; f.tok_e[t * 2 + 1] = i1; f.tok_pos[t * 2] = p0; f.tok_pos[t * 2 + 1] = p1; f.tok_w[t * 2] = s0 / sum; f.tok_w[t * 2 + 1] = s1 / sum;
    }
  }
}
struct ARowGather { const bf16_t* base; const int* lst; int n; __device__ const bf16_t* operator()(int m) const { const int mm = m < n ? m : n - 1; return base + (size_t)lst[mm] * FD; } };
struct ARowAct { const bf16_t* base; int n; __device__ const bf16_t* operator()(int m) const { const int mm = m < n ? m : n - 1; return base + (size_t)mm * 512; } };
struct EpiGU { bf16_t* act; int n;
  __device__ void operator()(const f32x4 (&acc)[4][4], int mb, int nb, int lane) const {
    const int fr = lane & 15, fg = lane >> 4; const int jg = nb >> 6;
#pragma unroll
    for (int mt = 0; mt < 4; ++mt) { const int m = mb + mt * 16 + fr; if (m < n) {
#pragma unroll
      for (int nt = 0; nt < 2; ++nt) { const f32x4 g = acc[mt][nt], u = acc[mt][nt + 2]; u32x2 o; o.x = pk2(fsilu(g.x) * u.x, fsilu(g.y) * u.y); o.y = pk2(fsilu(g.z) * u.z, fsilu(g.w) * u.w);
        *(u32x2*)(act + (size_t)m * 512 + jg * 32 + nt * 16 + fg * 4) = o; } } }
  } };
struct EpiDown { bf16_t* y; int n;
  __device__ void operator()(const f32x4 (&acc)[4][4], int mb, int nb, int lane) const {
    const int fr = lane & 15, fg = lane >> 4;
#pragma unroll
    for (int mt = 0; mt < 4; ++mt) { const int m = mb + mt * 16 + fr; if (m < n) {
#pragma unroll
      for (int nt = 0; nt < 4; ++nt) { const f32x4 a = acc[mt][nt]; u32x2 o; o.x = pk2(a.x, a.y); o.y = pk2(a.z, a.w); *(u32x2*)(y + (size_t)m * FD + nb + nt * 16 + fg * 4) = o; } } }
  } };
template <int WHICH>
__device__ __forceinline__ void ph_moe_gemm(const FP& f, char* lds) {
  int tbase = 0, offe = 0;
#pragma unroll 1
  for (int e = 0; e < 16; ++e) {
    const int n = f.cnt[e]; const int ntm = (n + 255) >> 8, ntile = ntm * 8;
    int first = (int)blockIdx.x - (tbase % (int)gridDim.x); if (first < 0) first += gridDim.x;
    for (int q = first; q < ntile; q += gridDim.x) {
      const int tm = q >> 3, tn = q & 7;
      if (WHICH == 0) { ARowGather ar{f.hb, f.list + (size_t)e * FT, n}; EpiGU ep{f.act + (size_t)offe * 512, n}; gemm_tile<4, 2>(ar, f.moe_gu + (size_t)e * FD * FD, FD, FD, tm * 256, tn * 128, lds, ep); }
      else { ARowAct ar{f.act + (size_t)offe * 512, n}; EpiDown ep{f.ymoe + (size_t)offe * FD, n}; gemm_tile<4, 2>(ar, f.moe_d + (size_t)e * FD * 512, 512, 512, tm * 256, tn * 128, lds, ep); }
    }
    tbase += ntile; offe += n;
  }
}
__device__ __forceinline__ void ph_moe_combine(const FP& f, int layer) {
  const int lane = threadIdx.x & 63, gw = blockIdx.x * (NT / 64) + (threadIdx.x >> 6), ngw = gridDim.x * (NT / 64);
  int off[17]; off[0] = 0;
#pragma unroll
  for (int e = 0; e < 16; ++e) off[e + 1] = off[e] + f.cnt[e];
  for (int t = gw; t < FT; t += ngw) {
    const int b = t / FS, s = t - b * FS; if (layer == 1 && s < FLC) continue;
    const int e0 = f.tok_e[t * 2], e1 = f.tok_e[t * 2 + 1]; int o0 = 0, o1 = 0;
#pragma unroll
    for (int e = 0; e < 16; ++e) { o0 = e == e0 ? off[e] : o0; o1 = e == e1 ? off[e] : o1; }
    const bf16_t* y0 = f.ymoe + (size_t)(o0 + f.tok_pos[t * 2]) * FD; const bf16_t* y1 = f.ymoe + (size_t)(o1 + f.tok_pos[t * 2 + 1]) * FD;
    const float w0 = f.tok_w[t * 2], w1 = f.tok_w[t * 2 + 1]; float* xr = f_xs_row(f, t); const float* md = f_modrow(f, layer, t) + 5 * FD;
#pragma unroll
    for (int j = 0; j < 4; ++j) { const int c = j * 256 + lane * 4; const u32x2 a = *(const u32x2*)(y0 + c), bq = *(const u32x2*)(y1 + c); f32x4 x = *(f32x4*)(xr + c); const f32x4 g = *(const f32x4*)(md + c);
      x.x += g.x * (w0 * bflo(a.x) + w1 * bflo(bq.x)); x.y += g.y * (w0 * bfhi(a.x) + w1 * bfhi(bq.x)); x.z += g.z * (w0 * bflo(a.y) + w1 * bflo(bq.y)); x.w += g.w * (w0 * bfhi(a.y) + w1 * bfhi(bq.y));
      *(f32x4*)(xr + c) = x; }
  }
}
constexpr float QK_SCALE_LOG2E = 0.125f * 1.4426950408889634f;
struct EpiIn0 { const FP* f;
  __device__ void operator()(f32x4 (&acc)[4][4], int mb, int nb, int lane) const {
    const int fr = lane & 15, fg = lane >> 4; const FP& F = *f;
    if (nb >= Z0_AQ && nb < Z0_AV) {
      const bool isq = nb < Z0_AK; const float* gn = isq ? F.p.att_q_norm : F.p.att_k_norm; const float osc = isq ? QK_SCALE_LOG2E : 1.f;
      f32x4 g[4];
#pragma unroll
      for (int nt = 0; nt < 4; ++nt) g[nt] = *(const f32x4*)(gn + nt * 16 + fg * 4);
      float inv[4];
#pragma unroll
      for (int r = 0; r < 4; ++r) inv[r] = exp2f(-(float)(fg * 4 + r) * 0.8304820237218406f);
#pragma unroll
      for (int mt = 0; mt < 4; ++mt) {
        const int m = mb + mt * 16 + fr; const int b = m / FS, s = m - b * FS;
        float ss = 0.f;
#pragma unroll
        for (int nt = 0; nt < 4; ++nt) ss += acc[mt][nt].x * acc[mt][nt].x + acc[mt][nt].y * acc[mt][nt].y + acc[mt][nt].z * acc[mt][nt].z + acc[mt][nt].w * acc[mt][nt].w;
        ss += __shfl_xor(ss, 16); ss += __shfl_xor(ss, 32);
        const float ri = 1.f / sqrtf(ss * (1.f / 64.f) + 1e-6f);
#pragma unroll
        for (int nt = 0; nt < 4; ++nt) acc[mt][nt] = acc[mt][nt] * ri * g[nt];
        if (s >= FLC) {
          const int pos = s - FLC; const float prow = (float)(pos >> 6), pcol = (float)(pos & 63);
#pragma unroll
          for (int r = 0; r < 4; ++r) {
            float a = prow * inv[r], cs = __cosf(a), sn = __sinf(a); float t1 = acc[mt][0][r], t2 = acc[mt][2][r]; acc[mt][0][r] = t1 * cs - t2 * sn; acc[mt][2][r] = t1 * sn + t2 * cs;
            a = pcol * inv[r]; cs = __cosf(a); sn = __sinf(a); t1 = acc[mt][1][r]; t2 = acc[mt][3][r]; acc[mt][1][r] = t1 * cs - t2 * sn; acc[mt][3][r] = t1 * sn + t2 * cs;
          }
        }
#pragma unroll
        for (int nt = 0; nt < 4; ++nt) acc[mt][nt] = acc[mt][nt] * osc;
      }
    } else if (nb < Z0_GK) {
#pragma unroll
      for (int mt = 0; mt < 4; ++mt)
#pragma unroll
        for (int nt = 0; nt < 4; ++nt) acc[mt][nt] = acc[mt][nt] * 0.17677669529663687f;
    }
    if (nb >= Z0_AV && nb < Z0_GDEC) {
      const int kvh = (nb - Z0_AV) >> 6;
#pragma unroll
      for (int mt = 0; mt < 4; ++mt) { const int m = mb + mt * 16 + fr; const int b = m / FS, s = m - b * FS;
#pragma unroll
        for (int nt = 0; nt < 4; ++nt)
#pragma unroll
          for (int r = 0; r < 4; ++r) F.vT[((size_t)(b * 2 + kvh) * 64 + nt * 16 + fg * 4 + r) * FS + s] = f2bf(acc[mt][nt][r]); }
      return;
    }
#pragma unroll
    for (int mt = 0; mt < 4; ++mt) { bf16_t* zr = F.zf + (size_t)(mb + mt * 16 + fr) * Z0_LD + nb + fg * 4;
#pragma unroll
      for (int nt = 0; nt < 4; ++nt) { u32x2 o; o.x = pk2(acc[mt][nt].x, acc[mt][nt].y); o.y = pk2(acc[mt][nt].z, acc[mt][nt].w); *(u32x2*)(zr + nt * 16) = o; } }
  } };
__device__ __forceinline__ void ph_inproj0(const FP& f, const bf16_t* wt, int tm0, int tm1, char* lds) {
  ARowPlain ar{f.hb, FD}; EpiIn0 ep{&f}; const int ntn = Z0_LD / 128, ntiles = (tm1 - tm0) * ntn;
  for (int t = blockIdx.x; t < ntiles; t += gridDim.x) { const int tm = tm0 + t / ntn, tn = t % ntn; gemm_tile<4, 2>(ar, wt, FD, FD, tm * 256, tn * 128, lds, ep); }
}

__device__ __forceinline__ void store4(float* p, f32x4 v) { *(f32x4*)p = v; }
__device__ __forceinline__ void store4(bf16_t* p, f32x4 v) { u32x2 o; o.x = pk2(v.x, v.y); o.y = pk2(v.z, v.w); *(u32x2*)p = o; }
constexpr int ATT_LDS = 2 * 16384;
template <class OutT>
__device__ __forceinline__ void ph_attn(const FP& f, int b_lo, int b_hi, OutT* cat, int ldc, char* lds, bool rev = false) {
  const int tid = threadIdx.x, lane = tid & 63, w = tid >> 6, fr = lane & 15, fg = lane >> 4;
  const int nb_ = b_hi - b_lo; const int n_lat = nb_ * 64 * 2, n_items = n_lat + nb_ * 4 * 2;
  const int lrow = tid >> 3, lkc = tid & 7;
  for (int item = rev ? gridDim.x - 1 - blockIdx.x : blockIdx.x; item < n_items; item += gridDim.x) {
    int b, kvh, q0; bool is_ctx = false;
    if (item < n_lat) { b = b_lo + item / 128; const int r = item % 128; q0 = (r >> 1) * 64; kvh = r & 1; } else { const int r = item - n_lat; is_ctx = true; b = b_lo + r / 8; q0 = ((r % 8) >> 1) * 64; kvh = r & 1; }
    const int hq = kvh * 4 + (w & 3); const int qw = q0 + 32 * (w >> 2); const int tq0 = b * FS + (is_ctx ? 0 : FLC) + qw;
    bf16x8 qf[2][2];
#pragma unroll
    for (int qt = 0; qt < 2; ++qt)
#pragma unroll
      for (int kh = 0; kh < 2; ++kh) qf[qt][kh] = *(const bf16x8*)(f.zf + (size_t)(tq0 + qt * 16 + fr) * Z0_LD + Z0_AQ + hq * 64 + kh * 32 + fg * 8);
    f32x4 ot[4][2];
#pragma unroll
    for (int i = 0; i < 4; ++i)
#pragma unroll
      for (int j = 0; j < 2; ++j) ot[i][j] = (f32x4){0.f, 0.f, 0.f, 0.f};
    const float sinkl = f.p.att_sink[hq] * 1.4426950408889634f;
    float mrow[2], lsum[2];
#pragma unroll
    for (int qt = 0; qt < 2; ++qt) { mrow[qt] = sinkl; lsum[qt] = fg == 0 ? 1.f : 0.f; }
    u32x4 rk, rv;
    auto tile_valid = [&](int i) -> bool { if (i >= 5) return true; if (is_ctx) return false; const int k0 = q0 - 128 + 64 * i; return k0 >= 0 && k0 < FL; };
    auto tile_tok0 = [&](int i) -> int { return i >= 5 ? 64 * (i - 5) : FLC + q0 - 128 + 64 * i; };
    auto issue = [&](int i) { const int s0 = tile_tok0(i);
      rk = *(const u32x4*)(f.zf + (size_t)(b * FS + s0 + lrow) * Z0_LD + Z0_AK + kvh * 64 + lkc * 8);
      rv = *(const u32x4*)(f.vT + ((size_t)(b * 2 + kvh) * 64 + lrow) * FS + s0 + lkc * 8); };
    auto commit = [&](int buf) { char* kb = lds + buf * 16384; char* vb = kb + 8192;
      *(u32x4*)(kb + lrow * 128 + ((lkc ^ (lrow & 7)) << 4)) = rk;
      *(u32x4*)(vb + lrow * 128 + (((2 * lkc) ^ (lrow & 14)) << 3)) = rv; };
    int ifirst = 0; while (!tile_valid(ifirst)) ++ifirst;
    __syncthreads();
    issue(ifirst); commit(0);
    __syncthreads();
    int cur = 0;
#pragma unroll 1
    for (int i = ifirst; i < 9; ++i) {
      if (!tile_valid(i)) continue;
      int inext = i + 1; while (inext < 9 && !tile_valid(inext)) ++inext;
      if (inext < 9) issue(inext);
      {
        const char* kb = lds + cur * 16384; const char* vb = kb + 8192;
        f32x4 st[4][2];
#pragma unroll
        for (int a = 0; a < 4; ++a)
#pragma unroll
          for (int c = 0; c < 2; ++c) st[a][c] = (f32x4){0.f, 0.f, 0.f, 0.f};
#pragma unroll
        for (int kh = 0; kh < 2; ++kh) {
          bf16x8 kf[4];
#pragma unroll
          for (int kt = 0; kt < 4; ++kt) { const int row = kt * 16 + fr; kf[kt] = *(const bf16x8*)(kb + row * 128 + (((kh * 4 + fg) ^ (row & 7)) << 4)); }
#pragma unroll
          for (int kt = 0; kt < 4; ++kt)
#pragma unroll
            for (int c = 0; c < 2; ++c) st[kt][c] = __builtin_amdgcn_mfma_f32_16x16x32_bf16(kf[kt], qf[c][kh], st[kt][c], 0, 0, 0);
        }
        if (i < 5) {
          const int k0 = q0 - 128 + 64 * i;
#pragma unroll
          for (int kt = 0; kt < 4; ++kt)
#pragma unroll
            for (int c = 0; c < 2; ++c)
#pragma unroll
              for (int r = 0; r < 4; ++r) { const int dk = (k0 + kt * 16 + fg * 4 + r) - (qw + c * 16 + fr); if (dk > 128 || dk < -128) st[kt][c][r] = -1e30f; }
        }
        bf16x8 pf[2][2];
#pragma unroll
        for (int c = 0; c < 2; ++c) {
          float mx = mrow[c];
#pragma unroll
          for (int kt = 0; kt < 4; ++kt) mx = fmaxf(mx, fmaxf(fmaxf(st[kt][c].x, st[kt][c].y), fmaxf(st[kt][c].z, st[kt][c].w)));
          mx = fmaxf(mx, __shfl_xor(mx, 16)); mx = fmaxf(mx, __shfl_xor(mx, 32));
          const float alpha = exp2f(mrow[c] - mx); mrow[c] = mx; float ps = 0.f;
#pragma unroll
          for (int kt = 0; kt < 4; ++kt) { f32x4 p; p.x = exp2f(st[kt][c].x - mx); p.y = exp2f(st[kt][c].y - mx); p.z = exp2f(st[kt][c].z - mx); p.w = exp2f(st[kt][c].w - mx); ps += (p.x + p.y) + (p.z + p.w); st[kt][c] = p; }
          lsum[c] = lsum[c] * alpha + ps;
#pragma unroll
          for (int nt = 0; nt < 4; ++nt) ot[nt][c] = ot[nt][c] * alpha;
#pragma unroll
          for (int ks = 0; ks < 2; ++ks) { u32x4 u; u.x = pk2(st[2 * ks][c].x, st[2 * ks][c].y); u.y = pk2(st[2 * ks][c].z, st[2 * ks][c].w); u.z = pk2(st[2 * ks + 1][c].x, st[2 * ks + 1][c].y); u.w = pk2(st[2 * ks + 1][c].z, st[2 * ks + 1][c].w); pf[c][ks] = __builtin_bit_cast(bf16x8, u); }
        }
#pragma unroll
        for (int ks = 0; ks < 2; ++ks) {
          bf16x8 vf[4];
#pragma unroll
          for (int nt = 0; nt < 4; ++nt) { const int row = nt * 16 + fr; const char* rp = vb + row * 128; const int c0 = (8 * ks + fg) ^ (row & 14), c1 = (8 * ks + 4 + fg) ^ (row & 14);
            const u32x2 lo = *(const u32x2*)(rp + (c0 << 3)), hi = *(const u32x2*)(rp + (c1 << 3)); u32x4 u; u.x = lo.x; u.y = lo.y; u.z = hi.x; u.w = hi.y; vf[nt] = __builtin_bit_cast(bf16x8, u); }
#pragma unroll
          for (int nt = 0; nt < 4; ++nt)
#pragma unroll
            for (int c = 0; c < 2; ++c) ot[nt][c] = __builtin_amdgcn_mfma_f32_16x16x32_bf16(vf[nt], pf[c][ks], ot[nt][c], 0, 0, 0);
        }
      }
      if (inext < 9) commit(cur ^ 1);
      __syncthreads();
      cur ^= 1;
    }
#pragma unroll
    for (int c = 0; c < 2; ++c) { float l = lsum[c]; l += __shfl_xor(l, 16); l += __shfl_xor(l, 32); const float il = 1.f / l;
      OutT* dst = cat + (size_t)(tq0 + c * 16 + fr) * ldc + 512 + hq * 64 + fg * 4;
#pragma unroll
      for (int nt = 0; nt < 4; ++nt) store4(dst + nt * 16, ot[nt][c] * il); }
  }
}
__device__ __forceinline__ float flogsigm(float x) { return x < 0.f ? x - __logf(1.f + __expf(x)) : -__logf(1.f + __expf(-x)); }
constexpr int GLA_A_LDS = 2 * 64 * 33 * 4 + 64 * 65 * 4;
__device__ __forceinline__ void ph_gla_a(const FP& f, int b_lo, int b_hi, char* lds) {
  float* kbar = (float*)lds; float* vl = kbar + 2 * 64 * 33;
  const int tid = threadIdx.x; const int nitems = (b_hi - b_lo) * 8 * 68;
  for (int item = blockIdx.x; item < nitems; item += gridDim.x) {
    const int b = b_lo + item / (8 * 68), h = (item / 68) % 8, c = item % 68; const int t0 = b * FS + c * 64;
    __syncthreads();
    { const int dir = tid >> 8, d = (tid >> 3) & 31, tg = tid & 7;
      float wv[16];
#pragma unroll
      for (int r = 0; r < 16; ++r) wv[r] = f.p.gla_dec_w[(dir * 16 + r) * 256 + h * 32 + d];
      const float bias = f.p.gla_dec_b[dir * 256 + h * 32 + d];
      float la[8];
#pragma unroll
      for (int i = 0; i < 8; ++i) { const bf16_t* zd = f.zf + (size_t)(t0 + tg * 8 + i) * Z0_LD + Z0_GDEC + dir * 16; const u32x4 u0 = *(const u32x4*)zd, u1 = *(const u32x4*)(zd + 8);
        float a = bias; a += bflo(u0.x) * wv[0] + bfhi(u0.x) * wv[1] + bflo(u0.y) * wv[2] + bfhi(u0.y) * wv[3] + bflo(u0.z) * wv[4] + bfhi(u0.z) * wv[5] + bflo(u0.w) * wv[6] + bfhi(u0.w) * wv[7];
        a += bflo(u1.x) * wv[8] + bfhi(u1.x) * wv[9] + bflo(u1.y) * wv[10] + bfhi(u1.y) * wv[11] + bflo(u1.z) * wv[12] + bfhi(u1.z) * wv[13] + bflo(u1.w) * wv[14] + bfhi(u1.w) * wv[15];
        la[i] = flogsigm(a) * (1.f / 16.f); }
      float tot = 0.f;
      if (dir == 0) {
#pragma unroll
        for (int i = 0; i < 8; ++i) { tot += la[i]; la[i] = tot; }
      } else {
#pragma unroll
        for (int i = 7; i >= 0; --i) { tot += la[i]; la[i] = tot; }
      }
      float pre = 0.f;
      const int lb = (tid & 63) & ~7;
#pragma unroll
      for (int o = 1; o < 8; ++o) { const float v = __shfl(tot, lb | ((tg + (dir == 0 ? -o : o)) & 7)); const bool take = dir == 0 ? (tg - o >= 0) : (tg + o <= 7); pre += take ? v : 0.f; }
      float full = pre + tot;
      const float bC = __shfl(full, lb | (dir == 0 ? 7 : 0));
#pragma unroll
      for (int i = 0; i < 8; ++i) { const int t = tg * 8 + i; const float bb = la[i] + pre; f.gla_b[((size_t)(t0 + t) * 2 + dir) * 256 + h * 32 + d] = bb;
        const float kv = bf2f(f.zf[(size_t)(t0 + t) * Z0_LD + Z0_GK + h * 32 + d]); kbar[(dir * 64 + t) * 33 + d] = kv * __expf(bC - bb); }
      if (tg == 0) f.gla_dec[((size_t)((b * 8 + h) * 2 + dir) * 68 + c) * 32 + d] = bC;
    }
    { const int t = tid >> 3, e8 = (tid & 7) * 8; const u32x4 u = *(const u32x4*)(f.zf + (size_t)(t0 + t) * Z0_LD + Z0_GV + h * 64 + e8); float* dst = vl + t * 65 + e8;
      dst[0] = bflo(u.x); dst[1] = bfhi(u.x); dst[2] = bflo(u.y); dst[3] = bfhi(u.y); dst[4] = bflo(u.z); dst[5] = bfhi(u.z); dst[6] = bflo(u.w); dst[7] = bfhi(u.w); }
    __syncthreads();
    { const int dir = tid >> 8, e = (tid >> 3) & 31, dq = tid & 7;
      float a0[4] = {0.f, 0.f, 0.f, 0.f}, a1[4] = {0.f, 0.f, 0.f, 0.f};
      for (int t = 0; t < 64; ++t) { const float v0 = vl[t * 65 + e], v1 = vl[t * 65 + e + 32]; const float* kb = kbar + (dir * 64 + t) * 33 + dq * 4;
#pragma unroll
        for (int j = 0; j < 4; ++j) { a0[j] += kb[j] * v0; a1[j] += kb[j] * v1; } }
      float* dst = f.gla_s + ((size_t)((b * 8 + h) * 2 + dir) * 68 + c) * 2048;
      *(f32x4*)(dst + e * 32 + dq * 4) = (f32x4){a0[0], a0[1], a0[2], a0[3]}; *(f32x4*)(dst + (e + 32) * 32 + dq * 4) = (f32x4){a1[0], a1[1], a1[2], a1[3]}; }
  }
}
__device__ __forceinline__ void ph_gla_b(const FP& f, int b_lo, int b_hi) {
  const int n = (b_hi - b_lo) * 8 * 2 * 2048;
  for (int i = blockIdx.x * NT + threadIdx.x; i < n; i += gridDim.x * NT) {
    const int el = i & 2047, seq = i >> 11; const int dir = seq & 1, h = (seq >> 1) & 7, b = b_lo + (seq >> 4); const int d = el & 31;
    float* sb = f.gla_s + (size_t)((b * 8 + h) * 2 + dir) * 68 * 2048 + el; const float* db = f.gla_dec + (size_t)((b * 8 + h) * 2 + dir) * 68 * 32 + d;
    float S = 0.f;
#pragma unroll 4
    for (int step = 0; step < 68; ++step) { const int c = dir == 0 ? step : (step < 4 ? 3 - step : 71 - step); const float kv = sb[(size_t)c * 2048]; const float dc = db[c * 32]; sb[(size_t)c * 2048] = S; S = __expf(dc) * S + kv; }
  }
}
constexpr int GLA_C_LDS = 2 * 4096 * 2 + 8192 + 512;
template <class OutT>
__device__ __forceinline__ void ph_gla_c(const FP& f, int b_lo, int b_hi, OutT* cat, int ldc, char* lds) {
  bf16_t* qtl = (bf16_t*)lds; bf16_t* khl = qtl + 2 * 2048; char* vtl = lds + 16384; float* ssq = (float*)(lds + 16384 + 8192);
  const int tid = threadIdx.x, lane = tid & 63, w = tid >> 6, fr = lane & 15, fg = lane >> 4, it = w & 3, eh = w >> 2;
  const int nitems = (b_hi - b_lo) * 8 * 68;
  for (int item = blockIdx.x; item < nitems; item += gridDim.x) {
    const int b = b_lo + item / (8 * 68), h = (item / 68) % 8, c = item % 68; const int t0 = b * FS + c * 64;
    __syncthreads();
    { const int t = tid >> 3, d4 = (tid & 7) * 4; const bf16_t* zr = f.zf + (size_t)(t0 + t) * Z0_LD; const u32x2 qu = *(const u32x2*)(zr + Z0_GQ + h * 32 + d4), ku = *(const u32x2*)(zr + Z0_GK + h * 32 + d4);
      const float q[4] = {bflo(qu.x), bfhi(qu.x), bflo(qu.y), bfhi(qu.y)}, k[4] = {bflo(ku.x), bfhi(ku.x), bflo(ku.y), bfhi(ku.y)};
#pragma unroll
      for (int dir = 0; dir < 2; ++dir) { const f32x4 bb = *(const f32x4*)(f.gla_b + ((size_t)(t0 + t) * 2 + dir) * 256 + h * 32 + d4);
        u32x2 qo, ko; qo.x = pk2(q[0] * __expf(bb.x), q[1] * __expf(bb.y)); qo.y = pk2(q[2] * __expf(bb.z), q[3] * __expf(bb.w)); ko.x = pk2(k[0] * __expf(-bb.x), k[1] * __expf(-bb.y)); ko.y = pk2(k[2] * __expf(-bb.z), k[3] * __expf(-bb.w));
        *(u32x2*)(qtl + dir * 2048 + t * 32 + d4) = qo; *(u32x2*)(khl + dir * 2048 + t * 32 + d4) = ko; } }
    { const int t = tid >> 3, e8 = (tid & 7) * 8; const u32x4 u = *(const u32x4*)(f.zf + (size_t)(t0 + t) * Z0_LD + Z0_GV + h * 64 + e8); const unsigned uu[4] = {u.x, u.y, u.z, u.w};
#pragma unroll
      for (int j = 0; j < 8; ++j) { const int e = e8 + j; const bf16_t val = (bf16_t)((j & 1) ? (uu[j >> 1] >> 16) : (uu[j >> 1] & 0xffffu)); *(bf16_t*)(vtl + e * 128 + ((((t >> 2) ^ (e & 14)) << 3) | ((t & 3) << 1))) = val; } }
    __syncthreads();
    f32x4 ot[2]; ot[0] = (f32x4){0.f, 0.f, 0.f, 0.f}; ot[1] = ot[0];
#pragma unroll
    for (int dir = 0; dir < 2; ++dir) {
      const bf16x8 qfr = *(const bf16x8*)(qtl + dir * 2048 + (it * 16 + fr) * 32 + fg * 8);
      f32x4 st[4];
#pragma unroll
      for (int jt = 0; jt < 4; ++jt) { const bf16x8 kfr = *(const bf16x8*)(khl + dir * 2048 + (jt * 16 + fr) * 32 + fg * 8); st[jt] = __builtin_amdgcn_mfma_f32_16x16x32_bf16(kfr, qfr, (f32x4){0.f, 0.f, 0.f, 0.f}, 0, 0, 0); }
#pragma unroll
      for (int jt = 0; jt < 4; ++jt)
#pragma unroll
        for (int r = 0; r < 4; ++r) { const int j = jt * 16 + fg * 4 + r, i = it * 16 + fr; const bool keep = dir == 0 ? (j <= i) : (j >= i); if (!keep) st[jt][r] = 0.f; }
      bf16x8 pf[2];
#pragma unroll
      for (int ks = 0; ks < 2; ++ks) { u32x4 u; u.x = pk2(st[2 * ks].x, st[2 * ks].y); u.y = pk2(st[2 * ks].z, st[2 * ks].w); u.z = pk2(st[2 * ks + 1].x, st[2 * ks + 1].y); u.w = pk2(st[2 * ks + 1].z, st[2 * ks + 1].w); pf[ks] = __builtin_bit_cast(bf16x8, u); }
      const float* Sg = f.gla_s + ((size_t)((b * 8 + h) * 2 + dir) * 68 + c) * 2048;
#pragma unroll
      for (int n2 = 0; n2 < 2; ++n2) { const int row = (eh * 2 + n2) * 16 + fr;
#pragma unroll
        for (int ks = 0; ks < 2; ++ks) { const char* rp = vtl + row * 128; const int c0 = (8 * ks + fg) ^ (row & 14), c1 = (8 * ks + 4 + fg) ^ (row & 14);
          const u32x2 lo = *(const u32x2*)(rp + (c0 << 3)), hi = *(const u32x2*)(rp + (c1 << 3)); u32x4 u; u.x = lo.x; u.y = lo.y; u.z = hi.x; u.w = hi.y;
          ot[n2] = __builtin_amdgcn_mfma_f32_16x16x32_bf16(__builtin_bit_cast(bf16x8, u), pf[ks], ot[n2], 0, 0, 0); }
        const f32x4 s0 = *(const f32x4*)(Sg + row * 32 + fg * 8), s1 = *(const f32x4*)(Sg + row * 32 + fg * 8 + 4); u32x4 su; su.x = pk2(s0.x, s0.y); su.y = pk2(s0.z, s0.w); su.z = pk2(s1.x, s1.y); su.w = pk2(s1.z, s1.w);
        ot[n2] = __builtin_amdgcn_mfma_f32_16x16x32_bf16(__builtin_bit_cast(bf16x8, su), qfr, ot[n2], 0, 0, 0); }
    }
    float ss = 0.f;
#pragma unroll
    for (int n2 = 0; n2 < 2; ++n2) ss += ot[n2].x * ot[n2].x + ot[n2].y * ot[n2].y + ot[n2].z * ot[n2].z + ot[n2].w * ot[n2].w;
    ss += __shfl_xor(ss, 16); ss += __shfl_xor(ss, 32);
    if (fg == 0) ssq[eh * 64 + it * 16 + fr] = ss;
    __syncthreads();
    const float ri = 1.f / sqrtf((ssq[it * 16 + fr] + ssq[64 + it * 16 + fr]) * (1.f / 64.f) + 1e-6f);
    const int t = t0 + it * 16 + fr;
#pragma unroll
    for (int n2 = 0; n2 < 2; ++n2) { const int e = (eh * 2 + n2) * 16 + fg * 4; const u32x2 gu = *(const u32x2*)(f.zf + (size_t)t * Z0_LD + Z0_GG + h * 64 + e); const f32x4 gn = *(const f32x4*)(f.p.gla_out_norm + e);
      f32x4 o = ot[n2] * ri * gn; o.x *= fsilu(bflo(gu.x)); o.y *= fsilu(bfhi(gu.x)); o.z *= fsilu(bflo(gu.y)); o.w *= fsilu(bfhi(gu.y));
      store4(cat + (size_t)t * ldc + h * 64 + e, o); }
  }
}
struct RW {
  const bf16_t* z; int b_lo, b_hi;
  const bf16_t *w2T, *a2T, *g2T;
  bf16_t *M, *N, *R2, *Y0;
  const float *mu, *w0, *a0, *kk_scale, *k_a, *r_k, *ln_g, *ln_b;
};
constexpr int RC_R = 256, RC_K = 1024, RC_V = 1792, RC_ZW = 2560, RC_ZA = 2688, RC_ZG = 2816;
__device__ __forceinline__ int rw_q(int b, int h, int dir, int c) { return ((b * 12 + h) * 2 + dir) * 68 + c; }
__device__ __forceinline__ float fsoftplus(float x) { return x > 0.f ? x + __logf(1.f + __expf(-x)) : __logf(1.f + __expf(x)); }
__device__ __forceinline__ float zsm1(const RW& a, int tk, int col, bool hp, bool hn) {
  const bf16_t* p = a.z + (size_t)tk * Z1_LD + col; const float zc = bf2f(p[0]), pv = hp ? bf2f(p[-Z1_LD]) : 0.f, nx = hn ? bf2f(p[Z1_LD]) : 0.f;
  return zc + a.mu[col - 256] * (0.5f * (pv + nx) - zc);
}
__device__ __forceinline__ void zsm8(const RW& a, int tk, int col, bool hp, bool hn, float (&o)[8]) {
  const bf16_t* p = a.z + (size_t)tk * Z1_LD + col; const u32x4 c = *(const u32x4*)p; u32x4 pv = {0u, 0u, 0u, 0u}, nx = {0u, 0u, 0u, 0u};
  if (hp) pv = *(const u32x4*)(p - Z1_LD); if (hn) nx = *(const u32x4*)(p + Z1_LD);
  const f32x4 m0 = *(const f32x4*)(a.mu + col - 256), m1 = *(const f32x4*)(a.mu + col - 256 + 4);
  const unsigned cc[4] = {c.x, c.y, c.z, c.w}, pp[4] = {pv.x, pv.y, pv.z, pv.w}, nn[4] = {nx.x, nx.y, nx.z, nx.w}; const float mm[8] = {m0.x, m0.y, m0.z, m0.w, m1.x, m1.y, m1.z, m1.w};
#pragma unroll
  for (int j = 0; j < 4; ++j) { float zc = bflo(cc[j]); o[2 * j] = zc + mm[2 * j] * (0.5f * (bflo(pp[j]) + bflo(nn[j])) - zc); zc = bfhi(cc[j]); o[2 * j + 1] = zc + mm[2 * j + 1] * (0.5f * (bfhi(pp[j]) + bfhi(nn[j])) - zc); }
}
__device__ __forceinline__ bf16x8 pack8(const float (&v)[8]) { u32x4 u; u.x = pk2(v[0], v[1]); u.y = pk2(v[2], v[3]); u.z = pk2(v[4], v[5]); u.w = pk2(v[6], v[7]); return __builtin_bit_cast(bf16x8, u); }
#define MFMA16(a, b, c) __builtin_amdgcn_mfma_f32_16x16x32_bf16(a, b, c, 0, 0, 0)

constexpr int R1_PW = 0, R1_PA = 16384, R1_LP = 0, R1_XF = 16384;
constexpr int R1_KT = 32768, R1_BH = R1_KT + 8192, R1_KH = R1_BH + 8192, R1_RT = R1_KH + 8192;
constexpr int R1_BBT = R1_RT + 8192, R1_KBT = R1_BBT + 8192, R1_VT = R1_KBT + 8192;
constexpr int R1_AAK = R1_VT + 8192, R1_ARB = R1_AAK + 8192, R1_ARK = R1_ARB + 8192;
constexpr int R1_WT = R1_ARK + 8192, R1_U0T = R1_WT + 8192;
constexpr int R1_MISC = R1_U0T + 8192;
constexpr int R1_LDS = R1_MISC + (8 * 64 + 64 + 64) * 4;
__device__ __forceinline__ bf16x8 ldfrag(const char* base, int rt, int ks, int fr, int fg) { return *(const bf16x8*)(base + (rt * 16 + fr) * 128 + ks * 64 + fg * 16); }

__device__ __forceinline__ void ph_rwkv1(const RW& a, int b_lo, int b_hi, char* lds) {
  const int tid = threadIdx.x, lane = tid & 63, w = tid >> 6, fr = lane & 15, fg = lane >> 4;
  float* pw = (float*)(lds + R1_PW); float* pa = (float*)(lds + R1_PA); float* Lp = (float*)(lds + R1_LP); float* Xf = (float*)(lds + R1_XF);
  float* segsum = (float*)(lds + R1_MISC); float* gC = segsum + 512; float* bon = gC + 64;
  const int nitems = (b_hi - b_lo) * 12 * 2 * 68; const int q_lo = rw_q(b_lo, 0, 0, 0);
  for (int item = blockIdx.x; item < nitems; item += gridDim.x) {
    const int b = b_lo + item / (12 * 2 * 68), h = (item / (2 * 68)) % 12, dir = (item / 68) & 1, c = item % 68; const int t0 = b * FS + c * 64;
    const size_t qo = (size_t)(rw_q(b, h, dir, c) - q_lo) * 4096;
    const bool first_chunk = (c == 0 || c == 4), last_chunk = (c == 3 || c == 67);
    __syncthreads();
    { const int mat = w >> 2, mt = w & 3; const int i = mt * 16 + fr; const int ti = dir ? 63 - i : i; const int tk = t0 + ti; const bool hp = !(first_chunk && ti == 0), hn = !(last_chunk && ti == 63);
      bf16x8 af[2];
#pragma unroll
      for (int ks = 0; ks < 2; ++ks) { float v[8]; zsm8(a, tk, (mat ? RC_ZA : RC_ZW) + dir * 64 + ks * 32 + fg * 8, hp, hn, v); if (!mat) {
#pragma unroll
          for (int j = 0; j < 8; ++j) v[j] = tanhf(v[j]); }
        af[ks] = pack8(v); }
      const bf16_t* WT = (mat ? a.a2T : a.w2T) + ((size_t)dir * 768 + h * 64) * 64; float* dst = mat ? pa : pw;
#pragma unroll
      for (int nt = 0; nt < 4; ++nt) { f32x4 acc = {0.f, 0.f, 0.f, 0.f};
#pragma unroll
        for (int ks = 0; ks < 2; ++ks) { const bf16x8 bfr = *(const bf16x8*)(WT + (size_t)(nt * 16 + fr) * 64 + ks * 32 + fg * 8); acc = MFMA16(af[ks], bfr, acc); }
        *(f32x4*)(dst + (nt * 16 + fr) * 64 + mt * 16 + fg * 4) = acc; }
    }
    __syncthreads();
    { const int k = lane, ch = h * 64 + k;
      const float w0 = a.w0[dir * 768 + ch], a0 = a.a0[dir * 768 + ch], kks = a.kk_scale[ch], ka = a.k_a[ch], rk = a.r_k[ch];
      float rr[8], kd[8], kap[8], bet[8], vv[8], lw[8];
#pragma unroll
      for (int ii = 0; ii < 8; ++ii) { const int i = 8 * w + ii; const int ti = dir ? 63 - i : i; const int tk = t0 + ti; const bool hp = !(first_chunk && ti == 0), hn = !(last_chunk && ti == 63);
        const float r = zsm1(a, tk, RC_R + ch, hp, hn), kx = zsm1(a, tk, RC_K + ch, hp, hn), v = zsm1(a, tk, RC_V + ch, hp, hn);
        const float aw = w0 + pw[k * 64 + i]; const float wl = -fsoftplus(-aw) - 0.5f; lw[ii] = -__expf(wl);
        const float av = fsigm(a0 + pa[k * 64 + i]); kd[ii] = kx * (1.f + (av - 1.f) * ka);
        const float ks_ = kx * kks; const float nrm = wave_sum(ks_ * ks_); kap[ii] = ks_ / sqrtf(nrm + 1e-12f); bet[ii] = kap[ii] * av; rr[ii] = r; vv[ii] = v;
        const float bn = wave_sum(r * kd[ii] * rk); if (lane == 0) bon[i] = bn; }
      float cl[8]; float run = 0.f;
#pragma unroll
      for (int ii = 0; ii < 8; ++ii) { run += lw[ii]; cl[ii] = run; }
      segsum[w * 64 + k] = run;
      __syncthreads();
      float pre = 0.f, total = 0.f;
#pragma unroll
      for (int s = 0; s < 8; ++s) { const float v = segsum[s * 64 + k]; total += v; pre += s < w ? v : 0.f; }
      if (w == 0) gC[k] = __expf(total);
      float bb8[8], kb8[8];
#pragma unroll
      for (int ii = 0; ii < 8; ++ii) { const int i = 8 * w + ii; const float cum = pre + cl[ii], cumprev = cum - lw[ii]; const float eneg = __expf(-cum);
        *(bf16_t*)(lds + R1_KT + i * 128 + k * 2) = f2bf(kap[ii] * __expf(cumprev)); *(bf16_t*)(lds + R1_BH + i * 128 + k * 2) = f2bf(bet[ii] * eneg);
        *(bf16_t*)(lds + R1_KH + i * 128 + k * 2) = f2bf(kd[ii] * eneg); *(bf16_t*)(lds + R1_RT + i * 128 + k * 2) = f2bf(rr[ii] * __expf(cum));
        const float etc = __expf(total - cum); bb8[ii] = bet[ii] * etc; kb8[ii] = kd[ii] * etc; }
      *(bf16x8*)(lds + R1_BBT + k * 128 + w * 16) = pack8(bb8); *(bf16x8*)(lds + R1_KBT + k * 128 + w * 16) = pack8(kb8); *(bf16x8*)(lds + R1_VT + k * 128 + w * 16) = pack8(vv);
    }
    __syncthreads();
    { const int it = w & 3, half = w >> 2; const char* Xb = lds + (half ? R1_RT : R1_KT);
      const bf16x8 x0 = ldfrag(Xb, it, 0, fr, fg), x1 = ldfrag(Xb, it, 1, fr, fg); const int i = it * 16 + fr;
#pragma unroll
      for (int jt = 0; jt < 4; ++jt) {
        f32x4 d0 = {0.f, 0.f, 0.f, 0.f}, d1 = {0.f, 0.f, 0.f, 0.f};
        d0 = MFMA16(ldfrag(lds + R1_BH, jt, 0, fr, fg), x0, d0); d0 = MFMA16(ldfrag(lds + R1_BH, jt, 1, fr, fg), x1, d0);
        d1 = MFMA16(ldfrag(lds + R1_KH, jt, 0, fr, fg), x0, d1); d1 = MFMA16(ldfrag(lds + R1_KH, jt, 1, fr, fg), x1, d1);
#pragma unroll
        for (int r = 0; r < 4; ++r) { const int j = jt * 16 + fg * 4 + r; const bool keep = half ? (j <= i) : (j < i); if (!keep) { d0[r] = 0.f; d1[r] = 0.f; } }
        if (half == 0) {
#pragma unroll
          for (int r = 0; r < 4; ++r) Lp[i * 64 + r * 16 + jt * 4 + fg] = d0[r];
          u32x2 o; o.x = pk2(d1.x, d1.y); o.y = pk2(d1.z, d1.w); *(u32x2*)(lds + R1_AAK + i * 128 + (jt * 16 + fg * 4) * 2) = o;
        } else {
          u32x2 o; o.x = pk2(d0.x, d0.y); o.y = pk2(d0.z, d0.w); *(u32x2*)(lds + R1_ARB + i * 128 + (jt * 16 + fg * 4) * 2) = o;
          o.x = pk2(d1.x, d1.y); o.y = pk2(d1.z, d1.w); *(u32x2*)(lds + R1_ARK + i * 128 + (jt * 16 + fg * 4) * 2) = o;
        }
      }
    }
    __syncthreads();
    { const int it = w & 3; const bf16x8 b0 = ldfrag(lds + R1_AAK, it, 0, fr, fg), b1 = ldfrag(lds + R1_AAK, it, 1, fr, fg);
#pragma unroll
      for (int q = 0; q < 2; ++q) { const int et = (w >> 2) * 2 + q; f32x4 d = {0.f, 0.f, 0.f, 0.f};
        d = MFMA16(ldfrag(lds + R1_VT, et, 0, fr, fg), b0, d); d = MFMA16(ldfrag(lds + R1_VT, et, 1, fr, fg), b1, d);
        *(f32x4*)(Xf + (it * 16 + fr) * 64 + et * 16 + fg * 4) = d; } }
    __syncthreads();
    { float s[16];
#pragma unroll
      for (int m = 0; m < 16; ++m) s[m] = 0.f;
      const int col = (w & 3) * 16 + fr;
#pragma unroll
      for (int i = 0; i < 64; ++i) {
        float part = 0.f;
#pragma unroll
        for (int m4 = 0; m4 * 16 < i; ++m4) { const f32x4 l = *(const f32x4*)(Lp + i * 64 + fg * 16 + m4 * 4); part += l.x * s[m4 * 4] + l.y * s[m4 * 4 + 1] + l.z * s[m4 * 4 + 2] + l.w * s[m4 * 4 + 3]; }
        part += __shfl_xor(part, 16); part += __shfl_xor(part, 32);
        const float rhs = w < 4 ? -bf2f(*(const bf16_t*)(lds + R1_KT + i * 128 + col * 2)) : -Xf[i * 64 + col];
        const float val = rhs - part;
        s[i >> 2] = (fg == (i & 3)) ? val : s[i >> 2];
        if ((i & 3) == 3) asm volatile("" ::: "memory");
      }
      char* dst = lds + (w < 4 ? R1_WT : R1_U0T) + col * 128;
#pragma unroll
      for (int m = 0; m < 16; ++m) *(bf16_t*)(dst + (4 * m + fg) * 2) = f2bf(s[m]);
    }
    __syncthreads();
    { const int tt = w & 3, half = w >> 2;
      if (half == 0) {
        const bf16x8 b0 = ldfrag(lds + R1_ARB, tt, 0, fr, fg), b1 = ldfrag(lds + R1_ARB, tt, 1, fr, fg); const int i = tt * 16 + fr;
#pragma unroll 1
        for (int kt = 0; kt < 4; ++kt) { f32x4 d = {0.f, 0.f, 0.f, 0.f}; d = MFMA16(ldfrag(lds + R1_WT, kt, 0, fr, fg), b0, d); d = MFMA16(ldfrag(lds + R1_WT, kt, 1, fr, fg), b1, d);
          const u32x2 ru = *(const u32x2*)(lds + R1_RT + i * 128 + (kt * 16 + fg * 4) * 2); u32x2 o; o.x = pk2(d.x + bflo(ru.x), d.y + bfhi(ru.x)); o.y = pk2(d.z + bflo(ru.y), d.w + bfhi(ru.y));
          *(u32x2*)(a.R2 + qo + i * 64 + kt * 16 + fg * 4) = o; }
        const bf16x8 c0 = ldfrag(lds + R1_BBT, tt, 0, fr, fg), c1 = ldfrag(lds + R1_BBT, tt, 1, fr, fg); const int k2 = tt * 16 + fr;
#pragma unroll 1
        for (int kt = 0; kt < 4; ++kt) { f32x4 d = {0.f, 0.f, 0.f, 0.f}; d = MFMA16(ldfrag(lds + R1_WT, kt, 0, fr, fg), c0, d); d = MFMA16(ldfrag(lds + R1_WT, kt, 1, fr, fg), c1, d);
#pragma unroll
          for (int r = 0; r < 4; ++r) { const int k1 = kt * 16 + fg * 4 + r; if (k1 == k2) d[r] += gC[k1]; }
          u32x2 o; o.x = pk2(d.x, d.y); o.y = pk2(d.z, d.w); *(u32x2*)(a.M + qo + k2 * 64 + kt * 16 + fg * 4) = o; }
      } else {
        const bf16x8 b0 = ldfrag(lds + R1_ARB, tt, 0, fr, fg), b1 = ldfrag(lds + R1_ARB, tt, 1, fr, fg), k0 = ldfrag(lds + R1_ARK, tt, 0, fr, fg), k1 = ldfrag(lds + R1_ARK, tt, 1, fr, fg); const int i = tt * 16 + fr; const float bn = bon[i];
#pragma unroll 1
        for (int et = 0; et < 4; ++et) { f32x4 d = {0.f, 0.f, 0.f, 0.f};
          d = MFMA16(ldfrag(lds + R1_U0T, et, 0, fr, fg), b0, d); d = MFMA16(ldfrag(lds + R1_U0T, et, 1, fr, fg), b1, d); d = MFMA16(ldfrag(lds + R1_VT, et, 0, fr, fg), k0, d); d = MFMA16(ldfrag(lds + R1_VT, et, 1, fr, fg), k1, d);
#pragma unroll
          for (int r = 0; r < 4; ++r) d[r] += bn * bf2f(*(const bf16_t*)(lds + R1_VT + (et * 16 + fg * 4 + r) * 128 + i * 2));
          u32x2 o; o.x = pk2(d.x, d.y); o.y = pk2(d.z, d.w); *(u32x2*)(a.Y0 + qo + i * 64 + et * 16 + fg * 4) = o; }
        const bf16x8 u0 = ldfrag(lds + R1_U0T, tt, 0, fr, fg), u1 = ldfrag(lds + R1_U0T, tt, 1, fr, fg), v0 = ldfrag(lds + R1_VT, tt, 0, fr, fg), v1 = ldfrag(lds + R1_VT, tt, 1, fr, fg); const int e = tt * 16 + fr;
#pragma unroll 1
        for (int kt = 0; kt < 4; ++kt) { f32x4 d = {0.f, 0.f, 0.f, 0.f};
          d = MFMA16(ldfrag(lds + R1_BBT, kt, 0, fr, fg), u0, d); d = MFMA16(ldfrag(lds + R1_BBT, kt, 1, fr, fg), u1, d); d = MFMA16(ldfrag(lds + R1_KBT, kt, 0, fr, fg), v0, d); d = MFMA16(ldfrag(lds + R1_KBT, kt, 1, fr, fg), v1, d);
          u32x2 o; o.x = pk2(d.x, d.y); o.y = pk2(d.z, d.w); *(u32x2*)(a.N + qo + e * 64 + kt * 16 + fg * 4) = o; }
      }
    }
  }
}
__device__ __forceinline__ void ph_rwkv2(const RW& a, int b_lo, int b_hi) {
  const int lane = threadIdx.x & 63, fr = lane & 15, fg = lane >> 4; const int gw = blockIdx.x * (NT / 64) + (threadIdx.x >> 6), ngw = gridDim.x * (NT / 64);
  const int nseq = (b_hi - b_lo) * 12 * 2; const int q_lo = rw_q(b_lo, 0, 0, 0);
  for (int wi = gw; wi < nseq * 4; wi += ngw) {
    const int eg = wi & 3, seq = wi >> 2; const int dir = seq & 1, h = (seq >> 1) % 12, b = b_lo + seq / 24; const int e = eg * 16 + fr;
    f32x4 st[4];
#pragma unroll
    for (int mt = 0; mt < 4; ++mt) st[mt] = (f32x4){0.f, 0.f, 0.f, 0.f};
#pragma unroll 1
    for (int step = 0; step < 68; ++step) {
      const int c = dir == 0 ? step : (step < 4 ? 3 - step : 71 - step); const size_t qo = (size_t)(rw_q(b, h, dir, c) - q_lo) * 4096;
      const bf16_t* Mt = a.M + qo; bf16_t* Ns = a.N + qo + e * 64;
      bf16x8 sb[2];
#pragma unroll
      for (int s = 0; s < 2; ++s) { u32x4 u; u.x = pk2(st[2 * s].x, st[2 * s].y); u.y = pk2(st[2 * s].z, st[2 * s].w); u.z = pk2(st[2 * s + 1].x, st[2 * s + 1].y); u.w = pk2(st[2 * s + 1].z, st[2 * s + 1].w); sb[s] = __builtin_bit_cast(bf16x8, u); }
      f32x4 nw[4];
#pragma unroll
      for (int mt = 0; mt < 4; ++mt) { const u32x2 nu = *(const u32x2*)(Ns + mt * 16 + fg * 4); nw[mt] = (f32x4){bflo(nu.x), bfhi(nu.x), bflo(nu.y), bfhi(nu.y)}; }
#pragma unroll
      for (int mt = 0; mt < 4; ++mt) { const u32x4 su = __builtin_bit_cast(u32x4, sb[mt >> 1]); u32x2 o; o.x = (mt & 1) ? su.z : su.x; o.y = (mt & 1) ? su.w : su.y; *(u32x2*)(Ns + mt * 16 + fg * 4) = o; }
#pragma unroll
      for (int mt = 0; mt < 4; ++mt) {
#pragma unroll
        for (int s = 0; s < 2; ++s) { const bf16_t* mr = Mt + (mt * 16 + fr) * 64 + 32 * s + fg * 4; const u32x2 lo = *(const u32x2*)mr, hi = *(const u32x2*)(mr + 16); u32x4 u; u.x = lo.x; u.y = lo.y; u.z = hi.x; u.w = hi.y;
          nw[mt] = MFMA16(__builtin_bit_cast(bf16x8, u), sb[s], nw[mt]); }
        st[mt] = nw[mt]; }
    }
  }
}
constexpr int R3_LDS = 64 * 128 * 2 + 1024;
template <class OutT>
__device__ __forceinline__ void ph_rwkv3(const RW& a, int b_lo, int b_hi, OutT* cat, int ldc, char* lds) {
  const int tid = threadIdx.x, lane = tid & 63, w = tid >> 6, fr = lane & 15, fg = lane >> 4, it = w & 3, eh = w >> 2;
  bf16_t* sg = (bf16_t*)lds; float* red = (float*)(lds + 64 * 128 * 2);
  const int nitems = (b_hi - b_lo) * 12 * 64; const int q_lo = rw_q(b_lo, 0, 0, 0);
  for (int item = blockIdx.x; item < nitems; item += gridDim.x) {
    const int b = b_lo + item / (12 * 64), h = (item / 64) % 12, c = 4 + item % 64; const int t0 = b * FS + c * 64;
    __syncthreads();
    { const int t = tid >> 3, j16 = (tid & 7) * 16; const bool hp = !(c == 4 && t == 0), hn = !(c == 67 && t == 63);
#pragma unroll
      for (int q = 0; q < 2; ++q) { float v[8]; zsm8(a, t0 + t, RC_ZG + j16 + q * 8, hp, hn, v);
#pragma unroll
        for (int j = 0; j < 8; ++j) v[j] = fsigm(v[j]);
        *(bf16x8*)(sg + t * 128 + j16 + q * 8) = pack8(v); } }
    __syncthreads();
    f32x4 y[2], g[2];
#pragma unroll
    for (int n2 = 0; n2 < 2; ++n2) { y[n2] = (f32x4){0.f, 0.f, 0.f, 0.f}; g[n2] = y[n2]; }
    const int tl = it * 16 + fr;
#pragma unroll
    for (int dir = 0; dir < 2; ++dir) { const size_t qo = (size_t)(rw_q(b, h, dir, c) - q_lo) * 4096; const int i = dir ? 63 - tl : tl;
      const bf16x8 r0 = *(const bf16x8*)(a.R2 + qo + i * 64 + fg * 8), r1 = *(const bf16x8*)(a.R2 + qo + i * 64 + 32 + fg * 8);
#pragma unroll
      for (int n2 = 0; n2 < 2; ++n2) { const int et = eh * 2 + n2; const bf16_t* Sr = a.N + qo + (et * 16 + fr) * 64;
        y[n2] = MFMA16(*(const bf16x8*)(Sr + fg * 8), r0, y[n2]); y[n2] = MFMA16(*(const bf16x8*)(Sr + 32 + fg * 8), r1, y[n2]);
        const u32x2 yu = *(const u32x2*)(a.Y0 + qo + i * 64 + et * 16 + fg * 4); y[n2].x += bflo(yu.x); y[n2].y += bfhi(yu.x); y[n2].z += bflo(yu.y); y[n2].w += bfhi(yu.y); } }
#pragma unroll
    for (int ks = 0; ks < 4; ++ks) { const bf16x8 sb = *(const bf16x8*)(sg + tl * 128 + ks * 32 + fg * 8);
#pragma unroll
      for (int n2 = 0; n2 < 2; ++n2) { const int cch = h * 64 + (eh * 2 + n2) * 16 + fr; g[n2] = MFMA16(*(const bf16x8*)(a.g2T + (size_t)cch * 128 + ks * 32 + fg * 8), sb, g[n2]); } }
    float s1 = 0.f, s2 = 0.f;
#pragma unroll
    for (int n2 = 0; n2 < 2; ++n2) { s1 += (y[n2].x + y[n2].y) + (y[n2].z + y[n2].w); s2 += y[n2].x * y[n2].x + y[n2].y * y[n2].y + y[n2].z * y[n2].z + y[n2].w * y[n2].w; }
    s1 += __shfl_xor(s1, 16); s1 += __shfl_xor(s1, 32); s2 += __shfl_xor(s2, 16); s2 += __shfl_xor(s2, 32);
    if (fg == 0) { red[eh * 128 + tl] = s1; red[eh * 128 + 64 + tl] = s2; }
    __syncthreads();
    const float mean = (red[tl] + red[128 + tl]) * (1.f / 64.f); const float var = (red[64 + tl] + red[128 + 64 + tl]) * (1.f / 64.f) - mean * mean; const float ri = 1.f / sqrtf(var + 64e-5f);
#pragma unroll
    for (int n2 = 0; n2 < 2; ++n2) { const int cch = h * 64 + (eh * 2 + n2) * 16 + fg * 4; const f32x4 lg = *(const f32x4*)(a.ln_g + cch), lb = *(const f32x4*)(a.ln_b + cch);
      const f32x4 o = ((y[n2] - mean) * ri * lg + lb) * g[n2]; store4(cat + (size_t)(t0 + tl) * ldc + 256 + cch, o); }
  }
}
struct EpiPlainBf16 { bf16_t* z; int ld;
  __device__ void operator()(const f32x4 (&acc)[4][4], int mb, int nb, int lane) const { const int fr = lane & 15, fg = lane >> 4;
#pragma unroll
    for (int mt = 0; mt < 4; ++mt) { bf16_t* zr = z + (size_t)(mb + mt * 16 + fr) * ld + nb + fg * 4;
#pragma unroll
      for (int nt = 0; nt < 4; ++nt) { u32x2 o; o.x = pk2(acc[mt][nt].x, acc[mt][nt].y); o.y = pk2(acc[mt][nt].z, acc[mt][nt].w); *(u32x2*)(zr + nt * 16) = o; } } } };
__device__ __forceinline__ void ph_inproj1(const FP& f, const bf16_t* wt, int tm0, int tm1, char* lds) {
  ARowPlain ar{f.hb, FD}; EpiPlainBf16 ep{f.zf, Z1_LD}; const int ntn = Z1_LD / 128, ntiles = (tm1 - tm0) * ntn;
  for (int t = blockIdx.x; t < ntiles; t += gridDim.x) { const int tm = tm0 + t / ntn, tn = t % ntn; gemm_tile<4, 2>(ar, wt, FD, FD, tm * 256, tn * 128, lds, ep); }
}
__device__ __forceinline__ void ph_prep_rwkv(const FP& f, bf16_t* w2T, bf16_t* a2T, bf16_t* g2T, char* lds) {
  for (int t = blockIdx.x; t < 24 + 24 + 24; t += gridDim.x) {
    if (t < 24) prep_tile(f.p.rwkv_w2 + (size_t)(t / 12) * 64 * 768, 64, 768, w2T + (size_t)(t / 12) * 768 * 64, 0, (t % 12) * 64, RowMapId(), lds);
    else if (t < 48) { const int u = t - 24; prep_tile(f.p.rwkv_a2 + (size_t)(u / 12) * 64 * 768, 64, 768, a2T + (size_t)(u / 12) * 768 * 64, 0, (u % 12) * 64, RowMapId(), lds); }
    else { const int u = t - 48; prep_tile(f.p.rwkv_g2, 128, 768, g2T, (u / 12) * 64, (u % 12) * 64, RowMapId(), lds); }
  }
}
struct FW { const bf16_t* z; bf16_t* Gp; const bf16_t *T64t, *DFT2, *DFT3; int b_lo, b_hi; };
__device__ __forceinline__ void ph_prep_fourier(bf16_t* T64t, bf16_t* DFT2, bf16_t* DFT3) {
  for (int i = blockIdx.x * NT + threadIdx.x; i < 128 * 64 + 128 * 128 + 64 * 128; i += gridDim.x * NT) {
    if (i < 8192) { const int n = i >> 6, c = i & 63; const float a = (float)(((n & 63) * c) & 63) * (1.f / 32.f); T64t[i] = f2bf(n < 64 ? cospif(a) : -sinpif(a)); }
    else if (i < 8192 + 16384) { const int j = i - 8192, r = j >> 7, K = j & 127; const float a = (float)(((r & 63) * (K & 63)) & 63) * (1.f / 32.f); const float cs = cospif(a), sn = sinpif(a);
      DFT2[j] = f2bf(r < 64 ? (K < 64 ? cs : sn) : (K < 64 ? -sn : cs)); }
    else { const int j = i - 8192 - 16384, r = j >> 7, K = j & 127; const float a = (float)((r * (K & 63)) & 63) * (1.f / 32.f); DFT3[j] = f2bf(K < 64 ? cospif(a) : sinpif(a)); }
  }
}
constexpr int F1_LDS = 512 * 64 * 2;
__device__ __forceinline__ void ph_fourier1(const FW& a, int b_lo, int b_hi, char* lds, bool rev = false) {
  const int tid = threadIdx.x, lane = tid & 63, w = tid >> 6, fr = lane & 15, fg = lane >> 4;
  const int nitems = (b_hi - b_lo) * 64;
  for (int item = rev ? gridDim.x - 1 - blockIdx.x : blockIdx.x; item < nitems; item += gridDim.x) {
    const int b = b_lo + item / 64, l2 = item % 64; const size_t row0 = (size_t)b * FS + FLC + l2;
    __syncthreads();
    {
      const int g = w >> 1, nh = w & 1;
      bf16x8 bt[4][2];
#pragma unroll
      for (int q = 0; q < 4; ++q)
#pragma unroll
        for (int ks = 0; ks < 2; ++ks) bt[q][ks] = *(const bf16x8*)(a.T64t + ((nh * 4 + q) * 16 + fr) * 64 + ks * 32 + fg * 8);
#pragma unroll
      for (int mt = 0; mt < 4; ++mt) { const bf16_t* zr = a.z + (row0 + (size_t)64 * (mt * 16 + fr)) * Z1_LD + g * 64 + fg * 8; const bf16x8 a0 = *(const bf16x8*)zr, a1 = *(const bf16x8*)(zr + 32);
#pragma unroll
        for (int q = 0; q < 4; ++q) { f32x4 d = {0.f, 0.f, 0.f, 0.f}; d = MFMA16(a0, bt[q][0], d); d = MFMA16(a1, bt[q][1], d);
          u32x2 o; o.x = pk2(d.x, d.y); o.y = pk2(d.z, d.w); *(u32x2*)(lds + ((g * 128 + (nh * 4 + q) * 16 + fr) * 64 + mt * 16 + fg * 4) * 2) = o; } }
    }
    __syncthreads();
#pragma unroll 1
    for (int ct = 0; ct < 2; ++ct) {
      f32x4 acc[8];
#pragma unroll
      for (int nt = 0; nt < 8; ++nt) acc[nt] = (f32x4){0.f, 0.f, 0.f, 0.f};
      const int colt = 2 * w + ct; const int g = colt >> 2, m = (colt & 3) * 16 + fr;
#pragma unroll 1
      for (int ks = 0; ks < 4; ++ks) {
        const bf16x8 af = *(const bf16x8*)(lds + ((g * 128 + (ks >> 1) * 64 + m) * 64 + (ks & 1) * 32 + fg * 8) * 2);
#pragma unroll
        for (int nt = 0; nt < 8; ++nt) { const bf16x8 bf_ = *(const bf16x8*)(a.DFT2 + (nt * 16 + fr) * 128 + ks * 32 + fg * 8); acc[nt] = MFMA16(af, bf_, acc[nt]); }
      }
#pragma unroll
      for (int nt = 0; nt < 4; ++nt) { const int k1 = nt * 16 + fr; const float ang = (float)((k1 * l2) & 4095) * (1.f / 2048.f); const float ct_ = cospif(ang), st_ = sinpif(ang);
        bf16_t* gr = a.Gp + ((((size_t)(b - b_lo) * 64 + k1) * 2 + 0) * 64 + l2) * 256; bf16_t* gi = gr + (size_t)64 * 256;
        const f32x4 R = acc[nt], I = acc[nt + 4]; const f32x4 pr = R * ct_ + I * st_, pi = I * ct_ - R * st_; const int col = colt * 16 + fg * 4;
        u32x2 o; o.x = pk2(pr.x, pr.y); o.y = pk2(pr.z, pr.w); *(u32x2*)(gr + col) = o; o.x = pk2(pi.x, pi.y); o.y = pk2(pi.z, pi.w); *(u32x2*)(gi + col) = o; }
    }
  }
}
constexpr int F2_RS = 272, F2_LDS = 256 * F2_RS;
template <class OutT>
__device__ __forceinline__ void ph_fourier2(const FW& a, int b_lo, int b_hi, OutT* cat, int ldc, char* lds, bool rev = false) {
  const int tid = threadIdx.x, lane = tid & 63, w = tid >> 6, fr = lane & 15, fg = lane >> 4;
  const int nitems = (b_hi - b_lo) * 64;
  for (int item = rev ? gridDim.x - 1 - blockIdx.x : blockIdx.x; item < nitems; item += gridDim.x) {
    const int b = b_lo + item / 64, k1 = item % 64; const bf16_t* src = a.Gp + ((size_t)(b - b_lo) * 64 + k1) * 2 * 64 * 256;
    __syncthreads();
#pragma unroll 4
    for (int itn = 0; itn < 8; ++itn) { const int task = itn * 8 + w; const int K = (task & 1) * 64 + lane, c8 = task >> 1; const u32x4 u = *(const u32x4*)(src + (size_t)K * 256 + c8 * 8); const unsigned uu[4] = {u.x, u.y, u.z, u.w};
#pragma unroll
      for (int j = 0; j < 8; ++j) *(bf16_t*)(lds + (c8 * 8 + j) * F2_RS + K * 2) = (bf16_t)((j & 1) ? (uu[j >> 1] >> 16) : (uu[j >> 1] & 0xffffu)); }
    __syncthreads();
    f32x4 acc[2][4];
#pragma unroll
    for (int ct = 0; ct < 2; ++ct)
#pragma unroll
      for (int nt = 0; nt < 4; ++nt) acc[ct][nt] = (f32x4){0.f, 0.f, 0.f, 0.f};
#pragma unroll
    for (int ks = 0; ks < 4; ++ks) {
      bf16x8 af[2];
#pragma unroll
      for (int ct = 0; ct < 2; ++ct) af[ct] = *(const bf16x8*)(lds + ((2 * w + ct) * 16 + fr) * F2_RS + ks * 64 + fg * 16);
#pragma unroll
      for (int nt = 0; nt < 4; ++nt) { const bf16x8 bf_ = *(const bf16x8*)(a.DFT3 + (nt * 16 + fr) * 128 + ks * 32 + fg * 8);
#pragma unroll
        for (int ct = 0; ct < 2; ++ct) acc[ct][nt] = MFMA16(af[ct], bf_, acc[ct][nt]); }
    }
#pragma unroll
    for (int nt = 0; nt < 4; ++nt) { const int k2 = nt * 16 + fr; OutT* dst = cat + ((size_t)b * FS + FLC + k1 + 64 * k2) * ldc;
#pragma unroll
      for (int ct = 0; ct < 2; ++ct) store4(dst + (2 * w + ct) * 16 + fg * 4, acc[ct][nt] * (1.f / 512.f)); }
  }
}
#include <hip/hip_cooperative_groups.h>
namespace cg = cooperative_groups;
struct MK { FP f; RW r; FW w; bf16_t *wt_in0, *wt_in1, *wt_out0, *wt_out1, *w2T, *a2T, *g2T, *T64t, *DFT2, *DFT3; int ph_lo, ph_hi; };

__device__ __forceinline__ void ph_mod(const FP& f, char* lds) {
  float* sc = (float*)lds; float* red = sc + 5 * FD;
  const int tid = threadIdx.x;
  for (int i = tid; i < 5 * FD; i += NT) { const int r = i / FD, k = i - r * FD; const float v = r < FB ? f.p.c[r * FD + k] : f.p.c_ctx[k]; sc[i] = v / (1.f + expf(-v)); }
  __syncthreads();
  const int col = tid & 63, kq = tid >> 6;
  for (int item = blockIdx.x; item < 2 * 96; item += gridDim.x) {
    const int layer = item / 96, j = (item % 96) * 64 + col; const float* W = f.p.ada_w + (size_t)layer * FD * 6 * FD + j;
    float a[5] = {0.f, 0.f, 0.f, 0.f, 0.f};
#pragma unroll 8
    for (int kk = 0; kk < 128; ++kk) { const int k = kq * 128 + kk; const float w = W[(size_t)k * 6 * FD];
#pragma unroll
      for (int r = 0; r < 5; ++r) a[r] += sc[r * FD + k] * w; }
#pragma unroll
    for (int r = 0; r < 5; ++r) red[(kq * 5 + r) * 64 + col] = a[r];
    __syncthreads();
    if (tid < 320) { const int r = tid >> 6; float s = f.p.ada_b[layer * 6 * FD + (item % 96) * 64 + col];
#pragma unroll
      for (int q = 0; q < 8; ++q) s += red[(q * 5 + r) * 64 + col];
      f.p.mod[((size_t)layer * 5 + r) * 6 * FD + (item % 96) * 64 + col] = s; }
    __syncthreads();
  }
}
__device__ __forceinline__ const float* f_xin_row(const FP& f, int t) { const int b = t / FS, s = t - b * FS; return s < FLC ? f.p.ctx + ((size_t)b * FLC + s) * FD : f.p.x + ((size_t)b * FL + (s - FLC)) * FD; }
template <bool FIRST>
__device__ __forceinline__ void norm_h_row(const FP& f, int layer, int t, int lane, const f32x4 (&v)[4]) {
  float ss = 0.f;
#pragma unroll
  for (int j = 0; j < 4; ++j) ss += v[j].x * v[j].x + v[j].y * v[j].y + v[j].z * v[j].z + v[j].w * v[j].w;
  const float ri = 1.f / sqrtf(wave_sum(ss) * (1.f / FD) + 1e-6f); const float* md = f_modrow(f, layer, t); const float* gn = f.p.norm_mix + layer * FD;
#pragma unroll
  for (int j = 0; j < 4; ++j) { const int c = j * 256 + lane * 4; const f32x4 g = *(const f32x4*)(gn + c), sh = *(const f32x4*)(md + c), sc = *(const f32x4*)(md + FD + c);
    const f32x4 h = v[j] * ri * g * (sc + 1.f) + sh; u32x2 o; o.x = pk2(h.x, h.y); o.y = pk2(h.z, h.w); *(u32x2*)(f.hb + (size_t)t * FD + c) = o; }
}
__device__ __forceinline__ void ph_norm_h0(const FP& f) {
  const int lane = threadIdx.x & 63, gw = blockIdx.x * (NT / 64) + (threadIdx.x >> 6), ngw = gridDim.x * (NT / 64);
  for (int t = gw; t < FT; t += ngw) { const float* xr = f_xin_row(f, t); f32x4 v[4];
#pragma unroll
    for (int j = 0; j < 4; ++j) v[j] = *(const f32x4*)(xr + j * 256 + lane * 4);
    norm_h_row<true>(f, 0, t, lane, v); }
}
struct EpiOutProj0 { const FP* f;
  __device__ void operator()(const f32x4 (&acc)[4][4], int mb, int nb, int lane) const {
    const int fr = lane & 15, fg = lane >> 4;
#pragma unroll
    for (int mt = 0; mt < 4; ++mt) { const int m = mb + mt * 16 + fr; float* xo = f_xs_row(*f, m); const float* xi = f_xin_row(*f, m); const float* md = f_modrow(*f, 0, m) + 2 * FD;
#pragma unroll
      for (int nt = 0; nt < 4; ++nt) { const int c = nb + nt * 16 + fg * 4; const f32x4 x = *(const f32x4*)(xi + c), g = *(const f32x4*)(md + c); *(f32x4*)(xo + c) = x + g * acc[mt][nt]; } }
  } };
__device__ __forceinline__ void ph_outproj0(const FP& f, const bf16_t* wt, char* lds) {
  ARowPlain ar{f.hb, FD}; EpiOutProj0 ep{&f};
  for (int t = blockIdx.x; t < 68 * 8; t += gridDim.x) gemm_tile<4, 2>(ar, wt, FD, FD, (t >> 3) * 256, (t & 7) * 128, lds, ep);
}
template <bool LAST>
__device__ __forceinline__ void ph_combine(const FP& f, int layer) {
  const int lane = threadIdx.x & 63, gw = blockIdx.x * (NT / 64) + (threadIdx.x >> 6), ngw = gridDim.x * (NT / 64);
  int off[17]; off[0] = 0;
#pragma unroll
  for (int e = 0; e < 16; ++e) off[e + 1] = off[e] + f.cnt[e];
  for (int t = gw; t < FT; t += ngw) {
    const int b = t / FS, s = t - b * FS; if (LAST && s < FLC) continue;
    const int e0 = f.tok_e[t * 2], e1 = f.tok_e[t * 2 + 1]; int o0 = 0, o1 = 0;
#pragma unroll
    for (int e = 0; e < 16; ++e) { o0 = e == e0 ? off[e] : o0; o1 = e == e1 ? off[e] : o1; }
    const bf16_t* y0 = f.ymoe + (size_t)(o0 + f.tok_pos[t * 2]) * FD; const bf16_t* y1 = f.ymoe + (size_t)(o1 + f.tok_pos[t * 2 + 1]) * FD;
    const float w0 = f.tok_w[t * 2], w1 = f.tok_w[t * 2 + 1]; float* xr = f_xs_row(f, t); const float* md = f_modrow(f, layer, t) + 5 * FD;
    f32x4 v[4];
#pragma unroll
    for (int j = 0; j < 4; ++j) { const int c = j * 256 + lane * 4; const u32x2 a = *(const u32x2*)(y0 + c), bq = *(const u32x2*)(y1 + c); f32x4 x = *(f32x4*)(xr + c); const f32x4 g = *(const f32x4*)(md + c);
      x.x += g.x * (w0 * bflo(a.x) + w1 * bflo(bq.x)); x.y += g.y * (w0 * bfhi(a.x) + w1 * bfhi(bq.x)); x.z += g.z * (w0 * bflo(a.y) + w1 * bflo(bq.y)); x.w += g.w * (w0 * bfhi(a.y) + w1 * bfhi(bq.y));
      *(f32x4*)(xr + c) = x; v[j] = x; }
    if (!LAST) norm_h_row<false>(f, layer + 1, t, lane, v);
  }
}
__device__ __forceinline__ void ph_prep_all0(const MK& k, char* lds) {
  const FP& f = k.f;
  for (int t = blockIdx.x; t < 16 * 37; t += gridDim.x) prep_tile(f.p.even_w_in, FD, Z0_N, k.wt_in0, (t & 15) * 64, (t >> 4) * 64, RowMapIn0(), lds);
  { u32x4 z = {0u, 0u, 0u, 0u}; u32x4* dst = (u32x4*)(k.wt_in0 + (size_t)Z0_N * FD); const int n16 = (Z0_LD - Z0_N) * FD / 8; for (int i = blockIdx.x * NT + threadIdx.x; i < n16; i += gridDim.x * NT) dst[i] = z; }
  for (int t = blockIdx.x; t < 16 * 46; t += gridDim.x) prep_tile(f.p.odd_w_in, FD, Z1_N, k.wt_in1, (t & 15) * 64, (t >> 4) * 64, RowMapId(), lds);
  for (int t = blockIdx.x; t < 256; t += gridDim.x) prep_tile(f.p.even_w_out, FD, FD, k.wt_out0, (t & 15) * 64, (t >> 4) * 64, RowMapId(), lds);
  for (int t = blockIdx.x; t < 256; t += gridDim.x) prep_tile(f.p.odd_w_out, FD, FD, k.wt_out1, (t & 15) * 64, (t >> 4) * 64, RowMapId(), lds);
  ph_prep_rwkv(f, k.w2T, k.a2T, k.g2T, lds);
  ph_prep_moe(f, 0, lds);
  ph_prep_fourier(k.T64t, k.DFT2, k.DFT3);
  if (blockIdx.x == 0 && threadIdx.x < 64) f.cnt[threadIdx.x] = 0;
}

#ifndef PH_MASK
#define PH_MASK 0xffffffffu
#endif
__global__ void __launch_bounds__(NT) mega_k(MK karg) {
  extern __shared__ __attribute__((aligned(16))) char lds[];
  cg::grid_group grid = cg::this_grid();
  const MK* kp0 = (const MK*)__builtin_amdgcn_kernarg_segment_ptr();
  const int ph_lo = kp0->ph_lo, ph_hi = kp0->ph_hi;
#define KARGS() const MK* kp = kp0; asm volatile("" : "+s"(kp)); const MK& k = *kp; const FP& f = k.f; (void)f;
#define PHCODE(id) ((id) > 14 ? (id) - 3 : (id))
#define PHASE(id, body) if (((PH_MASK >> PHCODE(id)) & 1u) && ph_lo <= (id) && (id) < ph_hi) { KARGS() body; } if (ph_lo <= (id) && (id) + 1 < ph_hi) grid.sync();
  PHASE(0, { ph_mod(f, lds); ph_prep_all0(k, lds); })
  PHASE(1, { ph_norm_h0(f); })
  PHASE(2, { ph_inproj0(f, k.wt_in0, 0, 68, lds); })
  PHASE(3, { ph_gla_a(f, 0, FB, lds); ph_attn<bf16_t>(f, 0, FB, f.hb, FD, lds, true); })
  PHASE(4, { ph_gla_b(f, 0, FB); })
  PHASE(5, { ph_gla_c<bf16_t>(f, 0, FB, f.hb, FD, lds); })
  PHASE(6, { ph_outproj0(f, k.wt_out0, lds); })
  PHASE(7, { ph_ffn_router(f, 0); })
  PHASE(8, { ph_moe_gemm<0>(f, lds); })
  PHASE(9, { ph_moe_gemm<1>(f, lds); })
  PHASE(10, { ph_combine<false>(f, 0); ph_prep_moe(f, 1, lds); })
  PHASE(11, { ph_inproj1(f, k.wt_in1, 0, 68, lds); if (blockIdx.x == 0 && threadIdx.x < 64) f.cnt[threadIdx.x] = 0; })
#define RWKV_HALF(half) \
  PHASE(12 + 3 * (half), { ph_rwkv1(k.r, 2 * (half), 2 * (half) + 2, lds); }) \
  PHASE(13 + 3 * (half), { ph_rwkv2(k.r, 2 * (half), 2 * (half) + 2); ph_fourier1(k.w, 2 * (half), 2 * (half) + 2, lds, true); }) \
  PHASE(14 + 3 * (half), { ph_rwkv3<bf16_t>(k.r, 2 * (half), 2 * (half) + 2, f.hb, FD, lds); ph_fourier2<bf16_t>(k.w, 2 * (half), 2 * (half) + 2, f.hb, FD, lds, true); })
  RWKV_HALF(0)
  RWKV_HALF(1)
  PHASE(18, { ph_outproj(f, k.wt_out1, 1, lds); })
  PHASE(19, { ph_ffn_router(f, 1); })
  PHASE(20, { ph_moe_gemm<0>(f, lds); })
  PHASE(21, { ph_moe_gemm<1>(f, lds); })
  PHASE(22, { ph_combine<true>(f, 1); })
}
constexpr int N_PHASES = 23;
constexpr int MEGA_LDS = 147456;
static_assert(R1_LDS <= MEGA_LDS && GemmCfg<4, 2>::LDS_BYTES <= MEGA_LDS && F2_LDS <= MEGA_LDS && F1_LDS <= MEGA_LDS && 5 * FD * 4 + 8 * 5 * 64 * 4 <= MEGA_LDS, "LDS budget");

static size_t mega_carve(MK& k, char* base) {
  size_t off = 0; auto take = [&](size_t bytes) { char* r = base ? base + off : nullptr; off += (bytes + 255) & ~(size_t)255; return r; };
  FP& f = k.f;
  k.wt_in0 = (bf16_t*)take((size_t)Z0_LD * FD * 2); k.wt_in1 = (bf16_t*)take((size_t)Z1_LD * FD * 2); k.wt_out0 = (bf16_t*)take((size_t)FD * FD * 2); k.wt_out1 = (bf16_t*)take((size_t)FD * FD * 2);
  k.w2T = (bf16_t*)take((size_t)2 * 768 * 64 * 2); k.a2T = (bf16_t*)take((size_t)2 * 768 * 64 * 2); k.g2T = (bf16_t*)take((size_t)768 * 128 * 2);
  k.T64t = (bf16_t*)take(16384); k.DFT2 = (bf16_t*)take(32768); k.DFT3 = (bf16_t*)take(16384);
  f.moe_gu = (bf16_t*)take((size_t)16 * FD * FD * 2); f.moe_d = (bf16_t*)take((size_t)16 * FD * 512 * 2);
  f.p.xc = (float*)take((size_t)FB * FLC * FD * 4); f.p.mod = (float*)take((size_t)2 * 5 * 6 * FD * 4);
  f.cnt = (int*)take(256); f.list = (int*)take((size_t)16 * FT * 4); f.tok_e = (int*)take((size_t)FT * 8); f.tok_pos = (int*)take((size_t)FT * 8); f.tok_w = (float*)take((size_t)FT * 8);
  f.hb = (bf16_t*)take((size_t)FT * FD * 2);
  char* zreg = take((size_t)FT * Z1_LD * 2); f.zf = (bf16_t*)zreg; f.ymoe = (bf16_t*)zreg;
  const size_t mark = off;
  f.vT = (bf16_t*)take((size_t)FB * 2 * 64 * FS * 2); f.gla_b = (float*)take((size_t)FT * 512 * 4); f.gla_s = (float*)take((size_t)FB * 8 * 2 * 68 * 2048 * 4); f.gla_dec = (float*)take((size_t)FB * 8 * 2 * 68 * 32 * 4);
  const size_t e0 = off; off = mark;
  f.act = (bf16_t*)take((size_t)2 * FT * 512 * 2);
  const size_t e1 = off; off = mark;
  const size_t per = (size_t)2 * 12 * 2 * 68 * 4096 * 2;
  k.r.M = (bf16_t*)take(per); k.r.N = (bf16_t*)take(per); k.r.R2 = (bf16_t*)take(per); k.r.Y0 = (bf16_t*)take(per); k.w.Gp = (bf16_t*)take((size_t)2 * 64 * 2 * 64 * 256 * 2);
  const size_t e2 = off; off = e0 > e1 ? e0 : e1; off = off > e2 ? off : e2;
  return off;
}
extern "C" void kernel_launch(void* const* d_in, const int* in_sizes, int n_in, void* d_out, int out_size, void* d_ws, size_t ws_size, hipStream_t stream) {
  static MK k; static int grid_blocks = 0;
  memset(&k, 0, sizeof(k));
  if (n_in != 34 || out_size != FB * FL * FD) { fprintf(stderr, "kernel_launch: unexpected n_in %d / out_size %d\n", n_in, out_size); return; }
  NP& p = k.f.p; np_set_dims(p, FB, FL, FLC, FD); np_set_inputs(p, d_in); p.out = (float*)d_out;
  const size_t need = mega_carve(k, nullptr);
  if (need > ws_size) { fprintf(stderr, "kernel_launch: ws too small: need %zu have %zu\n", need, ws_size); return; }
  mega_carve(k, (char*)d_ws);
  RW& r = k.r; r.z = k.f.zf; r.w2T = k.w2T; r.a2T = k.a2T; r.g2T = k.g2T; r.mu = p.rwkv_mu; r.w0 = p.rwkv_w0; r.a0 = p.rwkv_a0; r.kk_scale = p.rwkv_kk_scale; r.k_a = p.rwkv_k_a; r.r_k = p.rwkv_r_k; r.ln_g = p.rwkv_ln_g; r.ln_b = p.rwkv_ln_b;
  k.w.z = k.f.zf; k.w.T64t = k.T64t; k.w.DFT2 = k.DFT2; k.w.DFT3 = k.DFT3;
  k.ph_lo = 0; k.ph_hi = N_PHASES;
  if (!grid_blocks) {
    int dev = 0, cus = 0, per_cu = 0; hipGetDevice(&dev); hipDeviceGetAttribute(&cus, hipDeviceAttributeMultiprocessorCount, dev);
    hipFuncSetAttribute((const void*)mega_k, hipFuncAttributeMaxDynamicSharedMemorySize, MEGA_LDS);
    hipOccupancyMaxActiveBlocksPerMultiprocessor(&per_cu, mega_k, NT, MEGA_LDS);
    if (per_cu < 1) fprintf(stderr, "kernel_launch: occupancy query says %d blocks/CU\n", per_cu);
    grid_blocks = cus;
    fprintf(stderr, "kernel_launch: cus %d per_cu %d grid %d ws need %zu MB of %zu MB\n", cus, per_cu, grid_blocks, need >> 20, ws_size >> 20);
  }
#if MEGA_MULTI_LAUNCH
  for (int ph = 0; ph < N_PHASES; ++ph) { k.ph_lo = ph; k.ph_hi = ph + 1; void* args[] = {&k}; hipLaunchCooperativeKernel((void*)mega_k, dim3(grid_blocks), dim3(NT), args, MEGA_LDS, stream); }
#else
  void* args[] = {&k};
  hipError_t e = hipLaunchCooperativeKernel((void*)mega_k, dim3(grid_blocks), dim3(NT), args, MEGA_LDS, stream);
  if (e != hipSuccess) fprintf(stderr, "cooperative launch failed: %s (grid %d)\n", hipGetErrorString(e), grid_blocks);
#endif
}
```

```cpp
#include <hip/hip_runtime.h>
#include <cstdio>
#include <cstring>
constexpr int FB = 4, FL = 4096, FLC = 256, FS = 4352, FT = 17408, FD = 1024;
constexpr int Z0_GQ = 0, Z0_GK = 256, Z0_GV = 512, Z0_GG = 1024, Z0_AQ = 1536, Z0_AK = 2048, Z0_AV = 2176, Z0_GDEC = 2304, Z0_N = 2336, Z0_LD = 2432;
constexpr int Z1_N = 2944, Z1_LD = 2944;
constexpr int W0_ROWS = 2560, W1_ROWS = 3072;
constexpr int SRC_GDEC = 1536, SRC_AQ = 1568;
__host__ __device__ __forceinline__ int z0_dst_of_src(int n) { return n < SRC_GDEC ? n : (n < SRC_AQ ? Z0_GDEC + (n - SRC_GDEC) : n - 32); }
__host__ __device__ __forceinline__ int z0_src_of_dst(int d) { return d < Z0_AQ ? d : (d < Z0_GDEC ? d + 32 : (d < Z0_N ? SRC_GDEC + (d - Z0_GDEC) : -1)); }
#include <math.h>
#include <stdint.h>
#ifdef HOST_TEST
#define HD
#define FAST_SIN sinf
#define FAST_COS cosf
#define MEMBAR()
#else
#define HD __host__ __device__ __forceinline__
#define FAST_SIN __sinf
#define FAST_COS __cosf
#define MEMBAR() asm volatile("" ::: "memory")
#endif

struct NP {
  int B, L, LC, S, T, D, GW;
  int GH, GC, AH, AKV, FW, FG, RD, RH, DE, E;
  int EC, OC, RC, NZ;
  int e_gq, e_gk, e_gv, e_gg, e_gdec, e_aq, e_ak, e_av;
  int layer, b0, dir, which, pad0;
  const float *x, *c, *ctx, *c_ctx, *ada_w, *ada_b, *norm_mix, *norm_ffn, *even_w_in, *even_w_out, *gla_dec_w, *gla_dec_b,
      *gla_out_norm, *att_q_norm, *att_k_norm, *att_sink, *odd_w_in, *odd_w_out, *rwkv_mu, *rwkv_w0, *rwkv_w2, *rwkv_a0,
      *rwkv_a2, *rwkv_g2, *rwkv_kk_scale, *rwkv_k_a, *rwkv_r_k, *rwkv_ln_g, *rwkv_ln_b, *router_w, *router_b, *moe_w_gate,
      *moe_w_up, *moe_w_down;
  float *out;
  float *xc;
  float *mod;
  float *rinv;
  float *hbuf;
  float *zb;
  float *lad;
  float *ogla;
  float *kkb;
  float *rsb, *vsb;
  float *decb, *ab, *kdb;
  float *yb;
  float *fa, *fb;
  float *cosT, *sinT;
  int *re;
  float *rw;
  float *act;
};

HD float sigm(float x) { return 1.f / (1.f + expf(-x)); }
HD float siluf_(float x) { return x * sigm(x); }
HD float softplusf_(float x) { return x > 0.f ? x + log1pf(expf(-x)) : log1pf(expf(x)); }
HD float logsigm(float x) { return -softplusf_(-x); }
HD float* xs_row(const NP& p, int t) { int b = t / p.S, s = t % p.S; return s < p.LC ? p.xc + ((size_t)b * p.LC + s) * p.D : p.out + ((size_t)b * p.L + (s - p.LC)) * p.D; }
HD const float* modrow(const NP& p, int layer, int t) { int b = t / p.S, s = t % p.S; int r = s < p.LC ? p.B : b; return p.mod + ((size_t)layer * (p.B + 1) + r) * 6 * p.D; }
HD float zs_at(const NP& p, int s, int c) {
  const float* z = p.zb + (size_t)s * p.NZ + p.FW + c;
  int seg0 = s < p.LC ? 0 : p.LC, seg1 = s < p.LC ? p.LC : p.S;
  float zc = z[0], pv = s > seg0 ? z[-p.NZ] : 0.f, nx = s < seg1 - 1 ? z[p.NZ] : 0.f;
  return zc + p.rwkv_mu[c] * (0.5f * (pv + nx) - zc);
}

static inline void np_set_dims(NP& p, int B, int L, int LC, int D) {
  p.B = B; p.L = L; p.LC = LC; p.S = L + LC; p.T = B * p.S; p.D = D; p.GW = 64;
  p.GH = (D / 2) / 64; p.GC = p.GH * 32; p.AH = (D / 2) / 64; p.AKV = p.AH / 4; p.FW = D / 4; p.FG = p.FW / 64; p.RD = D - p.FW; p.RH = p.RD / 64;
  p.DE = D == 1024 ? 512 : D / 2; p.E = 16;
  p.e_gq = 0; p.e_gk = p.e_gq + p.GH * 32; p.e_gv = p.e_gk + p.GH * 32; p.e_gg = p.e_gv + p.GH * 64; p.e_gdec = p.e_gg + p.GH * 64; p.e_aq = p.e_gdec + 32;
  p.e_ak = p.e_aq + p.AH * 64; p.e_av = p.e_ak + p.AKV * 64; p.EC = p.e_av + p.AKV * 64;
  p.RC = 3 * p.RD + 128 + 128 + 128; p.OC = p.FW + p.RC; p.NZ = p.OC > p.EC ? p.OC : p.EC;
}
static inline void np_set_inputs(NP& p, void* const* d_in) {
  const float** f = (const float**)&p.x; for (int i = 0; i < 34; ++i) f[i] = (const float*)d_in[i];
}
typedef unsigned short bf16_t;
typedef short bf16x8 __attribute__((ext_vector_type(8)));
typedef float f32x4 __attribute__((ext_vector_type(4)));
typedef float f32x2 __attribute__((ext_vector_type(2)));
typedef unsigned u32x4 __attribute__((ext_vector_type(4)));
typedef unsigned u32x2 __attribute__((ext_vector_type(2)));
typedef __bf16 bf16v2 __attribute__((ext_vector_type(2)));
#define NT 512
#define NBLK_MAX 256

__device__ __forceinline__ int tid_opaque() { int t = threadIdx.x; asm volatile("" : "+v"(t)); return t; }
#define TIDX tid_opaque()
__device__ __forceinline__ unsigned pk2(float a, float b) { bf16v2 r = __builtin_convertvector((f32x2){a, b}, bf16v2); return __builtin_bit_cast(unsigned, r); }
__device__ __forceinline__ bf16_t f2bf(float a) { return (bf16_t)(pk2(a, 0.f) & 0xffffu); }
__device__ __forceinline__ float bf2f(bf16_t v) { return __uint_as_float((unsigned)v << 16); }
__device__ __forceinline__ float bflo(unsigned u) { return __uint_as_float(u << 16); }
__device__ __forceinline__ float bfhi(unsigned u) { return __uint_as_float(u & 0xffff0000u); }
__device__ __forceinline__ float wave_sum(float v) {
#pragma unroll
  for (int o = 1; o < 64; o <<= 1) v += __shfl_xor(v, o);
  return v;
}
template <int CTRL, int ROW_MASK = 0xf>
__device__ __forceinline__ float dppmov(float v) { return __int_as_float(__builtin_amdgcn_update_dpp(0, __float_as_int(v), CTRL, ROW_MASK, 0xf, true)); }
__device__ __forceinline__ float wave_sum_dpp(float v) {
  v += dppmov<0x128>(v); v += dppmov<0x124>(v); v += dppmov<0x122>(v); v += dppmov<0x121>(v);
  v += dppmov<0x142, 0xa>(v); v += dppmov<0x143, 0xc>(v);
  return __int_as_float(__builtin_amdgcn_readlane(__float_as_int(v), 63));
}
__device__ __forceinline__ bf16x8 pack8(const float (&v)[8]) { u32x4 u; u.x = pk2(v[0], v[1]); u.y = pk2(v[2], v[3]); u.z = pk2(v[4], v[5]); u.w = pk2(v[6], v[7]); return __builtin_bit_cast(bf16x8, u); }
__device__ __forceinline__ float fsigm(float x) { return 1.f / (1.f + __expf(-x)); }
__device__ __forceinline__ float fsilu(float x) { return x * fsigm(x); }

template <int WM, int WN> struct GemmCfg { static constexpr int BM = WM * 64, BN = WN * 64, STAGE = (BM + BN) * 128, LDS_BYTES = 2 * STAGE; };

template <int WM, int WN, class ARow, class Epi>
__device__ __forceinline__ void gemm_tile(const ARow& arow, const bf16_t* __restrict__ Bt, int ldb, int K, int m0, int n0, char* lds, const Epi& epi) {
  constexpr int BM = WM * 64, BN = WN * 64, STAGE = (BM + BN) * 128;
  const int tid = TIDX, lane = tid & 63, wave = tid >> 6, wm = wave / WN, wn = wave % WN;
  const int crow = tid >> 3, kc = tid & 7;
  const bf16_t* ap[WM]; const bf16_t* bp[WN];
#pragma unroll
  for (int i = 0; i < WM; ++i) ap[i] = arow(m0 + crow + 64 * i) + kc * 8;
#pragma unroll
  for (int i = 0; i < WN; ++i) bp[i] = Bt + (size_t)(n0 + crow + 64 * i) * ldb + kc * 8;
  const int wofs = crow * 128 + ((kc ^ (crow & 7)) << 4);
  u32x4 ra[WM], rb[WN];
  f32x4 acc[4][4];
#pragma unroll
  for (int i = 0; i < 4; ++i)
#pragma unroll
    for (int j = 0; j < 4; ++j) acc[i][j] = (f32x4){0.f, 0.f, 0.f, 0.f};
  const int nk = K / 64;
#pragma unroll
  for (int i = 0; i < WM; ++i) ra[i] = *(const u32x4*)(ap[i]);
#pragma unroll
  for (int i = 0; i < WN; ++i) rb[i] = *(const u32x4*)(bp[i]);
  __syncthreads();
#pragma unroll
  for (int i = 0; i < WM; ++i) *(u32x4*)(lds + wofs + i * 8192) = ra[i];
#pragma unroll
  for (int i = 0; i < WN; ++i) *(u32x4*)(lds + BM * 128 + wofs + i * 8192) = rb[i];
  __syncthreads();
  const int fr = lane & 15, fg = lane >> 4;
  for (int kt = 0; kt < nk; ++kt) {
    char* cur = lds + (kt & 1) * STAGE; char* nxt = lds + ((kt + 1) & 1) * STAGE;
    if (kt + 1 < nk) {
#pragma unroll
      for (int i = 0; i < WM; ++i) ra[i] = *(const u32x4*)(ap[i] + (kt + 1) * 64);
#pragma unroll
      for (int i = 0; i < WN; ++i) rb[i] = *(const u32x4*)(bp[i] + (kt + 1) * 64);
    }
    const char* As = cur + (wm * 64) * 128; const char* Bs = cur + BM * 128 + (wn * 64) * 128;
#pragma unroll
    for (int kh = 0; kh < 2; ++kh) {
      bf16x8 af[4], bfr[4];
      const int ch = kh * 4 + fg;
#pragma unroll
      for (int t = 0; t < 4; ++t) { const int r = t * 16 + fr; const int o = r * 128 + ((ch ^ (r & 7)) << 4); af[t] = *(const bf16x8*)(As + o); bfr[t] = *(const bf16x8*)(Bs + o); }
#pragma unroll
      for (int mt = 0; mt < 4; ++mt)
#pragma unroll
        for (int nt = 0; nt < 4; ++nt) acc[mt][nt] = __builtin_amdgcn_mfma_f32_16x16x32_bf16(bfr[nt], af[mt], acc[mt][nt], 0, 0, 0);
    }
    if (kt + 1 < nk) {
#pragma unroll
      for (int i = 0; i < WM; ++i) *(u32x4*)(nxt + wofs + i * 8192) = ra[i];
#pragma unroll
      for (int i = 0; i < WN; ++i) *(u32x4*)(nxt + BM * 128 + wofs + i * 8192) = rb[i];
    }
    __syncthreads();
  }
  epi(acc, m0 + wm * 64, n0 + wn * 64, lane);
}

template <class RowMap>
__device__ __forceinline__ void prep_tile(const float* __restrict__ W, int K, int N, bf16_t* __restrict__ Wt, int k0, int n0, const RowMap& rm, char* lds) {
  float* tile = (float*)lds; const int tid = TIDX;
  __syncthreads();
  { const int k = tid >> 3, n8 = (tid & 7) * 8; const float* src = W + (size_t)(k0 + k) * N + n0 + n8;
#pragma unroll
    for (int j = 0; j < 8; ++j) tile[k * 65 + n8 + j] = (n0 + n8 + j < N) ? src[j] : 0.f; }
  __syncthreads();
  { const int n = tid >> 3, k8 = (tid & 7) * 8; const int dr = (n0 + n < N) ? rm(n0 + n) : -1;
    if (dr >= 0) { u32x4 o; const float* s = tile + k8 * 65 + n;
      o.x = pk2(s[0], s[65]); o.y = pk2(s[130], s[195]); o.z = pk2(s[260], s[325]); o.w = pk2(s[390], s[455]);
      *(u32x4*)(Wt + (size_t)dr * K + k0 + k8) = o; } }
}
#define XB_TMO      128
#define XB_XCNT(j)  (256  + 64 * (j))
#define XB_XSUB(j)  (1280 + 64 * (j))
#define XB_XGEN(j)  (2304 + 64 * (j))
#define XB_TOP      3328
#define XB_TOPGEN   3392
#define XCD_BAR_WORDS 3456
#define XB_SPIN_CAP (1u << 22)
#define LAS __attribute__((address_space(3)))
__device__ __forceinline__ unsigned xb_ld(unsigned* p)              { return __hip_atomic_load(p, __ATOMIC_RELAXED, __HIP_MEMORY_SCOPE_AGENT); }
__device__ __forceinline__ unsigned xb_add(unsigned* p, unsigned v) { return __hip_atomic_fetch_add(p, v, __ATOMIC_RELAXED, __HIP_MEMORY_SCOPE_AGENT); }
__device__ __forceinline__ unsigned xb_xcc_id() { return (unsigned)__builtin_amdgcn_s_getreg((3 << 11) | 20) & 0xFu; }
#define XB_SPIN(cond, bar) do { unsigned _sp = 0; while (cond) { __builtin_amdgcn_s_sleep(1); \
    if ((++_sp & 255u) == 0u) { if (xb_ld(&(bar)[XB_TMO])) break; if (_sp > XB_SPIN_CAP) { atomicAdd(&(bar)[XB_TMO], 1u); break; } } } } while (0)
struct XcdBarrier { unsigned* bar; unsigned x; volatile LAS unsigned* st; };
__device__ __forceinline__ XcdBarrier xcd_barrier_post(unsigned* bar, volatile LAS unsigned* st) {
  XcdBarrier b; b.bar = bar; b.x = xb_xcc_id(); b.st = st;
  if (threadIdx.x == 0) (void)xb_add(&bar[XB_XCNT(b.x)], 1u);
  return b;
}
__device__ __forceinline__ void xcd_barrier_complete(unsigned* bar, unsigned x, unsigned& nloc, unsigned& nx) {
  const unsigned G = gridDim.x * gridDim.y * gridDim.z; unsigned sum, cnt, mine, sp = 0u;
  for (;;) {
    sum = 0u; cnt = 0u; mine = 0u;
#pragma unroll
    for (unsigned j = 0; j < 16; ++j) { const unsigned c = xb_ld(&bar[XB_XCNT(j)]); sum += c; cnt += (c > 0u) ? 1u : 0u; mine = (j == x) ? c : mine; }
    if (sum == G) break;
    __builtin_amdgcn_s_sleep(1);
    if ((++sp & 255u) == 0u) { if (xb_ld(&bar[XB_TMO])) break; if (sp > XB_SPIN_CAP) { atomicAdd(&bar[XB_TMO], 1u); break; } }
  }
  nloc = mine > 0u ? mine : 1u; nx = cnt > 0u ? cnt : 1u;
}
__device__ __forceinline__ void xcd_barrier(const XcdBarrier& b) {
  asm volatile("s_waitcnt vmcnt(0)" ::: "memory");
  __syncthreads();
  if (threadIdx.x == 0) {
    unsigned* bar = b.bar;
    __builtin_amdgcn_s_waitcnt(0);
    unsigned nloc = b.st[0], nx = b.st[1];
    if (nloc == 0u) { xcd_barrier_complete(bar, b.x, nloc, nx); b.st[0] = nloc; b.st[1] = nx; }
    const unsigned old = xb_add(&bar[XB_XSUB(b.x)], 1u);
    const unsigned gen = old / nloc;
    if (old + 1u == (gen + 1u) * nloc) {
      __builtin_amdgcn_fence(__ATOMIC_RELEASE, "agent");
      asm volatile("s_waitcnt vmcnt(0)" ::: "memory");
      const unsigned og = xb_add(&bar[XB_TOP], 1u);
      const unsigned tg = og / nx;
      if (og + 1u == (tg + 1u) * nx) xb_add(&bar[XB_TOPGEN], 1u);
      else XB_SPIN(xb_ld(&bar[XB_TOPGEN]) == tg, bar);
      __builtin_amdgcn_fence(__ATOMIC_ACQUIRE, "agent");
      xb_add(&bar[XB_XGEN(b.x)], 1u);
      asm volatile("s_waitcnt vmcnt(0)" ::: "memory");
    } else {
      XB_SPIN(xb_ld(&bar[XB_XGEN(b.x)]) == gen, bar);
      __builtin_amdgcn_fence(__ATOMIC_ACQUIRE, "agent");
      asm volatile("s_waitcnt vmcnt(0)" ::: "memory");
    }
  }
  __syncthreads();
}
struct RowMapIn0 { __device__ int operator()(int n) const { return z0_dst_of_src(n); } };
struct RowMapId { __device__ int operator()(int n) const { return n; } };
struct ARowPlain { const bf16_t* base; int lda; __device__ const bf16_t* operator()(int m) const { return base + (size_t)m * lda; } };
struct FP {
  NP p;
  bf16_t* hb;
  bf16_t* wt_in;
  bf16_t* wt_out;
  bf16_t* moe_gu;
  bf16_t* moe_d;
  int* cnt;
  int* list;
  int* tok_e;
  int* tok_pos;
  float* tok_w;
  bf16_t* act;
  bf16_t* ymoe;
  bf16_t* zf;
  bf16_t* vT;
  float* gla_b;
  float* gla_s;
  float* gla_dec;
  int layer; int pad1;
};
__device__ __forceinline__ float* f_xs_row(const FP& f, int t) { const int b = t / FS, s = t - b * FS; return s < FLC ? f.p.xc + ((size_t)b * FLC + s) * FD : f.p.out + ((size_t)b * FL + (s - FLC)) * FD; }
__device__ __forceinline__ const float* f_modrow(const FP& f, int layer, int t) { const int b = t / FS, s = t - b * FS; const int r = s < FLC ? FB : b; return f.p.mod + ((size_t)layer * (FB + 1) + r) * 6 * FD; }
__device__ __forceinline__ const float* f_xin_row(const FP& f, int t) { const int b = t / FS, s = t - b * FS; return s < FLC ? f.p.ctx + ((size_t)b * FLC + s) * FD : f.p.x + ((size_t)b * FL + (s - FLC)) * FD; }

struct RowMapGate { __device__ int operator()(int j) const { return (j >> 5) * 64 + (j & 31); } };
struct RowMapUp { __device__ int operator()(int j) const { return (j >> 5) * 64 + 32 + (j & 31); } };
__device__ __forceinline__ void ph_prep_out(const FP& f, int layer, char* lds) {
  const float* W = layer == 0 ? f.p.even_w_out : f.p.odd_w_out;
  for (int t = blockIdx.x; t < 16 * 16; t += gridDim.x) prep_tile(W, FD, FD, f.wt_out, (t & 15) * 64, (t >> 4) * 64, RowMapId(), lds);
}
template <class GateMap = RowMapGate, class UpMap = RowMapUp>
__device__ __forceinline__ void ph_prep_moe(const FP& f, int layer, char* lds) {
  const int per_e = 128 * 3;
  for (int t = blockIdx.x; t < 16 * per_e; t += gridDim.x) {
    const int e = t / per_e, r = t % per_e, which = r / 128, q = r % 128;
    if (which == 0) prep_tile(f.p.moe_w_gate + (size_t)(layer * 16 + e) * FD * 512, FD, 512, f.moe_gu + (size_t)e * FD * FD, (q & 15) * 64, (q >> 4) * 64, GateMap(), lds);
    else if (which == 1) prep_tile(f.p.moe_w_up + (size_t)(layer * 16 + e) * FD * 512, FD, 512, f.moe_gu + (size_t)e * FD * FD, (q & 15) * 64, (q >> 4) * 64, UpMap(), lds);
    else prep_tile(f.p.moe_w_down + (size_t)(layer * 16 + e) * 512 * FD, 512, FD, f.moe_d + (size_t)e * FD * 512, (q & 7) * 64, (q >> 3) * 64, RowMapId(), lds);
  }
}
struct EpiOutProj { const FP* f; int layer;
  __device__ void operator()(const f32x4 (&acc)[4][4], int mb, int nb, int lane) const {
    const int fr = lane & 15, fg = lane >> 4;
#pragma unroll
    for (int mt = 0; mt < 4; ++mt) { const int m = mb + mt * 16 + fr; float* xr = f_xs_row(*f, m); const float* md = f_modrow(*f, layer, m) + 2 * FD;
#pragma unroll
      for (int nt = 0; nt < 4; ++nt) { const int c = nb + nt * 16 + fg * 4; f32x4 x = *(f32x4*)(xr + c); const f32x4 g = *(const f32x4*)(md + c); x += g * acc[mt][nt]; *(f32x4*)(xr + c) = x; } }
  } };
__device__ __forceinline__ void ph_outproj(const FP& f, const bf16_t* wt, int layer, char* lds) {
  ARowPlain ar{f.hb, FD}; EpiOutProj ep{&f, layer};
  for (int t = blockIdx.x; t < 68 * 8; t += gridDim.x) { const int tm = t >> 3, tn = t & 7; if (layer == 1 && (tm % 17) == 0) continue; gemm_tile<4, 2>(ar, wt, FD, FD, tm * 256, tn * 128, lds, ep); }
}
template <bool DRY = false>
__device__ __forceinline__ void ph_ffn_router(const FP& f, int layer, char* lds) {
  const int tid = TIDX, lane = tid & 63, w = tid >> 6;
  f32x4* rwl = (f32x4*)lds; int* lcnt = (int*)(lds + 65536); int* lbase = lcnt + 16; int* rec = lbase + 16;
  __syncthreads();
  for (int idx = tid; idx < 4096; idx += NT) { const int k = idx >> 2, q = idx & 3; const int j = k >> 8, ln = (k & 255) >> 2, i = k & 3; rwl[((j * 4 + i) * 4 + q) * 64 + ln] = *(const f32x4*)(f.p.router_w + (size_t)k * 16 + q * 4); }
  if (tid < 16) lcnt[tid] = 0;
  __syncthreads();
  const int tb = blockIdx.x * 68;
  for (int tl = w; tl < 68; tl += 8) {
    const int t = tb + tl; const int b = t / FS, s = t - b * FS; const bool skip = (layer == 1 && s < FLC) || t >= FT;
    if (skip) { if (lane == 0) rec[tl * 4] = -1; continue; }
    const float* xr = f_xs_row(f, t); const float* md = f_modrow(f, layer, t); const float* gn = f.p.norm_ffn + layer * FD;
    f32x4 v[4]; float ss = 0.f;
#pragma unroll
    for (int j = 0; j < 4; ++j) { v[j] = *(const f32x4*)(xr + j * 256 + lane * 4); ss += v[j].x * v[j].x + v[j].y * v[j].y + v[j].z * v[j].z + v[j].w * v[j].w; }
    const float ri = 1.f / sqrtf(wave_sum_dpp(ss) * (1.f / FD) + 1e-6f);
    float lg[16];
#pragma unroll
    for (int e = 0; e < 16; ++e) lg[e] = 0.f;
#pragma unroll
    for (int j = 0; j < 4; ++j) { const int c = j * 256 + lane * 4; const f32x4 g = *(const f32x4*)(gn + c), sh = *(const f32x4*)(md + 3 * FD + c), sc = *(const f32x4*)(md + 4 * FD + c);
      f32x4 h = v[j] * ri * g * (sc + 1.f) + sh; u32x2 o; o.x = pk2(h.x, h.y); o.y = pk2(h.z, h.w); *(u32x2*)(f.hb + (size_t)t * FD + c) = o;
#pragma unroll
      for (int i = 0; i < 4; ++i) { const float hv = h[i];
#pragma unroll
        for (int q = 0; q < 4; ++q) { const f32x4 wv = rwl[((j * 4 + i) * 4 + q) * 64 + lane]; lg[q * 4 + 0] += hv * wv.x; lg[q * 4 + 1] += hv * wv.y; lg[q * 4 + 2] += hv * wv.z; lg[q * 4 + 3] += hv * wv.w; } } }
#pragma unroll
    for (int e = 0; e < 16; ++e) lg[e] = wave_sum_dpp(lg[e]);
    if (lane == 0) {
      float sc[16], sel[16];
#pragma unroll
      for (int e = 0; e < 16; ++e) { sc[e] = 1.f / (1.f + expf(-lg[e])); sel[e] = sc[e] + f.p.router_b[e]; }
      int best = 0; float bests = -1e30f;
#pragma unroll
      for (int g = 0; g < 4; ++g) { float m1 = -1e30f, m2 = -1e30f;
#pragma unroll
        for (int i = 0; i < 4; ++i) { const float x = sel[g * 4 + i]; if (x > m1) { m2 = m1; m1 = x; } else if (x > m2) m2 = x; }
        if (m1 + m2 > bests) { bests = m1 + m2; best = g; } }
      int i0 = 0, i1 = 0; float v0 = -1e30f, v1 = -1e30f, s0 = 0.f, s1 = 0.f;
#pragma unroll
      for (int e = 0; e < 16; ++e) if ((e >> 2) == best) { const float x = sel[e];
        if (x > v0) { v1 = v0; i1 = i0; s1 = s0; v0 = x; i0 = e; s0 = sc[e]; } else if (x > v1) { v1 = x; i1 = e; s1 = sc[e]; } }
      const float sum = s0 + s1;
      if (DRY) { asm volatile("" :: "v"(sum), "v"(i0), "v"(i1)); rec[tl * 4] = -1; }
      else { rec[tl * 4] = i0; rec[tl * 4 + 1] = i1; rec[tl * 4 + 2] = atomicAdd(lcnt + i0, 1); rec[tl * 4 + 3] = atomicAdd(lcnt + i1, 1);
        f.tok_e[t * 2] = i0; f.tok_e[t * 2 + 1] = i1; f.tok_w[t * 2] = s0 / sum; f.tok_w[t * 2 + 1] = s1 / sum; }
    }
  }
  __syncthreads();
  if (tid < 16) lbase[tid] = (!DRY && lcnt[tid] > 0) ? atomicAdd(f.cnt + tid, lcnt[tid]) : 0;
  __syncthreads();
  if (tid < 68 && rec[tid * 4] >= 0) { const int t = tb + tid, e0 = rec[tid * 4], e1 = rec[tid * 4 + 1]; const int p0 = lbase[e0] + rec[tid * 4 + 2], p1 = lbase[e1] + rec[tid * 4 + 3];
    f.list[(size_t)e0 * FT + p0] = t; f.list[(size_t)e1 * FT + p1] = t; f.tok_pos[t * 2] = p0; f.tok_pos[t * 2 + 1] = p1; }
}
struct ARowGather { const bf16_t* base; const int* lst; int n; __device__ const bf16_t* operator()(int m) const { const int mm = m < n ? m : n - 1; return base + (size_t)lst[mm] * FD; } };
struct ARowAct { const bf16_t* base; int n; __device__ const bf16_t* operator()(int m) const { const int mm = m < n ? m : n - 1; return base + (size_t)mm * 512; } };
struct EpiGU { bf16_t* act; int n;
  __device__ void operator()(const f32x4 (&acc)[4][4], int mb, int nb, int lane) const {
    const int fr = lane & 15, fg = lane >> 4; const int jg = nb >> 6;
#pragma unroll
    for (int mt = 0; mt < 4; ++mt) { const int m = mb + mt * 16 + fr; if (m < n) {
#pragma unroll
      for (int nt = 0; nt < 2; ++nt) { const f32x4 g = acc[mt][nt], u = acc[mt][nt + 2]; u32x2 o; o.x = pk2(fsilu(g.x) * u.x, fsilu(g.y) * u.y); o.y = pk2(fsilu(g.z) * u.z, fsilu(g.w) * u.w);
        *(u32x2*)(act + (size_t)m * 512 + jg * 32 + nt * 16 + fg * 4) = o; } } }
  } };
struct EpiDown { bf16_t* y; int n;
  __device__ void operator()(const f32x4 (&acc)[4][4], int mb, int nb, int lane) const {
    const int fr = lane & 15, fg = lane >> 4;
#pragma unroll
    for (int mt = 0; mt < 4; ++mt) { const int m = mb + mt * 16 + fr; if (m < n) {
#pragma unroll
      for (int nt = 0; nt < 4; ++nt) { const f32x4 a = acc[mt][nt]; u32x2 o; o.x = pk2(a.x, a.y); o.y = pk2(a.z, a.w); *(u32x2*)(y + (size_t)m * FD + nb + nt * 16 + fg * 4) = o; } } }
  } };
template <int WHICH>
__device__ __forceinline__ void ph_moe_gemm(const FP& f, char* lds) {
  int tbase = 0, offe = 0;
#pragma unroll 1
  for (int e = 0; e < 16; ++e) {
    const int n = f.cnt[e]; const int ntm = (n + 255) >> 8, ntile = ntm * 8;
    int first = (int)blockIdx.x - (tbase % (int)gridDim.x); if (first < 0) first += gridDim.x;
    for (int q = first; q < ntile; q += gridDim.x) {
      const int tm = q >> 3, tn = q & 7;
      if (WHICH == 0) { ARowGather ar{f.hb, f.list + (size_t)e * FT, n}; EpiGU ep{f.act + (size_t)offe * 512, n}; gemm_tile<4, 2>(ar, f.moe_gu + (size_t)e * FD * FD, FD, FD, tm * 256, tn * 128, lds, ep); }
      else { ARowAct ar{f.act + (size_t)offe * 512, n}; EpiDown ep{f.ymoe + (size_t)offe * FD, n}; gemm_tile<4, 2>(ar, f.moe_d + (size_t)e * FD * 512, 512, 512, tm * 256, tn * 128, lds, ep); }
    }
    tbase += ntile; offe += n;
  }
}
__device__ __forceinline__ void ph_moe_combine(const FP& f, int layer) {
  const int lane = TIDX & 63, gw = blockIdx.x * (NT / 64) + (TIDX >> 6), ngw = gridDim.x * (NT / 64);
  int off[17]; off[0] = 0;
#pragma unroll
  for (int e = 0; e < 16; ++e) off[e + 1] = off[e] + f.cnt[e];
  for (int t = gw; t < FT; t += ngw) {
    const int b = t / FS, s = t - b * FS; if (layer == 1 && s < FLC) continue;
    const int e0 = f.tok_e[t * 2], e1 = f.tok_e[t * 2 + 1]; int o0 = 0, o1 = 0;
#pragma unroll
    for (int e = 0; e < 16; ++e) { o0 = e == e0 ? off[e] : o0; o1 = e == e1 ? off[e] : o1; }
    const bf16_t* y0 = f.ymoe + (size_t)(o0 + f.tok_pos[t * 2]) * FD; const bf16_t* y1 = f.ymoe + (size_t)(o1 + f.tok_pos[t * 2 + 1]) * FD;
    const float w0 = f.tok_w[t * 2], w1 = f.tok_w[t * 2 + 1]; float* xr = f_xs_row(f, t); const float* md = f_modrow(f, layer, t) + 5 * FD;
#pragma unroll
    for (int j = 0; j < 4; ++j) { const int c = j * 256 + lane * 4; const u32x2 a = *(const u32x2*)(y0 + c), bq = *(const u32x2*)(y1 + c); f32x4 x = *(f32x4*)(xr + c); const f32x4 g = *(const f32x4*)(md + c);
      x.x += g.x * (w0 * bflo(a.x) + w1 * bflo(bq.x)); x.y += g.y * (w0 * bfhi(a.x) + w1 * bfhi(bq.x)); x.z += g.z * (w0 * bflo(a.y) + w1 * bflo(bq.y)); x.w += g.w * (w0 * bfhi(a.y) + w1 * bfhi(bq.y));
      *(f32x4*)(xr + c) = x; }
  }
}
namespace g8 {
#define G8_LAS __attribute__((address_space(3)))
constexpr int BM = 256, BK = 64, HALF = 128, HTB = HALF * BK * 2, STAGE_BYTES = 8 * HTB;
__host__ __device__ __forceinline__ int lds_byte(int r, int c) { const int st = (r >> 4) * 2 + (c >> 5), rr = r & 15, cc = c & 31, ob = rr * 64 + cc * 2; return st * 1024 + (ob ^ (((ob >> 9) & 1) << 5)); }
__host__ __device__ __forceinline__ void stage_rc(int b, int& R, int& C) { const int st = b / 1024, sb = b % 1024, swz = sb ^ (((sb >> 9) & 1) << 5); R = (st >> 1) * 16 + swz / 64; C = (st & 1) * 32 + (swz % 64) / 2; }
struct Unit { int pm, pn, e, nrows, roff; };
template <class Epi, class Sched>
__device__ __forceinline__ void gemm_phase(G8_LAS unsigned char* lds, const int K, const Sched& S, const Epi& E) {
  const int tid = TIDX, wid = __builtin_amdgcn_readfirstlane(tid >> 6), lane = tid & 63, wr = wid >> 2, wc = wid & 3, fr = lane & 15, fq = lane >> 4;
  const int nt = K / BK;
  unsigned voffB[2];
#pragma unroll
  for (int i = 0; i < 2; ++i) { int R_, C_; stage_rc(tid * 16 + i * 8192, R_, C_); voffB[i] = (unsigned)(R_ * K + C_) * 2u; }
#define G8_AOFF(dst, U) _Pragma("unroll") for (int h = 0; h < 2; ++h) _Pragma("unroll") for (int i = 0; i < 2; ++i) { int R_, C_; stage_rc(tid * 16 + i * 8192, R_, C_); dst[h][i] = S.a_off(U, h * HALF + R_) + (unsigned)C_ * 2u; }
  const size_t kstep = (size_t)(BK * 2); const size_t hstepB = (size_t)HALF * K * 2;
  const unsigned ldsw = (unsigned)wid * 1024u;
  const int aoff = lds_byte(wr * 64 + fr, fq * 8), boff = lds_byte(wc * 32 + fr, fq * 8);
#define G8_SA(b, h) (((b) * 2 + (h)) * HTB)
#define G8_SB(b, h) ((4 + (b) * 2 + (h)) * HTB)
#define G8_STAGEB(bufoff, gbase) do { _Pragma("unroll") for (int _i = 0; _i < 2; ++_i) \
    __builtin_amdgcn_global_load_lds((const unsigned*)((const char*)(gbase) + voffB[_i]), (G8_LAS unsigned*)(lds + (bufoff) + ldsw + _i * 8192), 16, 0, 0); } while (0)
#define G8_STAGEA(bufoff, offs, kb) do { _Pragma("unroll") for (int _i = 0; _i < 2; ++_i) \
    __builtin_amdgcn_global_load_lds((const unsigned*)(abase + (size_t)(offs)[_i] + (kb)), (G8_LAS unsigned*)(lds + (bufoff) + ldsw + _i * 8192), 16, 0, 0); } while (0)
#define G8_LDA(dst, b, h) do { _Pragma("unroll") for (int m = 0; m < 4; ++m) _Pragma("unroll") for (int k = 0; k < 2; ++k) dst[m][k] = *(const G8_LAS bf16x8*)(lds + G8_SA(b, h) + aoff + m * 2048 + k * 1024); } while (0)
#define G8_LDB(dst, b, h) do { _Pragma("unroll") for (int n = 0; n < 2; ++n) _Pragma("unroll") for (int k = 0; k < 2; ++k) dst[n][k] = *(const G8_LAS bf16x8*)(lds + G8_SB(b, h) + boff + n * 2048 + k * 1024); } while (0)
#define G8_MMA(ai, bj, At, Bt) do { __builtin_amdgcn_s_setprio(1); _Pragma("unroll") for (int m = 0; m < 4; ++m) _Pragma("unroll") for (int n = 0; n < 2; ++n) _Pragma("unroll") for (int k = 0; k < 2; ++k) \
    acc[ai][bj][m][n] = __builtin_amdgcn_mfma_f32_16x16x32_bf16(Bt[n][k], At[m][k], acc[ai][bj][m][n], 0, 0, 0); __builtin_amdgcn_s_setprio(0); } while (0)
#define G8_WAIT_V(n) asm volatile("s_waitcnt vmcnt(" #n ")" ::: "memory")
#define G8_WAIT_L(n) asm volatile("s_waitcnt lgkmcnt(" #n ")" ::: "memory")
#define G8_BAR __builtin_amdgcn_s_barrier()
#define G8_SCHED __builtin_amdgcn_sched_barrier(0)
  Unit cur, nxt; int ui = 0;
  if (!S.next(0, cur)) return;
  f32x4 acc[2][2][4][2];
#pragma unroll
  for (int a = 0; a < 2; ++a)
#pragma unroll
    for (int b = 0; b < 2; ++b)
#pragma unroll
      for (int m = 0; m < 4; ++m)
#pragma unroll
        for (int n = 0; n < 2; ++n) acc[a][b][m][n] = (f32x4){0.f, 0.f, 0.f, 0.f};
  bf16x8 At[4][2], B0[2][2], B1[2][2];
  const char* abase = S.a_base();
  unsigned ca[2][2], na[2][2];
  G8_AOFF(ca, cur)
  const char* cB = S.b_rows(cur);
  G8_STAGEB(G8_SB(0, 0), cB); G8_STAGEA(G8_SA(0, 0), ca[0], 0); G8_STAGEB(G8_SB(0, 1), cB + hstepB); G8_STAGEA(G8_SA(0, 1), ca[1], 0);
  if (wr == 1) G8_BAR;
  G8_WAIT_V(4); G8_BAR;
  G8_STAGEB(G8_SB(1, 0), cB + kstep); G8_STAGEA(G8_SA(1, 0), ca[0], kstep); G8_STAGEB(G8_SB(1, 1), cB + hstepB + kstep);
  G8_WAIT_V(6); G8_BAR;
  for (;;) {
    const bool has_next = S.next(ui + 1, nxt);
    const char* nB = has_next ? S.b_rows(nxt) : cB;
    if (!Sched::LAZY_NEXT) { if (has_next) { G8_AOFF(na, nxt) } else {
#pragma unroll
      for (int h = 0; h < 2; ++h)
#pragma unroll
        for (int i = 0; i < 2; ++i) na[h][i] = ca[h][i]; } }
    for (int t = 0; t < nt; t += 2) {
      const bool last = (t == nt - 2);
      const size_t k1 = (size_t)(t + 1) * kstep;
      const size_t k2 = last ? 0 : (size_t)(t + 2) * kstep; const size_t k3 = k2 + kstep;
      const char* b2 = last ? nB : cB + (size_t)(t + 2) * kstep; const char* b3 = b2 + kstep;
      G8_LDB(B0, 0, 0); G8_SCHED; G8_LDA(At, 0, 0); G8_STAGEA(G8_SA(1, 1), ca[1], k1);
      if (last) {
        if (Sched::LAZY_NEXT) { if (has_next) { G8_AOFF(ca, nxt) } }
        else {
#pragma unroll
          for (int h = 0; h < 2; ++h)
#pragma unroll
            for (int i = 0; i < 2; ++i) ca[h][i] = na[h][i]; } }
      G8_WAIT_L(8); G8_BAR; G8_WAIT_L(0); G8_MMA(0, 0, At, B0); G8_BAR; G8_SCHED;
      G8_LDB(B1, 0, 1); G8_STAGEB(G8_SB(0, 0), b2);
      G8_BAR; G8_WAIT_L(0); G8_MMA(0, 1, At, B1); G8_BAR;
      G8_LDA(At, 0, 1); G8_STAGEA(G8_SA(0, 0), ca[0], k2);
      G8_BAR; G8_WAIT_L(0); G8_MMA(1, 0, At, B0); G8_BAR; G8_SCHED;
      G8_STAGEB(G8_SB(0, 1), b2 + hstepB);
      G8_WAIT_V(6); G8_BAR; G8_MMA(1, 1, At, B1); G8_BAR;
      G8_LDB(B0, 1, 0); G8_SCHED; G8_LDA(At, 1, 0); G8_STAGEA(G8_SA(0, 1), ca[1], k2);
      G8_WAIT_L(8); G8_BAR; G8_WAIT_L(0); G8_MMA(0, 0, At, B0); G8_BAR; G8_SCHED;
      G8_LDB(B1, 1, 1); G8_STAGEB(G8_SB(1, 0), b3);
      G8_BAR; G8_WAIT_L(0); G8_MMA(0, 1, At, B1); G8_BAR;
      G8_LDA(At, 1, 1); G8_STAGEA(G8_SA(1, 0), ca[0], k3);
      G8_BAR; G8_WAIT_L(0); G8_MMA(1, 0, At, B0); G8_BAR; G8_SCHED;
      G8_STAGEB(G8_SB(1, 1), b3 + hstepB);
      G8_WAIT_V(6); G8_BAR; G8_MMA(1, 1, At, B1); G8_BAR;
    }
    E(acc, cur, wr, wc, fr, fq);
    if (!has_next) break;
#pragma unroll
    for (int a = 0; a < 2; ++a)
#pragma unroll
      for (int b = 0; b < 2; ++b)
#pragma unroll
        for (int m = 0; m < 4; ++m)
#pragma unroll
          for (int n = 0; n < 2; ++n) acc[a][b][m][n] = (f32x4){0.f, 0.f, 0.f, 0.f};
    cur = nxt; cB = nB; ++ui;
  }
  G8_WAIT_V(0);
  if (wr == 0) G8_BAR;
  G8_BAR;
#undef G8_AOFF
#undef G8_SA
#undef G8_SB
#undef G8_STAGEA
#undef G8_STAGEB
#undef G8_LDA
#undef G8_LDB
#undef G8_MMA
#undef G8_WAIT_V
#undef G8_WAIT_L
#undef G8_BAR
#undef G8_SCHED
}
struct SchedDense { static constexpr bool LAZY_NEXT = true; const char* A; const char* Bt; int K, nM, nN, G, c; int m_skip_mod;
  __device__ bool next(int i, Unit& u) const { const long L = (long)i * G + c; const int total = nM * nN; if (L >= total) return false;
    const int grp = 8 * nN; const int g = (int)L / grp, r = (int)L % grp; const int gsz = (nM - g * 8) < 8 ? (nM - g * 8) : 8; int pm = g * 8 + r % gsz; const int pn = r / gsz;
    if (m_skip_mod > 0) pm = pm + pm / (m_skip_mod - 1) + 1;
    u.pm = pm; u.pn = pn; u.e = 0; u.nrows = 1 << 30; u.roff = 0; return true; }
  __device__ const char* a_base() const { return A; }
  __device__ unsigned a_off(const Unit& u, int row) const { return (unsigned)((size_t)(u.pm * 256 + row) * K * 2); }
  __device__ const char* b_rows(const Unit& u) const { return Bt + (size_t)u.pn * 256 * K * 2; }
};
}
namespace g8 {
template <int WHICH> struct SchedMoE { static constexpr bool LAZY_NEXT = (WHICH == 1); const FP* f; int G, c;
  __device__ bool next(int i, Unit& u) const { int L = i * G + c; int roff = 0; bool found = false;
    u.pm = 0; u.pn = 0; u.e = 0; u.nrows = 1; u.roff = 0;
#pragma unroll
    for (int e = 0; e < 16; ++e) { const int n = __builtin_amdgcn_readfirstlane(__hip_atomic_load(f->cnt + e, __ATOMIC_RELAXED, __HIP_MEMORY_SCOPE_AGENT));   const int nu = ((n + 255) >> 8) * 4; const bool hit = !found && L < nu;
      if (hit) { u.pm = L >> 2; u.pn = L & 3; u.e = e; u.nrows = n; u.roff = roff; found = true; }
      if (!found) { L -= nu; roff += n; } }
    return found; }
  __device__ const char* a_base() const { return WHICH == 0 ? (const char*)f->hb : (const char*)f->act; }
  __device__ unsigned a_off(const Unit& u, int row) const { int m = u.pm * 256 + row; m = m < u.nrows ? m : u.nrows - 1;
    if (WHICH == 0) return (unsigned)f->list[(size_t)u.e * FT + m] * (unsigned)(FD * 2); else return (unsigned)(u.roff + m) * 1024u; }
  __device__ const char* b_rows(const Unit& u) const { return WHICH == 0 ? (const char*)(f->moe_gu + (size_t)u.e * FD * FD + (size_t)u.pn * 256 * FD) : (const char*)(f->moe_d + (size_t)u.e * FD * 512 + (size_t)u.pn * 256 * 512); }
};
#define G8_ROWS_BEGIN _Pragma("unroll") for (int ai = 0; ai < 2; ++ai) _Pragma("unroll") for (int m = 0; m < 4; ++m) { const int rl = ai * 128 + wr * 64 + m * 16 + fr;
#define G8_ROWS_END }
struct EpiIn0 { const FP* f;
  __device__ void operator()(const f32x4 (&acc)[2][2][4][2], const Unit& u, int wr, int wc, int fr, int fq) const {
#pragma unroll
    for (int bj = 0; bj < 2; ++bj) { const int cb = u.pn * 256 + bj * 128 + wc * 32; if (cb >= Z0_N) continue;
      const float sc = cb < Z0_GK ? 0.17677669529663687f : 1.f; const bool isv = cb >= Z0_AV && cb < Z0_GDEC;
      G8_ROWS_BEGIN { const int row = u.pm * 256 + rl;
        if (isv) { const int b = row / FS, s = row - b * FS; const int kvh = (cb - Z0_AV) >> 6, j0 = ((cb - Z0_AV) & 63) + 4 * fq;
#pragma unroll
          for (int n = 0; n < 2; ++n)
#pragma unroll
            for (int i = 0; i < 4; ++i) f->vT[((size_t)(b * 2 + kvh) * 64 + j0 + n * 16 + i) * FS + s] = f2bf(acc[ai][bj][m][n][i]);
        } else { bf16_t* zr = f->zf + (size_t)row * Z0_LD + cb + 4 * fq;
#pragma unroll
          for (int n = 0; n < 2; ++n) { const f32x4 a = acc[ai][bj][m][n] * sc; u32x2 o; o.x = pk2(a.x, a.y); o.y = pk2(a.z, a.w); *(u32x2*)(zr + n * 16) = o; } } } G8_ROWS_END
    } } };
struct EpiPlain { bf16_t* z; int ld, ncols;
  __device__ void operator()(const f32x4 (&acc)[2][2][4][2], const Unit& u, int wr, int wc, int fr, int fq) const {
#pragma unroll
    for (int bj = 0; bj < 2; ++bj) { const int cb = u.pn * 256 + bj * 128 + wc * 32; if (cb >= ncols) continue;
      G8_ROWS_BEGIN { bf16_t* zr = z + (size_t)(u.pm * 256 + rl) * ld + cb + 4 * fq;
#pragma unroll
        for (int n = 0; n < 2; ++n) { const f32x4 a = acc[ai][bj][m][n]; u32x2 o; o.x = pk2(a.x, a.y); o.y = pk2(a.z, a.w); *(u32x2*)(zr + n * 16) = o; } } G8_ROWS_END
    } } };
template <int LAYER> struct EpiOutProj { const FP* f;
  __device__ void operator()(const f32x4 (&acc)[2][2][4][2], const Unit& u, int wr, int wc, int fr, int fq) const {
    G8_ROWS_BEGIN { const int row = u.pm * 256 + rl; float* xo = f_xs_row(*f, row); const float* xi = LAYER == 0 ? f_xin_row(*f, row) : xo; const float* md = f_modrow(*f, LAYER, row) + 2 * FD;
#pragma unroll
      for (int bj = 0; bj < 2; ++bj)
#pragma unroll
        for (int n = 0; n < 2; ++n) { const int c = u.pn * 256 + bj * 128 + wc * 32 + n * 16 + 4 * fq; const f32x4 x = *(const f32x4*)(xi + c), g = *(const f32x4*)(md + c); *(f32x4*)(xo + c) = x + g * acc[ai][bj][m][n]; } } G8_ROWS_END
  } };
struct EpiGU { const FP* f;
  __device__ void operator()(const f32x4 (&acc)[2][2][4][2], const Unit& u, int wr, int wc, int fr, int fq) const {
    G8_ROWS_BEGIN { const int mrow = u.pm * 256 + rl; if (mrow < u.nrows) { bf16_t* ar = f->act + (size_t)(u.roff + mrow) * 512;
#pragma unroll
      for (int bj = 0; bj < 2; ++bj) { const f32x4 g = acc[ai][bj][m][0], up = acc[ai][bj][m][1]; u32x2 o; o.x = pk2(fsilu(g.x) * up.x, fsilu(g.y) * up.y); o.y = pk2(fsilu(g.z) * up.z, fsilu(g.w) * up.w);
        *(u32x2*)(ar + ((u.pn * 256 + bj * 128 + wc * 32) >> 1) + 4 * fq) = o; } } } G8_ROWS_END
  } };
struct EpiDown { const FP* f;
  __device__ void operator()(const f32x4 (&acc)[2][2][4][2], const Unit& u, int wr, int wc, int fr, int fq) const {
    G8_ROWS_BEGIN { const int mrow = u.pm * 256 + rl; if (mrow < u.nrows) { bf16_t* yr = f->ymoe + (size_t)(u.roff + mrow) * FD;
#pragma unroll
      for (int bj = 0; bj < 2; ++bj)
#pragma unroll
        for (int n = 0; n < 2; ++n) { const f32x4 a = acc[ai][bj][m][n]; u32x2 o; o.x = pk2(a.x, a.y); o.y = pk2(a.z, a.w); *(u32x2*)(yr + u.pn * 256 + bj * 128 + wc * 32 + n * 16 + 4 * fq) = o; } } } G8_ROWS_END
  } };
}
struct RowMapGate8 { __device__ int operator()(int j) const { return (j >> 4) * 32 + (j & 15); } };
struct RowMapUp8 { __device__ int operator()(int j) const { return (j >> 4) * 32 + 16 + (j & 15); } };
constexpr float QK_SCALE_LOG2E = 0.125f * 1.4426950408889634f;
struct EpiIn0 { const FP* f;
  __device__ void operator()(f32x4 (&acc)[4][4], int mb, int nb, int lane) const {
    const int fr = lane & 15, fg = lane >> 4; const FP& F = *f;
    if (nb >= Z0_AQ && nb < Z0_AV) {
      const bool isq = nb < Z0_AK; const float* gn = isq ? F.p.att_q_norm : F.p.att_k_norm; const float osc = isq ? QK_SCALE_LOG2E : 1.f;
      f32x4 g[4];
#pragma unroll
      for (int nt = 0; nt < 4; ++nt) g[nt] = *(const f32x4*)(gn + nt * 16 + fg * 4);
      float inv[4];
#pragma unroll
      for (int r = 0; r < 4; ++r) inv[r] = exp2f(-(float)(fg * 4 + r) * 0.8304820237218406f);
#pragma unroll
      for (int mt = 0; mt < 4; ++mt) {
        const int m = mb + mt * 16 + fr; const int b = m / FS, s = m - b * FS;
        float ss = 0.f;
#pragma unroll
        for (int nt = 0; nt < 4; ++nt) ss += acc[mt][nt].x * acc[mt][nt].x + acc[mt][nt].y * acc[mt][nt].y + acc[mt][nt].z * acc[mt][nt].z + acc[mt][nt].w * acc[mt][nt].w;
        ss += __shfl_xor(ss, 16); ss += __shfl_xor(ss, 32);
        const float ri = 1.f / sqrtf(ss * (1.f / 64.f) + 1e-6f);
#pragma unroll
        for (int nt = 0; nt < 4; ++nt) acc[mt][nt] = acc[mt][nt] * ri * g[nt];
        if (s >= FLC) {
          const int pos = s - FLC; const float prow = (float)(pos >> 6), pcol = (float)(pos & 63);
#pragma unroll
          for (int r = 0; r < 4; ++r) {
            float a = prow * inv[r], cs = __cosf(a), sn = __sinf(a); float t1 = acc[mt][0][r], t2 = acc[mt][2][r]; acc[mt][0][r] = t1 * cs - t2 * sn; acc[mt][2][r] = t1 * sn + t2 * cs;
            a = pcol * inv[r]; cs = __cosf(a); sn = __sinf(a); t1 = acc[mt][1][r]; t2 = acc[mt][3][r]; acc[mt][1][r] = t1 * cs - t2 * sn; acc[mt][3][r] = t1 * sn + t2 * cs;
          }
        }
#pragma unroll
        for (int nt = 0; nt < 4; ++nt) acc[mt][nt] = acc[mt][nt] * osc;
      }
    } else if (nb < Z0_GK) {
#pragma unroll
      for (int mt = 0; mt < 4; ++mt)
#pragma unroll
        for (int nt = 0; nt < 4; ++nt) acc[mt][nt] = acc[mt][nt] * 0.17677669529663687f;
    }
    if (nb >= Z0_AV && nb < Z0_GDEC) {
      const int kvh = (nb - Z0_AV) >> 6;
#pragma unroll
      for (int mt = 0; mt < 4; ++mt) { const int m = mb + mt * 16 + fr; const int b = m / FS, s = m - b * FS;
#pragma unroll
        for (int nt = 0; nt < 4; ++nt)
#pragma unroll
          for (int r = 0; r < 4; ++r) F.vT[((size_t)(b * 2 + kvh) * 64 + nt * 16 + fg * 4 + r) * FS + s] = f2bf(acc[mt][nt][r]); }
      return;
    }
#pragma unroll
    for (int mt = 0; mt < 4; ++mt) { bf16_t* zr = F.zf + (size_t)(mb + mt * 16 + fr) * Z0_LD + nb + fg * 4;
#pragma unroll
      for (int nt = 0; nt < 4; ++nt) { u32x2 o; o.x = pk2(acc[mt][nt].x, acc[mt][nt].y); o.y = pk2(acc[mt][nt].z, acc[mt][nt].w); *(u32x2*)(zr + nt * 16) = o; } }
  } };
__device__ __forceinline__ void ph_inproj0(const FP& f, const bf16_t* wt, int tm0, int tm1, char* lds) {
  ARowPlain ar{f.hb, FD}; EpiIn0 ep{&f}; const int ntn = Z0_LD / 128, ntiles = (tm1 - tm0) * ntn;
  for (int t = blockIdx.x; t < ntiles; t += gridDim.x) { const int tm = tm0 + t / ntn, tn = t % ntn; gemm_tile<4, 2>(ar, wt, FD, FD, tm * 256, tn * 128, lds, ep); }
}

__device__ __forceinline__ void store4(float* p, f32x4 v) { *(f32x4*)p = v; }
__device__ __forceinline__ void store4(bf16_t* p, f32x4 v) { u32x2 o; o.x = pk2(v.x, v.y); o.y = pk2(v.z, v.w); *(u32x2*)p = o; }
constexpr int ATT_LDS = 2 * 16384;
__device__ __forceinline__ void qk_fix_q(const FP& f, bf16x8& x0, bf16x8& x1, int fg, bool lat, int pos) {
  const u32x4 u0 = __builtin_bit_cast(u32x4, x0), u1 = __builtin_bit_cast(u32x4, x1); float a[8], c[8];
  a[0] = bflo(u0.x); a[1] = bfhi(u0.x); a[2] = bflo(u0.y); a[3] = bfhi(u0.y); a[4] = bflo(u0.z); a[5] = bfhi(u0.z); a[6] = bflo(u0.w); a[7] = bfhi(u0.w);
  c[0] = bflo(u1.x); c[1] = bfhi(u1.x); c[2] = bflo(u1.y); c[3] = bfhi(u1.y); c[4] = bflo(u1.z); c[5] = bfhi(u1.z); c[6] = bflo(u1.w); c[7] = bfhi(u1.w);
  float ss = 0.f;
#pragma unroll
  for (int j = 0; j < 8; ++j) ss += a[j] * a[j] + c[j] * c[j];
  ss += __shfl_xor(ss, 16); ss += __shfl_xor(ss, 32);
  const float ri = 1.f / sqrtf(ss * (1.f / 64.f) + 1e-6f);
  const float p = (fg < 2) ? (float)(pos >> 6) : (float)(pos & 63);
#pragma unroll
  for (int j = 0; j < 8; ++j) { const int d = fg * 8 + j; float t1 = a[j] * ri * f.p.att_q_norm[d], t2 = c[j] * ri * f.p.att_q_norm[32 + d];
    if (lat) { const float ang = p * exp2f(-(float)(d & 15) * 0.8304820237218406f), cs = __cosf(ang), sn = __sinf(ang); const float r1 = t1 * cs - t2 * sn, r2 = t1 * sn + t2 * cs; t1 = r1; t2 = r2; }
    a[j] = t1 * QK_SCALE_LOG2E; c[j] = t2 * QK_SCALE_LOG2E; }
  x0 = pack8(a); x1 = pack8(c);
}
__device__ __forceinline__ void qk_fix_k(const FP& f, u32x4& rk, int lkc, bool lat, int pos) {
  float a[8]; a[0] = bflo(rk.x); a[1] = bfhi(rk.x); a[2] = bflo(rk.y); a[3] = bfhi(rk.y); a[4] = bflo(rk.z); a[5] = bfhi(rk.z); a[6] = bflo(rk.w); a[7] = bfhi(rk.w);
  float ss = 0.f;
#pragma unroll
  for (int j = 0; j < 8; ++j) ss += a[j] * a[j];
  ss += __shfl_xor(ss, 1); ss += __shfl_xor(ss, 2); ss += __shfl_xor(ss, 4);
  const float ri = 1.f / sqrtf(ss * (1.f / 64.f) + 1e-6f);
#pragma unroll
  for (int j = 0; j < 8; ++j) a[j] = a[j] * ri * f.p.att_k_norm[lkc * 8 + j];
  if (lat) { const float p = ((lkc & 3) < 2) ? (float)(pos >> 6) : (float)(pos & 63);
#pragma unroll
    for (int j = 0; j < 8; ++j) { const float other = __shfl_xor(a[j], 4); const int d = (lkc & 3) * 8 + j; const float ang = p * exp2f(-(float)(d & 15) * 0.8304820237218406f), cs = __cosf(ang), sn = __sinf(ang);
      a[j] = lkc < 4 ? a[j] * cs - other * sn : other * sn + a[j] * cs; } }
  rk.x = pk2(a[0], a[1]); rk.y = pk2(a[2], a[3]); rk.z = pk2(a[4], a[5]); rk.w = pk2(a[6], a[7]);
}
template <class OutT, bool RAWQK = false>
__device__ __forceinline__ void ph_attn(const FP& f, int b_lo, int b_hi, OutT* cat, int ldc, char* lds, bool rev = false) {
  const int tid = TIDX, lane = tid & 63, w = tid >> 6, fr = lane & 15, fg = lane >> 4;
  const int nb_ = b_hi - b_lo; const int n_lat = nb_ * 64 * 2, n_items = n_lat + nb_ * 4 * 2;
  const int lrow = tid >> 3, lkc = tid & 7;
  for (int item = rev ? gridDim.x - 1 - blockIdx.x : blockIdx.x; item < n_items; item += gridDim.x) {
    int b, kvh, q0; bool is_ctx = false;
    if (item < n_lat) { b = b_lo + item / 128; const int r = item % 128; q0 = (r >> 1) * 64; kvh = r & 1; } else { const int r = item - n_lat; is_ctx = true; b = b_lo + r / 8; q0 = ((r % 8) >> 1) * 64; kvh = r & 1; }
    const int hq = kvh * 4 + (w & 3); const int qw = q0 + 32 * (w >> 2); const int tq0 = b * FS + (is_ctx ? 0 : FLC) + qw;
    bf16x8 qf[2][2];
#pragma unroll
    for (int qt = 0; qt < 2; ++qt)
#pragma unroll
      for (int kh = 0; kh < 2; ++kh) qf[qt][kh] = *(const bf16x8*)(f.zf + (size_t)(tq0 + qt * 16 + fr) * Z0_LD + Z0_AQ + hq * 64 + kh * 32 + fg * 8);
    if (RAWQK) {
#pragma unroll
      for (int qt = 0; qt < 2; ++qt) qk_fix_q(f, qf[qt][0], qf[qt][1], fg, !is_ctx, qw + qt * 16 + fr);
    }
    f32x4 ot[4][2];
#pragma unroll
    for (int i = 0; i < 4; ++i)
#pragma unroll
      for (int j = 0; j < 2; ++j) ot[i][j] = (f32x4){0.f, 0.f, 0.f, 0.f};
    const float sinkl = f.p.att_sink[hq] * 1.4426950408889634f;
    float mrow[2], lsum[2];
#pragma unroll
    for (int qt = 0; qt < 2; ++qt) { mrow[qt] = sinkl; lsum[qt] = fg == 0 ? 1.f : 0.f; }
    u32x4 rk, rv;
    auto tile_valid = [&](int i) -> bool { if (i >= 5) return true; if (is_ctx) return false; const int k0 = q0 - 128 + 64 * i; return k0 >= 0 && k0 < FL; };
    auto tile_tok0 = [&](int i) -> int { return i >= 5 ? 64 * (i - 5) : FLC + q0 - 128 + 64 * i; };
    auto issue = [&](int i) { const int s0 = tile_tok0(i);
      rk = *(const u32x4*)(f.zf + (size_t)(b * FS + s0 + lrow) * Z0_LD + Z0_AK + kvh * 64 + lkc * 8);
      rv = *(const u32x4*)(f.vT + ((size_t)(b * 2 + kvh) * 64 + lrow) * FS + s0 + lkc * 8);
      if (RAWQK) qk_fix_k(f, rk, lkc, i < 5, s0 - FLC + lrow); };
    auto commit = [&](int buf) { char* kb = lds + buf * 16384; char* vb = kb + 8192;
      *(u32x4*)(kb + lrow * 128 + ((lkc ^ (lrow & 7)) << 4)) = rk;
      *(u32x4*)(vb + lrow * 128 + (((2 * lkc) ^ (lrow & 14)) << 3)) = rv; };
    int ifirst = 0; while (!tile_valid(ifirst)) ++ifirst;
    __syncthreads();
    issue(ifirst); commit(0);
    __syncthreads();
    int cur = 0;
#pragma unroll 1
    for (int i = ifirst; i < 9; ++i) {
      if (!tile_valid(i)) continue;
      int inext = i + 1; while (inext < 9 && !tile_valid(inext)) ++inext;
      if (inext < 9) issue(inext);
      {
        const char* kb = lds + cur * 16384; const char* vb = kb + 8192;
        f32x4 st[4][2];
#pragma unroll
        for (int a = 0; a < 4; ++a)
#pragma unroll
          for (int c = 0; c < 2; ++c) st[a][c] = (f32x4){0.f, 0.f, 0.f, 0.f};
#pragma unroll
        for (int kh = 0; kh < 2; ++kh) {
          bf16x8 kf[4];
#pragma unroll
          for (int kt = 0; kt < 4; ++kt) { const int row = kt * 16 + fr; kf[kt] = *(const bf16x8*)(kb + row * 128 + (((kh * 4 + fg) ^ (row & 7)) << 4)); }
#pragma unroll
          for (int kt = 0; kt < 4; ++kt)
#pragma unroll
            for (int c = 0; c < 2; ++c) st[kt][c] = __builtin_amdgcn_mfma_f32_16x16x32_bf16(kf[kt], qf[c][kh], st[kt][c], 0, 0, 0);
        }
        if (i < 5) {
          const int k0 = q0 - 128 + 64 * i;
#pragma unroll
          for (int kt = 0; kt < 4; ++kt)
#pragma unroll
            for (int c = 0; c < 2; ++c)
#pragma unroll
              for (int r = 0; r < 4; ++r) { const int dk = (k0 + kt * 16 + fg * 4 + r) - (qw + c * 16 + fr); if (dk > 128 || dk < -128) st[kt][c][r] = -1e30f; }
        }
        bf16x8 pf[2][2];
#pragma unroll
        for (int c = 0; c < 2; ++c) {
          float mx = mrow[c];
#pragma unroll
          for (int kt = 0; kt < 4; ++kt) mx = fmaxf(mx, fmaxf(fmaxf(st[kt][c].x, st[kt][c].y), fmaxf(st[kt][c].z, st[kt][c].w)));
          mx = fmaxf(mx, __shfl_xor(mx, 16)); mx = fmaxf(mx, __shfl_xor(mx, 32));
          const float alpha = exp2f(mrow[c] - mx); mrow[c] = mx; float ps = 0.f;
#pragma unroll
          for (int kt = 0; kt < 4; ++kt) { f32x4 p; p.x = exp2f(st[kt][c].x - mx); p.y = exp2f(st[kt][c].y - mx); p.z = exp2f(st[kt][c].z - mx); p.w = exp2f(st[kt][c].w - mx); ps += (p.x + p.y) + (p.z + p.w); st[kt][c] = p; }
          lsum[c] = lsum[c] * alpha + ps;
#pragma unroll
          for (int nt = 0; nt < 4; ++nt) ot[nt][c] = ot[nt][c] * alpha;
#pragma unroll
          for (int ks = 0; ks < 2; ++ks) { u32x4 u; u.x = pk2(st[2 * ks][c].x, st[2 * ks][c].y); u.y = pk2(st[2 * ks][c].z, st[2 * ks][c].w); u.z = pk2(st[2 * ks + 1][c].x, st[2 * ks + 1][c].y); u.w = pk2(st[2 * ks + 1][c].z, st[2 * ks + 1][c].w); pf[c][ks] = __builtin_bit_cast(bf16x8, u); }
        }
#pragma unroll
        for (int ks = 0; ks < 2; ++ks) {
          bf16x8 vf[4];
#pragma unroll
          for (int nt = 0; nt < 4; ++nt) { const int row = nt * 16 + fr; const char* rp = vb + row * 128; const int c0 = (8 * ks + fg) ^ (row & 14), c1 = (8 * ks + 4 + fg) ^ (row & 14);
            const u32x2 lo = *(const u32x2*)(rp + (c0 << 3)), hi = *(const u32x2*)(rp + (c1 << 3)); u32x4 u; u.x = lo.x; u.y = lo.y; u.z = hi.x; u.w = hi.y; vf[nt] = __builtin_bit_cast(bf16x8, u); }
#pragma unroll
          for (int nt = 0; nt < 4; ++nt)
#pragma unroll
            for (int c = 0; c < 2; ++c) ot[nt][c] = __builtin_amdgcn_mfma_f32_16x16x32_bf16(vf[nt], pf[c][ks], ot[nt][c], 0, 0, 0);
        }
      }
      if (inext < 9) commit(cur ^ 1);
      __syncthreads();
      cur ^= 1;
    }
#pragma unroll
    for (int c = 0; c < 2; ++c) { float l = lsum[c]; l += __shfl_xor(l, 16); l += __shfl_xor(l, 32); const float il = 1.f / l;
      OutT* dst = cat + (size_t)(tq0 + c * 16 + fr) * ldc + 512 + hq * 64 + fg * 4;
#pragma unroll
      for (int nt = 0; nt < 4; ++nt) store4(dst + nt * 16, ot[nt][c] * il); }
  }
}
__device__ __forceinline__ float flogsigm(float x) { return x < 0.f ? x - __logf(1.f + __expf(x)) : -__logf(1.f + __expf(-x)); }
constexpr int GLA_A_LDS = 2 * 64 * 33 * 4 + 64 * 65 * 4;
__device__ __forceinline__ void ph_gla_a(const FP& f, int b_lo, int b_hi, char* lds) {
  float* kbar = (float*)lds; float* vl = kbar + 2 * 64 * 33;
  const int tid = TIDX; const int nitems = (b_hi - b_lo) * 8 * 68;
  for (int item = blockIdx.x; item < nitems; item += gridDim.x) {
    const int b = b_lo + item / (8 * 68), h = (item / 68) % 8, c = item % 68; const int t0 = b * FS + c * 64;
    __syncthreads();
    { const int dir = tid >> 8, d = (tid >> 3) & 31, tg = tid & 7;
      float wv[16];
#pragma unroll
      for (int r = 0; r < 16; ++r) wv[r] = f.p.gla_dec_w[(dir * 16 + r) * 256 + h * 32 + d];
      const float bias = f.p.gla_dec_b[dir * 256 + h * 32 + d];
      float la[8];
#pragma unroll
      for (int i = 0; i < 8; ++i) { const bf16_t* zd = f.zf + (size_t)(t0 + tg * 8 + i) * Z0_LD + Z0_GDEC + dir * 16; const u32x4 u0 = *(const u32x4*)zd, u1 = *(const u32x4*)(zd + 8);
        float a = bias; a += bflo(u0.x) * wv[0] + bfhi(u0.x) * wv[1] + bflo(u0.y) * wv[2] + bfhi(u0.y) * wv[3] + bflo(u0.z) * wv[4] + bfhi(u0.z) * wv[5] + bflo(u0.w) * wv[6] + bfhi(u0.w) * wv[7];
        a += bflo(u1.x) * wv[8] + bfhi(u1.x) * wv[9] + bflo(u1.y) * wv[10] + bfhi(u1.y) * wv[11] + bflo(u1.z) * wv[12] + bfhi(u1.z) * wv[13] + bflo(u1.w) * wv[14] + bfhi(u1.w) * wv[15];
        la[i] = flogsigm(a) * (1.f / 16.f); }
      float tot = 0.f;
      if (dir == 0) {
#pragma unroll
        for (int i = 0; i < 8; ++i) { tot += la[i]; la[i] = tot; }
      } else {
#pragma unroll
        for (int i = 7; i >= 0; --i) { tot += la[i]; la[i] = tot; }
      }
      float pre = 0.f;
      const int lb = (tid & 63) & ~7;
#pragma unroll
      for (int o = 1; o < 8; ++o) { const float v = __shfl(tot, lb | ((tg + (dir == 0 ? -o : o)) & 7)); const bool take = dir == 0 ? (tg - o >= 0) : (tg + o <= 7); pre += take ? v : 0.f; }
      float full = pre + tot;
      const float bC = __shfl(full, lb | (dir == 0 ? 7 : 0));
#pragma unroll
      for (int i = 0; i < 8; ++i) { const int t = tg * 8 + i; const float bb = la[i] + pre; f.gla_b[((size_t)(t0 + t) * 2 + dir) * 256 + h * 32 + d] = bb;
        const float kv = bf2f(f.zf[(size_t)(t0 + t) * Z0_LD + Z0_GK + h * 32 + d]); kbar[(dir * 64 + t) * 33 + d] = kv * __expf(bC - bb); }
      if (tg == 0) f.gla_dec[((size_t)((b * 8 + h) * 2 + dir) * 68 + c) * 32 + d] = bC;
    }
    { const int t = tid >> 3, e8 = (tid & 7) * 8; const u32x4 u = *(const u32x4*)(f.zf + (size_t)(t0 + t) * Z0_LD + Z0_GV + h * 64 + e8); float* dst = vl + t * 65 + e8;
      dst[0] = bflo(u.x); dst[1] = bfhi(u.x); dst[2] = bflo(u.y); dst[3] = bfhi(u.y); dst[4] = bflo(u.z); dst[5] = bfhi(u.z); dst[6] = bflo(u.w); dst[7] = bfhi(u.w); }
    __syncthreads();
    { const int dir = tid >> 8, e = (tid >> 3) & 31, dq = tid & 7;
      float a0[4] = {0.f, 0.f, 0.f, 0.f}, a1[4] = {0.f, 0.f, 0.f, 0.f};
      for (int t = 0; t < 64; ++t) { const float v0 = vl[t * 65 + e], v1 = vl[t * 65 + e + 32]; const float* kb = kbar + (dir * 64 + t) * 33 + dq * 4;
#pragma unroll
        for (int j = 0; j < 4; ++j) { a0[j] += kb[j] * v0; a1[j] += kb[j] * v1; } }
      float* dst = f.gla_s + ((size_t)((b * 8 + h) * 2 + dir) * 68 + c) * 2048;
      *(f32x4*)(dst + e * 32 + dq * 4) = (f32x4){a0[0], a0[1], a0[2], a0[3]}; *(f32x4*)(dst + (e + 32) * 32 + dq * 4) = (f32x4){a1[0], a1[1], a1[2], a1[3]}; }
  }
}
template <bool DRY = false>
__device__ __forceinline__ void ph_gla_b(const FP& f, int b_lo, int b_hi) {
  const int n = (b_hi - b_lo) * 8 * 2 * 2048;
  for (int i = blockIdx.x * NT + TIDX; i < n; i += gridDim.x * NT) {
    const int el = i & 2047, seq = i >> 11; const int dir = seq & 1, h = (seq >> 1) & 7, b = b_lo + (seq >> 4); const int d = el & 31;
    float* sb = f.gla_s + (size_t)((b * 8 + h) * 2 + dir) * 68 * 2048 + el; const float* db = f.gla_dec + (size_t)((b * 8 + h) * 2 + dir) * 68 * 32 + d;
    float S = 0.f;
#pragma unroll 4
    for (int step = 0; step < 68; ++step) { const int c = dir == 0 ? step : (step < 4 ? 3 - step : 71 - step); const float kv = sb[(size_t)c * 2048]; const float dc = db[c * 32]; if (!DRY) sb[(size_t)c * 2048] = S; S = __expf(dc) * S + kv; }
    if (DRY) asm volatile("" :: "v"(S));
  }
}
constexpr int GLA_C_LDS = 2 * 4096 * 2 + 8192 + 512;
template <class OutT>
__device__ __forceinline__ void ph_gla_c(const FP& f, int b_lo, int b_hi, OutT* cat, int ldc, char* lds) {
  bf16_t* qtl = (bf16_t*)lds; bf16_t* khl = qtl + 2 * 2048; char* vtl = lds + 16384; float* ssq = (float*)(lds + 16384 + 8192);
  const int tid = TIDX, lane = tid & 63, w = tid >> 6, fr = lane & 15, fg = lane >> 4, it = w & 3, eh = w >> 2;
  const int nitems = (b_hi - b_lo) * 8 * 68;
  for (int item = blockIdx.x; item < nitems; item += gridDim.x) {
    const int b = b_lo + item / (8 * 68), h = (item / 68) % 8, c = item % 68; const int t0 = b * FS + c * 64;
    __syncthreads();
    { const int t = tid >> 3, d4 = (tid & 7) * 4; const bf16_t* zr = f.zf + (size_t)(t0 + t) * Z0_LD; const u32x2 qu = *(const u32x2*)(zr + Z0_GQ + h * 32 + d4), ku = *(const u32x2*)(zr + Z0_GK + h * 32 + d4);
      const float q[4] = {bflo(qu.x), bfhi(qu.x), bflo(qu.y), bfhi(qu.y)}, k[4] = {bflo(ku.x), bfhi(ku.x), bflo(ku.y), bfhi(ku.y)};
#pragma unroll
      for (int dir = 0; dir < 2; ++dir) { const f32x4 bb = *(const f32x4*)(f.gla_b + ((size_t)(t0 + t) * 2 + dir) * 256 + h * 32 + d4);
        u32x2 qo, ko; qo.x = pk2(q[0] * __expf(bb.x), q[1] * __expf(bb.y)); qo.y = pk2(q[2] * __expf(bb.z), q[3] * __expf(bb.w)); ko.x = pk2(k[0] * __expf(-bb.x), k[1] * __expf(-bb.y)); ko.y = pk2(k[2] * __expf(-bb.z), k[3] * __expf(-bb.w));
        *(u32x2*)(qtl + dir * 2048 + t * 32 + d4) = qo; *(u32x2*)(khl + dir * 2048 + t * 32 + d4) = ko; } }
    { const int t = tid >> 3, e8 = (tid & 7) * 8; const u32x4 u = *(const u32x4*)(f.zf + (size_t)(t0 + t) * Z0_LD + Z0_GV + h * 64 + e8); const unsigned uu[4] = {u.x, u.y, u.z, u.w};
#pragma unroll
      for (int j = 0; j < 8; ++j) { const int e = e8 + j; const bf16_t val = (bf16_t)((j & 1) ? (uu[j >> 1] >> 16) : (uu[j >> 1] & 0xffffu)); *(bf16_t*)(vtl + e * 128 + ((((t >> 2) ^ (e & 14)) << 3) | ((t & 3) << 1))) = val; } }
    __syncthreads();
    f32x4 ot[2]; ot[0] = (f32x4){0.f, 0.f, 0.f, 0.f}; ot[1] = ot[0];
#pragma unroll
    for (int dir = 0; dir < 2; ++dir) {
      const bf16x8 qfr = *(const bf16x8*)(qtl + dir * 2048 + (it * 16 + fr) * 32 + fg * 8);
      f32x4 st[4];
#pragma unroll
      for (int jt = 0; jt < 4; ++jt) { const bf16x8 kfr = *(const bf16x8*)(khl + dir * 2048 + (jt * 16 + fr) * 32 + fg * 8); st[jt] = __builtin_amdgcn_mfma_f32_16x16x32_bf16(kfr, qfr, (f32x4){0.f, 0.f, 0.f, 0.f}, 0, 0, 0); }
#pragma unroll
      for (int jt = 0; jt < 4; ++jt)
#pragma unroll
        for (int r = 0; r < 4; ++r) { const int j = jt * 16 + fg * 4 + r, i = it * 16 + fr; const bool keep = dir == 0 ? (j <= i) : (j >= i); if (!keep) st[jt][r] = 0.f; }
      bf16x8 pf[2];
#pragma unroll
      for (int ks = 0; ks < 2; ++ks) { u32x4 u; u.x = pk2(st[2 * ks].x, st[2 * ks].y); u.y = pk2(st[2 * ks].z, st[2 * ks].w); u.z = pk2(st[2 * ks + 1].x, st[2 * ks + 1].y); u.w = pk2(st[2 * ks + 1].z, st[2 * ks + 1].w); pf[ks] = __builtin_bit_cast(bf16x8, u); }
      const float* Sg = f.gla_s + ((size_t)((b * 8 + h) * 2 + dir) * 68 + c) * 2048;
#pragma unroll
      for (int n2 = 0; n2 < 2; ++n2) { const int row = (eh * 2 + n2) * 16 + fr;
#pragma unroll
        for (int ks = 0; ks < 2; ++ks) { const char* rp = vtl + row * 128; const int c0 = (8 * ks + fg) ^ (row & 14), c1 = (8 * ks + 4 + fg) ^ (row & 14);
          const u32x2 lo = *(const u32x2*)(rp + (c0 << 3)), hi = *(const u32x2*)(rp + (c1 << 3)); u32x4 u; u.x = lo.x; u.y = lo.y; u.z = hi.x; u.w = hi.y;
          ot[n2] = __builtin_amdgcn_mfma_f32_16x16x32_bf16(__builtin_bit_cast(bf16x8, u), pf[ks], ot[n2], 0, 0, 0); }
        const f32x4 s0 = *(const f32x4*)(Sg + row * 32 + fg * 8), s1 = *(const f32x4*)(Sg + row * 32 + fg * 8 + 4); u32x4 su; su.x = pk2(s0.x, s0.y); su.y = pk2(s0.z, s0.w); su.z = pk2(s1.x, s1.y); su.w = pk2(s1.z, s1.w);
        ot[n2] = __builtin_amdgcn_mfma_f32_16x16x32_bf16(__builtin_bit_cast(bf16x8, su), qfr, ot[n2], 0, 0, 0); }
    }
    float ss = 0.f;
#pragma unroll
    for (int n2 = 0; n2 < 2; ++n2) ss += ot[n2].x * ot[n2].x + ot[n2].y * ot[n2].y + ot[n2].z * ot[n2].z + ot[n2].w * ot[n2].w;
    ss += __shfl_xor(ss, 16); ss += __shfl_xor(ss, 32);
    if (fg == 0) ssq[eh * 64 + it * 16 + fr] = ss;
    __syncthreads();
    const float ri = 1.f / sqrtf((ssq[it * 16 + fr] + ssq[64 + it * 16 + fr]) * (1.f / 64.f) + 1e-6f);
    const int t = t0 + it * 16 + fr;
#pragma unroll
    for (int n2 = 0; n2 < 2; ++n2) { const int e = (eh * 2 + n2) * 16 + fg * 4; const u32x2 gu = *(const u32x2*)(f.zf + (size_t)t * Z0_LD + Z0_GG + h * 64 + e); const f32x4 gn = *(const f32x4*)(f.p.gla_out_norm + e);
      f32x4 o = ot[n2] * ri * gn; o.x *= fsilu(bflo(gu.x)); o.y *= fsilu(bfhi(gu.x)); o.z *= fsilu(bflo(gu.y)); o.w *= fsilu(bfhi(gu.y));
      store4(cat + (size_t)t * ldc + h * 64 + e, o); }
  }
}
struct RW {
  const bf16_t* z; int b_lo, b_hi;
  const bf16_t *w2T, *a2T, *g2T;
  bf16_t *M, *N, *R2, *Y0;
  const float *mu, *w0, *a0, *kk_scale, *k_a, *r_k, *ln_g, *ln_b;
};
#ifndef R1_REP
#define R1_REP 0
#endif
#define R1_LOOP(sn) for (int rp_ = 0; rp_ <= ((R1_REP >> ((sn) - 1)) & 1); ++rp_)
constexpr int RC_R = 256, RC_K = 1024, RC_V = 1792, RC_ZW = 2560, RC_ZA = 2688, RC_ZG = 2816;
__device__ __forceinline__ int rw_q(int b, int h, int dir, int c) { return ((b * 12 + h) * 2 + dir) * 68 + c; }
__device__ __forceinline__ float fsoftplus(float x) { return x > 0.f ? x + __logf(1.f + __expf(-x)) : __logf(1.f + __expf(x)); }
__device__ __forceinline__ float zsm1(const RW& a, int tk, int col, bool hp, bool hn) {
  const bf16_t* p = a.z + (size_t)tk * Z1_LD + col; const float zc = bf2f(p[0]), pv = bf2f(p[hp ? -Z1_LD : 0]), nx = bf2f(p[hn ? Z1_LD : 0]);
  return zc + a.mu[col - 256] * (0.5f * ((hp ? pv : 0.f) + (hn ? nx : 0.f)) - zc);
}
__device__ __forceinline__ void zsm8(const RW& a, int tk, int col, bool hp, bool hn, float (&o)[8]) {
  const bf16_t* p = a.z + (size_t)tk * Z1_LD + col; const u32x4 c = *(const u32x4*)p; const u32x4 pv = *(const u32x4*)(p + (hp ? -Z1_LD : 0)), nx = *(const u32x4*)(p + (hn ? Z1_LD : 0));
  const float fp = hp ? 0.5f : 0.f, fn = hn ? 0.5f : 0.f;
  const f32x4 m0 = *(const f32x4*)(a.mu + col - 256), m1 = *(const f32x4*)(a.mu + col - 256 + 4);
  const unsigned cc[4] = {c.x, c.y, c.z, c.w}, pp[4] = {pv.x, pv.y, pv.z, pv.w}, nn[4] = {nx.x, nx.y, nx.z, nx.w}; const float mm[8] = {m0.x, m0.y, m0.z, m0.w, m1.x, m1.y, m1.z, m1.w};
#pragma unroll
  for (int j = 0; j < 4; ++j) { float zc = bflo(cc[j]); o[2 * j] = zc + mm[2 * j] * (fp * bflo(pp[j]) + fn * bflo(nn[j]) - zc); zc = bfhi(cc[j]); o[2 * j + 1] = zc + mm[2 * j + 1] * (fp * bfhi(pp[j]) + fn * bfhi(nn[j]) - zc); }
}
#define MFMA16(a, b, c) __builtin_amdgcn_mfma_f32_16x16x32_bf16(a, b, c, 0, 0, 0)

constexpr int R1_PW = 0, R1_PA = 16384, R1_LP = 0, R1_XF = 16384;
constexpr int R1_KT = 32768, R1_BH = R1_KT + 8192, R1_KH = R1_BH + 8192, R1_RT = R1_KH + 8192;
constexpr int R1_BBT = R1_RT + 8192, R1_KBT = R1_BBT + 8192, R1_VT = R1_KBT + 8192;
constexpr int R1_AAK = R1_VT + 8192, R1_ARB = R1_AAK + 8192, R1_ARK = R1_ARB + 8192;
constexpr int R1_WT = R1_ARK + 8192, R1_U0T = R1_WT + 8192;
constexpr int R1_MISC = R1_U0T + 8192;
constexpr int R1_LDS = R1_MISC + (8 * 64 + 64 + 64) * 4;
__device__ __forceinline__ bf16x8 ldfrag(const char* base, int rt, int ks, int fr, int fg) { return *(const bf16x8*)(base + (rt * 16 + fr) * 128 + ks * 64 + fg * 16); }

__device__ __forceinline__ void ph_rwkv1(const RW& a, int b_lo, int b_hi, char* lds) {
  const int tid = TIDX, lane = tid & 63, w = tid >> 6, fr = lane & 15, fg = lane >> 4;
  float* pw = (float*)(lds + R1_PW); float* pa = (float*)(lds + R1_PA); float* Lp = (float*)(lds + R1_LP); float* Xf = (float*)(lds + R1_XF);
  float* segsum = (float*)(lds + R1_MISC); float* gC = segsum + 512; float* bon = gC + 64;
  const int nitems = (b_hi - b_lo) * 12 * 2 * 68; const int q_lo = rw_q(b_lo, 0, 0, 0);
  for (int item = blockIdx.x; item < nitems; item += gridDim.x) {
    const int b = b_lo + item / (12 * 2 * 68), h = (item / (2 * 68)) % 12, dir = (item / 68) & 1, c = item % 68; const int t0 = b * FS + c * 64;
    const size_t qo = (size_t)(rw_q(b, h, dir, c) - q_lo) * 4096;
    const bool first_chunk = (c == 0 || c == 4), last_chunk = (c == 3 || c == 67);
    __syncthreads();
    R1_LOOP(1) { const int mat = w >> 2, mt = w & 3; const int i = mt * 16 + fr; const int ti = dir ? 63 - i : i; const int tk = t0 + ti; const bool hp = !(first_chunk && ti == 0), hn = !(last_chunk && ti == 63);
      bf16x8 af[2];
#pragma unroll
      for (int ks = 0; ks < 2; ++ks) { float v[8]; zsm8(a, tk, (mat ? RC_ZA : RC_ZW) + dir * 64 + ks * 32 + fg * 8, hp, hn, v); if (!mat) {
#pragma unroll
          for (int j = 0; j < 8; ++j) v[j] = tanhf(v[j]); }
        af[ks] = pack8(v); }
      const bf16_t* WT = (mat ? a.a2T : a.w2T) + ((size_t)dir * 768 + h * 64) * 64; float* dst = mat ? pa : pw;
#pragma unroll
      for (int nt = 0; nt < 4; ++nt) { f32x4 acc = {0.f, 0.f, 0.f, 0.f};
#pragma unroll
        for (int ks = 0; ks < 2; ++ks) { const bf16x8 bfr = *(const bf16x8*)(WT + (size_t)(nt * 16 + fr) * 64 + ks * 32 + fg * 8); acc = MFMA16(af[ks], bfr, acc); }
        *(f32x4*)(dst + (nt * 16 + fr) * 64 + mt * 16 + fg * 4) = acc; }
    }
    __syncthreads();
    R1_LOOP(2) { const int k = lane, ch = h * 64 + k;
      const float w0 = a.w0[dir * 768 + ch], a0 = a.a0[dir * 768 + ch], kks = a.kk_scale[ch], ka = a.k_a[ch], rk = a.r_k[ch];
      float rr[8], kd[8], kap[8], bet[8], vv[8], lw[8];
#pragma unroll
      for (int ii = 0; ii < 8; ++ii) { const int i = 8 * w + ii; const int ti = dir ? 63 - i : i; const int tk = t0 + ti; const bool hp = !(first_chunk && ti == 0), hn = !(last_chunk && ti == 63);
        const float r = zsm1(a, tk, RC_R + ch, hp, hn), kx = zsm1(a, tk, RC_K + ch, hp, hn), v = zsm1(a, tk, RC_V + ch, hp, hn);
        const float aw = w0 + pw[k * 64 + i]; const float wl = -fsoftplus(-aw) - 0.5f; lw[ii] = -__expf(wl);
        const float av = fsigm(a0 + pa[k * 64 + i]); kd[ii] = kx * (1.f + (av - 1.f) * ka);
        const float ks_ = kx * kks; const float nrm = wave_sum_dpp(ks_ * ks_); kap[ii] = ks_ / sqrtf(nrm + 1e-12f); bet[ii] = kap[ii] * av; rr[ii] = r; vv[ii] = v;
        const float bn = wave_sum_dpp(r * kd[ii] * rk); if (lane == 0) bon[i] = bn; }
      float cl[8]; float run = 0.f;
#pragma unroll
      for (int ii = 0; ii < 8; ++ii) { run += lw[ii]; cl[ii] = run; }
      segsum[w * 64 + k] = run;
      __syncthreads();
      float pre = 0.f, total = 0.f;
#pragma unroll
      for (int s = 0; s < 8; ++s) { const float v = segsum[s * 64 + k]; total += v; pre += s < w ? v : 0.f; }
      if (w == 0) gC[k] = __expf(total);
      float bb8[8], kb8[8];
#pragma unroll
      for (int ii = 0; ii < 8; ++ii) { const int i = 8 * w + ii; const float cum = pre + cl[ii], cumprev = cum - lw[ii]; const float eneg = __expf(-cum);
        *(bf16_t*)(lds + R1_KT + i * 128 + k * 2) = f2bf(kap[ii] * __expf(cumprev)); *(bf16_t*)(lds + R1_BH + i * 128 + k * 2) = f2bf(bet[ii] * eneg);
        *(bf16_t*)(lds + R1_KH + i * 128 + k * 2) = f2bf(kd[ii] * eneg); *(bf16_t*)(lds + R1_RT + i * 128 + k * 2) = f2bf(rr[ii] * __expf(cum));
        const float etc = __expf(total - cum); bb8[ii] = bet[ii] * etc; kb8[ii] = kd[ii] * etc; }
      *(bf16x8*)(lds + R1_BBT + k * 128 + w * 16) = pack8(bb8); *(bf16x8*)(lds + R1_KBT + k * 128 + w * 16) = pack8(kb8); *(bf16x8*)(lds + R1_VT + k * 128 + w * 16) = pack8(vv);
    }
    __syncthreads();
    R1_LOOP(3) { const int it = w & 3, half = w >> 2; const char* Xb = lds + (half ? R1_RT : R1_KT);
      const bf16x8 x0 = ldfrag(Xb, it, 0, fr, fg), x1 = ldfrag(Xb, it, 1, fr, fg); const int i = it * 16 + fr;
#pragma unroll
      for (int jt = 0; jt < 4; ++jt) {
        f32x4 d0 = {0.f, 0.f, 0.f, 0.f}, d1 = {0.f, 0.f, 0.f, 0.f};
        d0 = MFMA16(ldfrag(lds + R1_BH, jt, 0, fr, fg), x0, d0); d0 = MFMA16(ldfrag(lds + R1_BH, jt, 1, fr, fg), x1, d0);
        d1 = MFMA16(ldfrag(lds + R1_KH, jt, 0, fr, fg), x0, d1); d1 = MFMA16(ldfrag(lds + R1_KH, jt, 1, fr, fg), x1, d1);
#pragma unroll
        for (int r = 0; r < 4; ++r) { const int j = jt * 16 + fg * 4 + r; const bool keep = half ? (j <= i) : (j < i); if (!keep) { d0[r] = 0.f; d1[r] = 0.f; } }
        if (half == 0) {
#pragma unroll
          for (int r = 0; r < 4; ++r) Lp[i * 64 + r * 16 + jt * 4 + fg] = d0[r];
          u32x2 o; o.x = pk2(d1.x, d1.y); o.y = pk2(d1.z, d1.w); *(u32x2*)(lds + R1_AAK + i * 128 + (jt * 16 + fg * 4) * 2) = o;
        } else {
          u32x2 o; o.x = pk2(d0.x, d0.y); o.y = pk2(d0.z, d0.w); *(u32x2*)(lds + R1_ARB + i * 128 + (jt * 16 + fg * 4) * 2) = o;
          o.x = pk2(d1.x, d1.y); o.y = pk2(d1.z, d1.w); *(u32x2*)(lds + R1_ARK + i * 128 + (jt * 16 + fg * 4) * 2) = o;
        }
      }
    }
    __syncthreads();
    R1_LOOP(4) { const int it = w & 3; const bf16x8 b0 = ldfrag(lds + R1_AAK, it, 0, fr, fg), b1 = ldfrag(lds + R1_AAK, it, 1, fr, fg);
#pragma unroll
      for (int q = 0; q < 2; ++q) { const int et = (w >> 2) * 2 + q; f32x4 d = {0.f, 0.f, 0.f, 0.f};
        d = MFMA16(ldfrag(lds + R1_VT, et, 0, fr, fg), b0, d); d = MFMA16(ldfrag(lds + R1_VT, et, 1, fr, fg), b1, d);
        *(f32x4*)(Xf + (it * 16 + fr) * 64 + et * 16 + fg * 4) = d; } }
    __syncthreads();
    R1_LOOP(5) { float s[16];
#pragma unroll
      for (int m = 0; m < 16; ++m) s[m] = 0.f;
      const int q = lane & 3, col = (w & 3) * 16 + (lane >> 2);
#pragma unroll
      for (int g = 0; g < 16; ++g) {
        float P[4], d[4], rhs[4];
#pragma unroll
        for (int rr = 0; rr < 4; ++rr) { const int i = 4 * g + rr; float p0 = 0.f, p1 = 0.f; d[rr] = 0.f;
#pragma unroll
          for (int c = 0; c <= (g >> 2); ++c) { const f32x4 l = *(const f32x4*)(Lp + i * 64 + q * 16 + c * 4); p0 += l.x * s[c * 4] + l.z * s[c * 4 + 2]; p1 += l.y * s[c * 4 + 1] + l.w * s[c * 4 + 3]; if (c == (g >> 2)) d[rr] = l[g & 3]; }
          float part = p0 + p1; part += dppmov<0xB1>(part); part += dppmov<0x4E>(part); P[rr] = part;
          rhs[rr] = w < 4 ? -bf2f(*(const bf16_t*)(lds + R1_KT + i * 128 + col * 2)) : -Xf[i * 64 + col]; }
        const float L10 = dppmov<0x00>(d[1]), L20 = dppmov<0x00>(d[2]), L21 = dppmov<0x55>(d[2]), L30 = dppmov<0x00>(d[3]), L31 = dppmov<0x55>(d[3]), L32 = dppmov<0xAA>(d[3]);
        const float v0 = rhs[0] - P[0]; const float v1 = rhs[1] - P[1] - L10 * v0; const float v2 = rhs[2] - P[2] - L20 * v0 - L21 * v1; const float v3 = rhs[3] - P[3] - L30 * v0 - L31 * v1 - L32 * v2;
        s[g] = q == 0 ? v0 : (q == 1 ? v1 : (q == 2 ? v2 : v3));
      }
      char* dst = lds + (w < 4 ? R1_WT : R1_U0T) + col * 128;
#pragma unroll
      for (int m = 0; m < 16; ++m) *(bf16_t*)(dst + (4 * m + q) * 2) = f2bf(s[m]);
    }
    __syncthreads();
    R1_LOOP(6) { const int tt = w & 3, half = w >> 2;
      if (half == 0) {
        const bf16x8 b0 = ldfrag(lds + R1_ARB, tt, 0, fr, fg), b1 = ldfrag(lds + R1_ARB, tt, 1, fr, fg); const int i = tt * 16 + fr;
#pragma unroll 1
        for (int kt = 0; kt < 4; ++kt) { f32x4 d = {0.f, 0.f, 0.f, 0.f}; d = MFMA16(ldfrag(lds + R1_WT, kt, 0, fr, fg), b0, d); d = MFMA16(ldfrag(lds + R1_WT, kt, 1, fr, fg), b1, d);
          const u32x2 ru = *(const u32x2*)(lds + R1_RT + i * 128 + (kt * 16 + fg * 4) * 2); u32x2 o; o.x = pk2(d.x + bflo(ru.x), d.y + bfhi(ru.x)); o.y = pk2(d.z + bflo(ru.y), d.w + bfhi(ru.y));
          *(u32x2*)(a.R2 + qo + i * 64 + kt * 16 + fg * 4) = o; }
        const bf16x8 c0 = ldfrag(lds + R1_BBT, tt, 0, fr, fg), c1 = ldfrag(lds + R1_BBT, tt, 1, fr, fg); const int k2 = tt * 16 + fr;
#pragma unroll 1
        for (int kt = 0; kt < 4; ++kt) { f32x4 d = {0.f, 0.f, 0.f, 0.f}; d = MFMA16(ldfrag(lds + R1_WT, kt, 0, fr, fg), c0, d); d = MFMA16(ldfrag(lds + R1_WT, kt, 1, fr, fg), c1, d);
#pragma unroll
          for (int r = 0; r < 4; ++r) { const int k1 = kt * 16 + fg * 4 + r; if (k1 == k2) d[r] += gC[k1]; }
          u32x2 o; o.x = pk2(d.x, d.y); o.y = pk2(d.z, d.w); *(u32x2*)(a.M + qo + k2 * 64 + kt * 16 + fg * 4) = o; }
      } else {
        const bf16x8 b0 = ldfrag(lds + R1_ARB, tt, 0, fr, fg), b1 = ldfrag(lds + R1_ARB, tt, 1, fr, fg), k0 = ldfrag(lds + R1_ARK, tt, 0, fr, fg), k1 = ldfrag(lds + R1_ARK, tt, 1, fr, fg); const int i = tt * 16 + fr; const float bn = bon[i];
#pragma unroll 1
        for (int et = 0; et < 4; ++et) { f32x4 d = {0.f, 0.f, 0.f, 0.f};
          d = MFMA16(ldfrag(lds + R1_U0T, et, 0, fr, fg), b0, d); d = MFMA16(ldfrag(lds + R1_U0T, et, 1, fr, fg), b1, d); d = MFMA16(ldfrag(lds + R1_VT, et, 0, fr, fg), k0, d); d = MFMA16(ldfrag(lds + R1_VT, et, 1, fr, fg), k1, d);
#pragma unroll
          for (int r = 0; r < 4; ++r) d[r] += bn * bf2f(*(const bf16_t*)(lds + R1_VT + (et * 16 + fg * 4 + r) * 128 + i * 2));
          u32x2 o; o.x = pk2(d.x, d.y); o.y = pk2(d.z, d.w); *(u32x2*)(a.Y0 + qo + i * 64 + et * 16 + fg * 4) = o; }
        const bf16x8 u0 = ldfrag(lds + R1_U0T, tt, 0, fr, fg), u1 = ldfrag(lds + R1_U0T, tt, 1, fr, fg), v0 = ldfrag(lds + R1_VT, tt, 0, fr, fg), v1 = ldfrag(lds + R1_VT, tt, 1, fr, fg); const int e = tt * 16 + fr;
#pragma unroll 1
        for (int kt = 0; kt < 4; ++kt) { f32x4 d = {0.f, 0.f, 0.f, 0.f};
          d = MFMA16(ldfrag(lds + R1_BBT, kt, 0, fr, fg), u0, d); d = MFMA16(ldfrag(lds + R1_BBT, kt, 1, fr, fg), u1, d); d = MFMA16(ldfrag(lds + R1_KBT, kt, 0, fr, fg), v0, d); d = MFMA16(ldfrag(lds + R1_KBT, kt, 1, fr, fg), v1, d);
          u32x2 o; o.x = pk2(d.x, d.y); o.y = pk2(d.z, d.w); *(u32x2*)(a.N + qo + e * 64 + kt * 16 + fg * 4) = o; }
      }
    }
  }
}
struct R2Regs { u32x2 mlo[4][2], mhi[4][2], nn[4]; };
__device__ __forceinline__ void r2_load(R2Regs& g, const bf16_t* Mt, const bf16_t* Ns, int fr, int fg) {
#pragma unroll
  for (int mt = 0; mt < 4; ++mt) {
#pragma unroll
    for (int s = 0; s < 2; ++s) { const bf16_t* mr = Mt + (mt * 16 + fr) * 64 + 32 * s + fg * 4; g.mlo[mt][s] = *(const u32x2*)mr; g.mhi[mt][s] = *(const u32x2*)(mr + 16); }
    g.nn[mt] = *(const u32x2*)(Ns + mt * 16 + fg * 4); }
}
template <bool DRY>
__device__ __forceinline__ void r2_step(const R2Regs& g, f32x4 (&st)[4], bf16_t* Ns, int fg) {
  bf16x8 sb[2]; u32x4 su[2];
#pragma unroll
  for (int s = 0; s < 2; ++s) { su[s].x = pk2(st[2 * s].x, st[2 * s].y); su[s].y = pk2(st[2 * s].z, st[2 * s].w); su[s].z = pk2(st[2 * s + 1].x, st[2 * s + 1].y); su[s].w = pk2(st[2 * s + 1].z, st[2 * s + 1].w); sb[s] = __builtin_bit_cast(bf16x8, su[s]); }
#pragma unroll
  for (int mt = 0; mt < 4; ++mt) { u32x2 o; o.x = (mt & 1) ? su[mt >> 1].z : su[mt >> 1].x; o.y = (mt & 1) ? su[mt >> 1].w : su[mt >> 1].y; if (!DRY) *(u32x2*)(Ns + mt * 16 + fg * 4) = o; }
#pragma unroll
  for (int mt = 0; mt < 4; ++mt) { f32x4 nw = (f32x4){bflo(g.nn[mt].x), bfhi(g.nn[mt].x), bflo(g.nn[mt].y), bfhi(g.nn[mt].y)};
#pragma unroll
    for (int s = 0; s < 2; ++s) { u32x4 u; u.x = g.mlo[mt][s].x; u.y = g.mlo[mt][s].y; u.z = g.mhi[mt][s].x; u.w = g.mhi[mt][s].y; nw = MFMA16(__builtin_bit_cast(bf16x8, u), sb[s], nw); }
    st[mt] = nw; }
}
template <bool DRY = false>
__device__ __forceinline__ void ph_rwkv2(const RW& a, int b_lo, int b_hi) {
  const int lane = TIDX & 63, fr = lane & 15, fg = lane >> 4; const int gw = (TIDX >> 6) * gridDim.x + blockIdx.x, ngw = gridDim.x * (NT / 64);
  const int nseq = (b_hi - b_lo) * 12 * 2; const int q_lo = rw_q(b_lo, 0, 0, 0);
  for (int wi = gw; wi < nseq * 4; wi += ngw) {
    const int eg = wi & 3, seq = wi >> 2; const int dir = seq & 1, h = (seq >> 1) % 12, b = b_lo + seq / 24; const int e = eg * 16 + fr;
    f32x4 st[4];
#pragma unroll
    for (int mt = 0; mt < 4; ++mt) st[mt] = (f32x4){0.f, 0.f, 0.f, 0.f};
    auto chunk_of = [&](int step) -> int { return dir == 0 ? step : (step < 4 ? 3 - step : 71 - step); };
    auto qoff = [&](int step) -> size_t { return (size_t)(rw_q(b, h, dir, chunk_of(step)) - q_lo) * 4096; };
    R2Regs ga, gb;
    { const size_t qo = qoff(0); r2_load(ga, a.M + qo, a.N + qo + e * 64, fr, fg); }
#pragma unroll 1
    for (int step = 0; step < 68; step += 2) {
      { const size_t qn = qoff(step + 1); r2_load(gb, a.M + qn, a.N + qn + e * 64, fr, fg); }
      r2_step<DRY>(ga, st, a.N + qoff(step) + e * 64, fg);
      if (step + 2 < 68) { const size_t qn = qoff(step + 2); r2_load(ga, a.M + qn, a.N + qn + e * 64, fr, fg); }
      r2_step<DRY>(gb, st, a.N + qoff(step + 1) + e * 64, fg);
    }
    if (DRY) { asm volatile("" :: "v"(st[0].x), "v"(st[1].x), "v"(st[2].x), "v"(st[3].x)); }
  }
}
constexpr int R3_LDS = 64 * 128 * 2 + 1024;
template <class OutT>
__device__ __forceinline__ void ph_rwkv3(const RW& a, int b_lo, int b_hi, OutT* cat, int ldc, char* lds) {
  const int tid = TIDX, lane = tid & 63, w = tid >> 6, fr = lane & 15, fg = lane >> 4, it = w & 3, eh = w >> 2;
  bf16_t* sg = (bf16_t*)lds; float* red = (float*)(lds + 64 * 128 * 2);
  const int nitems = (b_hi - b_lo) * 12 * 64; const int q_lo = rw_q(b_lo, 0, 0, 0);
  for (int item = blockIdx.x; item < nitems; item += gridDim.x) {
    const int b = b_lo + item / (12 * 64), h = (item / 64) % 12, c = 4 + item % 64; const int t0 = b * FS + c * 64;
    __syncthreads();
    { const int t = tid >> 3, j16 = (tid & 7) * 16; const bool hp = !(c == 4 && t == 0), hn = !(c == 67 && t == 63);
#pragma unroll
      for (int q = 0; q < 2; ++q) { float v[8]; zsm8(a, t0 + t, RC_ZG + j16 + q * 8, hp, hn, v);
#pragma unroll
        for (int j = 0; j < 8; ++j) v[j] = fsigm(v[j]);
        *(bf16x8*)(sg + t * 128 + j16 + q * 8) = pack8(v); } }
    __syncthreads();
    f32x4 y[2], g[2];
#pragma unroll
    for (int n2 = 0; n2 < 2; ++n2) { y[n2] = (f32x4){0.f, 0.f, 0.f, 0.f}; g[n2] = y[n2]; }
    const int tl = it * 16 + fr;
#pragma unroll
    for (int dir = 0; dir < 2; ++dir) { const size_t qo = (size_t)(rw_q(b, h, dir, c) - q_lo) * 4096; const int i = dir ? 63 - tl : tl;
      const bf16x8 r0 = *(const bf16x8*)(a.R2 + qo + i * 64 + fg * 8), r1 = *(const bf16x8*)(a.R2 + qo + i * 64 + 32 + fg * 8);
#pragma unroll
      for (int n2 = 0; n2 < 2; ++n2) { const int et = eh * 2 + n2; const bf16_t* Sr = a.N + qo + (et * 16 + fr) * 64;
        y[n2] = MFMA16(*(const bf16x8*)(Sr + fg * 8), r0, y[n2]); y[n2] = MFMA16(*(const bf16x8*)(Sr + 32 + fg * 8), r1, y[n2]);
        const u32x2 yu = *(const u32x2*)(a.Y0 + qo + i * 64 + et * 16 + fg * 4); y[n2].x += bflo(yu.x); y[n2].y += bfhi(yu.x); y[n2].z += bflo(yu.y); y[n2].w += bfhi(yu.y); } }
#pragma unroll
    for (int ks = 0; ks < 4; ++ks) { const bf16x8 sb = *(const bf16x8*)(sg + tl * 128 + ks * 32 + fg * 8);
#pragma unroll
      for (int n2 = 0; n2 < 2; ++n2) { const int cch = h * 64 + (eh * 2 + n2) * 16 + fr; g[n2] = MFMA16(*(const bf16x8*)(a.g2T + (size_t)cch * 128 + ks * 32 + fg * 8), sb, g[n2]); } }
    float s1 = 0.f, s2 = 0.f;
#pragma unroll
    for (int n2 = 0; n2 < 2; ++n2) { s1 += (y[n2].x + y[n2].y) + (y[n2].z + y[n2].w); s2 += y[n2].x * y[n2].x + y[n2].y * y[n2].y + y[n2].z * y[n2].z + y[n2].w * y[n2].w; }
    s1 += __shfl_xor(s1, 16); s1 += __shfl_xor(s1, 32); s2 += __shfl_xor(s2, 16); s2 += __shfl_xor(s2, 32);
    if (fg == 0) { red[eh * 128 + tl] = s1; red[eh * 128 + 64 + tl] = s2; }
    __syncthreads();
    const float mean = (red[tl] + red[128 + tl]) * (1.f / 64.f); const float var = (red[64 + tl] + red[128 + 64 + tl]) * (1.f / 64.f) - mean * mean; const float ri = 1.f / sqrtf(var + 64e-5f);
#pragma unroll
    for (int n2 = 0; n2 < 2; ++n2) { const int cch = h * 64 + (eh * 2 + n2) * 16 + fg * 4; const f32x4 lg = *(const f32x4*)(a.ln_g + cch), lb = *(const f32x4*)(a.ln_b + cch);
      const f32x4 o = ((y[n2] - mean) * ri * lg + lb) * g[n2]; store4(cat + (size_t)(t0 + tl) * ldc + 256 + cch, o); }
  }
}
struct EpiPlainBf16 { bf16_t* z; int ld;
  __device__ void operator()(const f32x4 (&acc)[4][4], int mb, int nb, int lane) const { const int fr = lane & 15, fg = lane >> 4;
#pragma unroll
    for (int mt = 0; mt < 4; ++mt) { bf16_t* zr = z + (size_t)(mb + mt * 16 + fr) * ld + nb + fg * 4;
#pragma unroll
      for (int nt = 0; nt < 4; ++nt) { u32x2 o; o.x = pk2(acc[mt][nt].x, acc[mt][nt].y); o.y = pk2(acc[mt][nt].z, acc[mt][nt].w); *(u32x2*)(zr + nt * 16) = o; } } } };
__device__ __forceinline__ void ph_inproj1(const FP& f, const bf16_t* wt, int tm0, int tm1, char* lds) {
  ARowPlain ar{f.hb, FD}; EpiPlainBf16 ep{f.zf, Z1_LD}; const int ntn = Z1_LD / 128, ntiles = (tm1 - tm0) * ntn;
  for (int t = blockIdx.x; t < ntiles; t += gridDim.x) { const int tm = tm0 + t / ntn, tn = t % ntn; gemm_tile<4, 2>(ar, wt, FD, FD, tm * 256, tn * 128, lds, ep); }
}
__device__ __forceinline__ void ph_prep_rwkv(const FP& f, bf16_t* w2T, bf16_t* a2T, bf16_t* g2T, char* lds) {
  for (int t = blockIdx.x; t < 24 + 24 + 24; t += gridDim.x) {
    if (t < 24) prep_tile(f.p.rwkv_w2 + (size_t)(t / 12) * 64 * 768, 64, 768, w2T + (size_t)(t / 12) * 768 * 64, 0, (t % 12) * 64, RowMapId(), lds);
    else if (t < 48) { const int u = t - 24; prep_tile(f.p.rwkv_a2 + (size_t)(u / 12) * 64 * 768, 64, 768, a2T + (size_t)(u / 12) * 768 * 64, 0, (u % 12) * 64, RowMapId(), lds); }
    else { const int u = t - 48; prep_tile(f.p.rwkv_g2, 128, 768, g2T, (u / 12) * 64, (u % 12) * 64, RowMapId(), lds); }
  }
}
struct FW { const bf16_t* z; bf16_t* Gp; const bf16_t *T64t, *DFT2, *DFT3; int b_lo, b_hi; };
__device__ __forceinline__ void ph_prep_fourier(bf16_t* T64t, bf16_t* DFT2, bf16_t* DFT3) {
  for (int i = blockIdx.x * NT + TIDX; i < 128 * 64 + 128 * 128 + 64 * 128; i += gridDim.x * NT) {
    if (i < 8192) { const int n = i >> 6, c = i & 63; const float a = (float)(((n & 63) * c) & 63) * (1.f / 32.f); T64t[i] = f2bf(n < 64 ? cospif(a) : -sinpif(a)); }
    else if (i < 8192 + 16384) { const int j = i - 8192, r = j >> 7, K = j & 127; const float a = (float)(((r & 63) * (K & 63)) & 63) * (1.f / 32.f); const float cs = cospif(a), sn = sinpif(a);
      DFT2[j] = f2bf(r < 64 ? (K < 64 ? cs : sn) : (K < 64 ? -sn : cs)); }
    else { const int j = i - 8192 - 16384, r = j >> 7, K = j & 127; const float a = (float)((r * (K & 63)) & 63) * (1.f / 32.f); DFT3[j] = f2bf(K < 64 ? cospif(a) : sinpif(a)); }
  }
}
constexpr int F1_LDS = 512 * 64 * 2;
__device__ __forceinline__ void ph_fourier1(const FW& a, int b_lo, int b_hi, char* lds, bool rev = false) {
  const int tid = TIDX, lane = tid & 63, w = tid >> 6, fr = lane & 15, fg = lane >> 4;
  const int nitems = (b_hi - b_lo) * 64;
  for (int item = rev ? gridDim.x - 1 - blockIdx.x : blockIdx.x; item < nitems; item += gridDim.x) {
    const int b = b_lo + item / 64, l2 = item % 64; const size_t row0 = (size_t)b * FS + FLC + l2;
    __syncthreads();
    {
      const int g = w >> 1, nh = w & 1;
      bf16x8 bt[4][2];
#pragma unroll
      for (int q = 0; q < 4; ++q)
#pragma unroll
        for (int ks = 0; ks < 2; ++ks) bt[q][ks] = *(const bf16x8*)(a.T64t + ((nh * 4 + q) * 16 + fr) * 64 + ks * 32 + fg * 8);
#pragma unroll
      for (int mt = 0; mt < 4; ++mt) { const bf16_t* zr = a.z + (row0 + (size_t)64 * (mt * 16 + fr)) * Z1_LD + g * 64 + fg * 8; const bf16x8 a0 = *(const bf16x8*)zr, a1 = *(const bf16x8*)(zr + 32);
#pragma unroll
        for (int q = 0; q < 4; ++q) { f32x4 d = {0.f, 0.f, 0.f, 0.f}; d = MFMA16(a0, bt[q][0], d); d = MFMA16(a1, bt[q][1], d);
          u32x2 o; o.x = pk2(d.x, d.y); o.y = pk2(d.z, d.w); *(u32x2*)(lds + ((g * 128 + (nh * 4 + q) * 16 + fr) * 64 + mt * 16 + fg * 4) * 2) = o; } }
    }
    __syncthreads();
#pragma unroll 1
    for (int ct = 0; ct < 2; ++ct) {
      f32x4 acc[8];
#pragma unroll
      for (int nt = 0; nt < 8; ++nt) acc[nt] = (f32x4){0.f, 0.f, 0.f, 0.f};
      const int colt = 2 * w + ct; const int g = colt >> 2, m = (colt & 3) * 16 + fr;
#pragma unroll 1
      for (int ks = 0; ks < 4; ++ks) {
        const bf16x8 af = *(const bf16x8*)(lds + ((g * 128 + (ks >> 1) * 64 + m) * 64 + (ks & 1) * 32 + fg * 8) * 2);
#pragma unroll
        for (int nt = 0; nt < 8; ++nt) { const bf16x8 bf_ = *(const bf16x8*)(a.DFT2 + (nt * 16 + fr) * 128 + ks * 32 + fg * 8); acc[nt] = MFMA16(af, bf_, acc[nt]); }
      }
#pragma unroll
      for (int nt = 0; nt < 4; ++nt) { const int k1 = nt * 16 + fr; const float ang = (float)((k1 * l2) & 4095) * (1.f / 2048.f); const float ct_ = cospif(ang), st_ = sinpif(ang);
        bf16_t* gr = a.Gp + ((((size_t)(b - b_lo) * 64 + k1) * 2 + 0) * 64 + l2) * 256; bf16_t* gi = gr + (size_t)64 * 256;
        const f32x4 R = acc[nt], I = acc[nt + 4]; const f32x4 pr = R * ct_ + I * st_, pi = I * ct_ - R * st_; const int col = colt * 16 + fg * 4;
        u32x2 o; o.x = pk2(pr.x, pr.y); o.y = pk2(pr.z, pr.w); *(u32x2*)(gr + col) = o; o.x = pk2(pi.x, pi.y); o.y = pk2(pi.z, pi.w); *(u32x2*)(gi + col) = o; }
    }
  }
}
constexpr int F2_RS = 272, F2_LDS = 256 * F2_RS;
template <class OutT>
__device__ __forceinline__ void ph_fourier2(const FW& a, int b_lo, int b_hi, OutT* cat, int ldc, char* lds, bool rev = false) {
  const int tid = TIDX, lane = tid & 63, w = tid >> 6, fr = lane & 15, fg = lane >> 4;
  const int nitems = (b_hi - b_lo) * 64;
  for (int item = rev ? gridDim.x - 1 - blockIdx.x : blockIdx.x; item < nitems; item += gridDim.x) {
    const int b = b_lo + item / 64, k1 = item % 64; const bf16_t* src = a.Gp + ((size_t)(b - b_lo) * 64 + k1) * 2 * 64 * 256;
    __syncthreads();
#pragma unroll 4
    for (int itn = 0; itn < 8; ++itn) { const int task = itn * 8 + w; const int K = (task & 1) * 64 + lane, c8 = task >> 1; const u32x4 u = *(const u32x4*)(src + (size_t)K * 256 + c8 * 8); const unsigned uu[4] = {u.x, u.y, u.z, u.w};
#pragma unroll
      for (int j = 0; j < 8; ++j) *(bf16_t*)(lds + (c8 * 8 + j) * F2_RS + K * 2) = (bf16_t)((j & 1) ? (uu[j >> 1] >> 16) : (uu[j >> 1] & 0xffffu)); }
    __syncthreads();
    f32x4 acc[2][4];
#pragma unroll
    for (int ct = 0; ct < 2; ++ct)
#pragma unroll
      for (int nt = 0; nt < 4; ++nt) acc[ct][nt] = (f32x4){0.f, 0.f, 0.f, 0.f};
#pragma unroll
    for (int ks = 0; ks < 4; ++ks) {
      bf16x8 af[2];
#pragma unroll
      for (int ct = 0; ct < 2; ++ct) af[ct] = *(const bf16x8*)(lds + ((2 * w + ct) * 16 + fr) * F2_RS + ks * 64 + fg * 16);
#pragma unroll
      for (int nt = 0; nt < 4; ++nt) { const bf16x8 bf_ = *(const bf16x8*)(a.DFT3 + (nt * 16 + fr) * 128 + ks * 32 + fg * 8);
#pragma unroll
        for (int ct = 0; ct < 2; ++ct) acc[ct][nt] = MFMA16(af[ct], bf_, acc[ct][nt]); }
    }
#pragma unroll
    for (int nt = 0; nt < 4; ++nt) { const int k2 = nt * 16 + fr; OutT* dst = cat + ((size_t)b * FS + FLC + k1 + 64 * k2) * ldc;
#pragma unroll
      for (int ct = 0; ct < 2; ++ct) store4(dst + (2 * w + ct) * 16 + fg * 4, acc[ct][nt] * (1.f / 512.f)); }
  }
}
#include <hip/hip_cooperative_groups.h>
namespace cg = cooperative_groups;
#ifndef DRY_MASK
#define DRY_MASK 0
#endif
#ifndef USE_G8
#define USE_G8 1
#endif
#ifndef G8_P2
#define G8_P2 USE_G8
#endif
#ifndef G8_P6
#define G8_P6 USE_G8
#endif
#ifndef G8_MOE
#define G8_MOE USE_G8
#endif
#ifndef G8_MOED
#define G8_MOED G8_MOE
#endif
#ifndef G8_MOE_L0
#define G8_MOE_L0 G8_MOE
#endif
#ifndef G8_MOE_L1
#define G8_MOE_L1 G8_MOE
#endif
#ifndef G8_P11
#define G8_P11 USE_G8
#endif
#ifndef G8_P18
#define G8_P18 USE_G8
#endif
#if G8_MOE_L1
#define PREP_MOE1() ph_prep_moe<RowMapGate8, RowMapUp8>(f, 1, lds)
#else
#define PREP_MOE1() ph_prep_moe(f, 1, lds)
#endif
struct MK { FP f; RW r; FW w; bf16_t *wt_in0, *wt_in1, *wt_out0, *wt_out1, *w2T, *a2T, *g2T, *T64t, *DFT2, *DFT3; unsigned* bar; int ph_lo, ph_hi; };

__device__ __forceinline__ void ph_mod(const FP& f, char* lds) {
  float* sc = (float*)lds; float* red = sc + 5 * FD;
  const int tid = TIDX;
  for (int i = tid; i < 5 * FD; i += NT) { const int r = i / FD, k = i - r * FD; const float v = r < FB ? f.p.c[r * FD + k] : f.p.c_ctx[k]; sc[i] = v / (1.f + expf(-v)); }
  __syncthreads();
  const int col = tid & 63, kq = tid >> 6;
  for (int item = blockIdx.x; item < 2 * 96; item += gridDim.x) {
    const int layer = item / 96, j = (item % 96) * 64 + col; const float* W = f.p.ada_w + (size_t)layer * FD * 6 * FD + j;
    float a[5] = {0.f, 0.f, 0.f, 0.f, 0.f};
#pragma unroll 8
    for (int kk = 0; kk < 128; ++kk) { const int k = kq * 128 + kk; const float w = W[(size_t)k * 6 * FD];
#pragma unroll
      for (int r = 0; r < 5; ++r) a[r] += sc[r * FD + k] * w; }
#pragma unroll
    for (int r = 0; r < 5; ++r) red[(kq * 5 + r) * 64 + col] = a[r];
    __syncthreads();
    if (tid < 320) { const int r = tid >> 6; float s = f.p.ada_b[layer * 6 * FD + (item % 96) * 64 + col];
#pragma unroll
      for (int q = 0; q < 8; ++q) s += red[(q * 5 + r) * 64 + col];
      f.p.mod[((size_t)layer * 5 + r) * 6 * FD + (item % 96) * 64 + col] = s; }
    __syncthreads();
  }
}
template <bool FIRST>
__device__ __forceinline__ void norm_h_row(const FP& f, int layer, int t, int lane, const f32x4 (&v)[4]) {
  float ss = 0.f;
#pragma unroll
  for (int j = 0; j < 4; ++j) ss += v[j].x * v[j].x + v[j].y * v[j].y + v[j].z * v[j].z + v[j].w * v[j].w;
  const float ri = 1.f / sqrtf(wave_sum(ss) * (1.f / FD) + 1e-6f); const float* md = f_modrow(f, layer, t); const float* gn = f.p.norm_mix + layer * FD;
#pragma unroll
  for (int j = 0; j < 4; ++j) { const int c = j * 256 + lane * 4; const f32x4 g = *(const f32x4*)(gn + c), sh = *(const f32x4*)(md + c), sc = *(const f32x4*)(md + FD + c);
    const f32x4 h = v[j] * ri * g * (sc + 1.f) + sh; u32x2 o; o.x = pk2(h.x, h.y); o.y = pk2(h.z, h.w); *(u32x2*)(f.hb + (size_t)t * FD + c) = o; }
}
__device__ __forceinline__ void ph_norm_h0(const FP& f) {
  const int lane = TIDX & 63, gw = blockIdx.x * (NT / 64) + (TIDX >> 6), ngw = gridDim.x * (NT / 64);
  for (int t = gw; t < FT; t += ngw) { const float* xr = f_xin_row(f, t); f32x4 v[4];
#pragma unroll
    for (int j = 0; j < 4; ++j) v[j] = *(const f32x4*)(xr + j * 256 + lane * 4);
    norm_h_row<true>(f, 0, t, lane, v); }
}
struct EpiOutProj0 { const FP* f;
  __device__ void operator()(const f32x4 (&acc)[4][4], int mb, int nb, int lane) const {
    const int fr = lane & 15, fg = lane >> 4;
#pragma unroll
    for (int mt = 0; mt < 4; ++mt) { const int m = mb + mt * 16 + fr; float* xo = f_xs_row(*f, m); const float* xi = f_xin_row(*f, m); const float* md = f_modrow(*f, 0, m) + 2 * FD;
#pragma unroll
      for (int nt = 0; nt < 4; ++nt) { const int c = nb + nt * 16 + fg * 4; const f32x4 x = *(const f32x4*)(xi + c), g = *(const f32x4*)(md + c); *(f32x4*)(xo + c) = x + g * acc[mt][nt]; } }
  } };
__device__ __forceinline__ void ph_outproj0(const FP& f, const bf16_t* wt, char* lds) {
  ARowPlain ar{f.hb, FD}; EpiOutProj0 ep{&f};
  for (int t = blockIdx.x; t < 68 * 8; t += gridDim.x) gemm_tile<4, 2>(ar, wt, FD, FD, (t >> 3) * 256, (t & 7) * 128, lds, ep);
}
template <bool LAST, bool DRY = false>
__device__ __forceinline__ void ph_combine(const FP& f, int layer) {
  const int lane = TIDX & 63, gw = blockIdx.x * (NT / 64) + (TIDX >> 6), ngw = gridDim.x * (NT / 64);
  int off[17]; off[0] = 0;
#pragma unroll
  for (int e = 0; e < 16; ++e) off[e + 1] = off[e] + f.cnt[e];
  for (int t = gw; t < FT; t += ngw) {
    const int b = t / FS, s = t - b * FS; if (LAST && s < FLC) continue;
    const int e0 = f.tok_e[t * 2], e1 = f.tok_e[t * 2 + 1]; int o0 = 0, o1 = 0;
#pragma unroll
    for (int e = 0; e < 16; ++e) { o0 = e == e0 ? off[e] : o0; o1 = e == e1 ? off[e] : o1; }
    const bf16_t* y0 = f.ymoe + (size_t)(o0 + f.tok_pos[t * 2]) * FD; const bf16_t* y1 = f.ymoe + (size_t)(o1 + f.tok_pos[t * 2 + 1]) * FD;
    const float w0 = f.tok_w[t * 2], w1 = f.tok_w[t * 2 + 1]; float* xr = f_xs_row(f, t); const float* md = f_modrow(f, layer, t) + 5 * FD;
    f32x4 v[4];
#pragma unroll
    for (int j = 0; j < 4; ++j) { const int c = j * 256 + lane * 4; const u32x2 a = *(const u32x2*)(y0 + c), bq = *(const u32x2*)(y1 + c); f32x4 x = *(f32x4*)(xr + c); const f32x4 g = *(const f32x4*)(md + c);
      x.x += g.x * (w0 * bflo(a.x) + w1 * bflo(bq.x)); x.y += g.y * (w0 * bfhi(a.x) + w1 * bfhi(bq.x)); x.z += g.z * (w0 * bflo(a.y) + w1 * bflo(bq.y)); x.w += g.w * (w0 * bfhi(a.y) + w1 * bfhi(bq.y));
      if (!DRY) *(f32x4*)(xr + c) = x; v[j] = x; }
    if (DRY) { asm volatile("" :: "v"(v[0].x), "v"(v[1].y), "v"(v[2].z), "v"(v[3].w)); continue; }
    if (!LAST) norm_h_row<false>(f, layer + 1, t, lane, v);
  }
}
__device__ __forceinline__ void ph_prep_all0(const MK& k, char* lds) {
  const FP& f = k.f;
  for (int t = blockIdx.x; t < 16 * 37; t += gridDim.x) prep_tile(f.p.even_w_in, FD, Z0_N, k.wt_in0, (t & 15) * 64, (t >> 4) * 64, RowMapIn0(), lds);
  { u32x4 z = {0u, 0u, 0u, 0u}; u32x4* dst = (u32x4*)(k.wt_in0 + (size_t)Z0_N * FD); const int n16 = (W0_ROWS - Z0_N) * FD / 8; for (int i = blockIdx.x * NT + TIDX; i < n16; i += gridDim.x * NT) dst[i] = z;
    u32x4* dst1 = (u32x4*)(k.wt_in1 + (size_t)Z1_N * FD); const int n16b = (W1_ROWS - Z1_N) * FD / 8; for (int i = blockIdx.x * NT + TIDX; i < n16b; i += gridDim.x * NT) dst1[i] = z; }
  for (int t = blockIdx.x; t < 16 * 46; t += gridDim.x) prep_tile(f.p.odd_w_in, FD, Z1_N, k.wt_in1, (t & 15) * 64, (t >> 4) * 64, RowMapId(), lds);
  for (int t = blockIdx.x; t < 256; t += gridDim.x) prep_tile(f.p.even_w_out, FD, FD, k.wt_out0, (t & 15) * 64, (t >> 4) * 64, RowMapId(), lds);
  for (int t = blockIdx.x; t < 256; t += gridDim.x) prep_tile(f.p.odd_w_out, FD, FD, k.wt_out1, (t & 15) * 64, (t >> 4) * 64, RowMapId(), lds);
  ph_prep_rwkv(f, k.w2T, k.a2T, k.g2T, lds);
#if G8_MOE_L0
  ph_prep_moe<RowMapGate8, RowMapUp8>(f, 0, lds);
#else
  ph_prep_moe(f, 0, lds);
#endif
  ph_prep_fourier(k.T64t, k.DFT2, k.DFT3);
  if (blockIdx.x == 0 && TIDX < 64) f.cnt[TIDX] = 0;
}

#ifndef PH_MASK
#define PH_MASK 0xffffffffu
#endif
#ifndef USE_XCD_BARRIER
#define USE_XCD_BARRIER 1
#endif
constexpr int N_PHASES = 23;
constexpr int MEGA_LDS = 147456;
__global__ void __launch_bounds__(NT) mega_k(MK karg) {
  extern __shared__ __attribute__((aligned(16))) char lds[];
  cg::grid_group grid = cg::this_grid();
  const MK* kp0 = (const MK*)__builtin_amdgcn_kernarg_segment_ptr();
  const int ph_lo = kp0->ph_lo, ph_hi = kp0->ph_hi;
#if USE_XCD_BARRIER
  if (TIDX == 0) { volatile LAS unsigned* xbst = (volatile LAS unsigned*)(lds + MEGA_LDS - 16); xbst[0] = 0u; xbst[1] = 0u; }
  __syncthreads();
  (void)xcd_barrier_post(kp0->bar, (volatile LAS unsigned*)(lds + MEGA_LDS - 16));
#define GRID_SYNC_ID(id) do { if ((id) == 0) grid.sync(); else { XcdBarrier xb_; xb_.bar = kp0->bar; xb_.x = xb_xcc_id(); xb_.st = (volatile LAS unsigned*)(lds + MEGA_LDS - 16); xcd_barrier(xb_); } } while (0)
#else
#define GRID_SYNC_ID(id) grid.sync()
#endif
#define KARGS() const MK* kp = kp0; asm volatile("" : "+s"(kp)); const MK& k = *kp; const FP& f = k.f; (void)f;
#define PHCODE(id) ((id) > 14 ? (id) - 3 : (id))
#ifndef REP_MASK
#define REP_MASK 0u
#endif
#ifndef SYNC_REP
#define SYNC_REP 1
#endif
#ifndef POISON_ID
#define POISON_ID -1
#endif
#ifndef POISON_VAL
#define POISON_VAL 0x7fc07fc0u
#endif
#define POISON_HOOK(id) if ((id) == POISON_ID) { unsigned* l32 = (unsigned*)lds; for (int i = TIDX; i < 131072 / 4; i += NT) l32[i] = POISON_VAL; __syncthreads(); }
#define PHASE(id, ...) POISON_HOOK(id) if (((PH_MASK >> PHCODE(id)) & 1u) && ph_lo <= (id) && (id) < ph_hi) { for (int rep_ = 0; rep_ <= (int)((REP_MASK >> (id)) & 1u); ++rep_) { KARGS() __VA_ARGS__; if (rep_ < (int)((REP_MASK >> (id)) & 1u)) GRID_SYNC_ID(1); } } if (ph_lo <= (id) && (id) + 1 < ph_hi && (id) + 1 < N_PHASES) { for (int sr_ = 0; sr_ < SYNC_REP; ++sr_) GRID_SYNC_ID(id); }
  PHASE(0, { ph_mod(f, lds); ph_prep_all0(k, lds); })
  PHASE(1, { ph_norm_h0(f); })
#define G8LDS ((G8_LAS unsigned char*)lds)
#define G8DENSE(A_, B_, nM_, nN_, skip_) g8::SchedDense{(const char*)(A_), (const char*)(B_), FD, nM_, nN_, (int)gridDim.x, (int)blockIdx.x, skip_}
#ifdef MOE1_SHIFT
#define G8MOE(W_) g8::SchedMoE<W_>{&f, (int)gridDim.x, (W_) ? (int)((blockIdx.x + 37u) % gridDim.x) : (int)blockIdx.x}
#else
#define G8MOE(W_) g8::SchedMoE<W_>{&f, (int)gridDim.x, (int)blockIdx.x}
#endif
#if G8_P2

  PHASE(2, { g8::gemm_phase(G8LDS, FD, G8DENSE(f.hb, k.wt_in0, 68, 10, 0), g8::EpiIn0{&f}); })
#else
  PHASE(2, { ph_inproj0(f, k.wt_in0, 0, 68, lds); })
#endif
  PHASE(3, { ph_gla_a(f, 0, FB, lds); ph_attn<bf16_t, G8_P2 != 0>(f, 0, FB, f.hb, FD, lds, true); })
  PHASE(4, { if (DRY_MASK & 1) { ph_gla_b<true>(f, 0, FB); } ph_gla_b(f, 0, FB); })
  PHASE(5, { ph_gla_c<bf16_t>(f, 0, FB, f.hb, FD, lds); })
#if G8_P6
  PHASE(6, { g8::gemm_phase(G8LDS, FD, G8DENSE(f.hb, k.wt_out0, 68, 4, 0), g8::EpiOutProj<0>{&f}); })
#else
  PHASE(6, { ph_outproj0(f, k.wt_out0, lds); })
#endif
  PHASE(7, { if (DRY_MASK & 2) { ph_ffn_router<true>(f, 0, lds); } ph_ffn_router(f, 0, lds); })
#if G8_MOE_L0
  PHASE(8, { g8::gemm_phase(G8LDS, FD, G8MOE(0), g8::EpiGU{&f}); })
#else
  PHASE(8, { ph_moe_gemm<0>(f, lds); })
#endif
#ifdef EXTRA_SYNC8
  GRID_SYNC_ID(1); GRID_SYNC_ID(1);
#endif
#ifdef SYNC_ONLY9
  __syncthreads();
#endif
#ifdef POISON_LDS9
  { unsigned* l32 = (unsigned*)lds; for (int i = TIDX; i < 131072 / 4; i += NT) l32[i] = POISON_LDS9; __syncthreads(); }
#endif
#ifdef COPY_ACT
  { KARGS() u32x4* src = (u32x4*)f.act; u32x4* dst = (u32x4*)((char*)f.act + (size_t)40 * 1024 * 1024); const long n16 = (long)2 * FT * 512 * 2 / 16; for (long i = blockIdx.x * (long)NT + TIDX; i < n16; i += (long)gridDim.x * NT) dst[i] = src[i]; } GRID_SYNC_ID(1);
  { KARGS() u32x4* dst = (u32x4*)f.act; u32x4* src = (u32x4*)((char*)f.act + (size_t)40 * 1024 * 1024); const long n16 = (long)2 * FT * 512 * 2 / 16; for (long i = blockIdx.x * (long)NT + TIDX; i < n16; i += (long)gridDim.x * NT) dst[i] = src[i]; } GRID_SYNC_ID(1);
#endif
#ifdef EXTRA_OLD9
  { KARGS() ph_moe_gemm<1>(f, lds); } GRID_SYNC_ID(1);
#endif
#if G8_MOE_L0 && G8_MOED
  PHASE(9, { g8::gemm_phase(G8LDS, 512, G8MOE(1), g8::EpiDown{&f}); })
#else
  PHASE(9, { ph_moe_gemm<1>(f, lds); })
#endif
#ifdef OLD9_AFTER
#ifdef REDO8
  { KARGS() g8::gemm_phase(G8LDS, FD, G8MOE(0), g8::EpiGU{&f}); } GRID_SYNC_ID(1);
#endif
  { KARGS() ph_moe_gemm<1>(f, lds); } GRID_SYNC_ID(1);
#endif
  PHASE(10, { if (DRY_MASK & 4) { ph_combine<false, true>(f, 0); } if (DRY_MASK & 8) { PREP_MOE1(); } ph_combine<false>(f, 0); PREP_MOE1(); })
#if G8_P11
  PHASE(11, { g8::gemm_phase(G8LDS, FD, G8DENSE(f.hb, k.wt_in1, 68, 12, 0), g8::EpiPlain{f.zf, Z1_LD, Z1_N}); if (blockIdx.x == 0 && TIDX < 64) f.cnt[TIDX] = 0; })
#else
  PHASE(11, { ph_inproj1(f, k.wt_in1, 0, 68, lds); if (blockIdx.x == 0 && TIDX < 64) f.cnt[TIDX] = 0; })
#endif
#define RWKV_HALF(half) \
  PHASE(12 + 3 * (half), { ph_rwkv1(k.r, 2 * (half), 2 * (half) + 2, lds); }) \
  PHASE(13 + 3 * (half), { if (DRY_MASK & 16) { ph_rwkv2<true>(k.r, 2 * (half), 2 * (half) + 2); } if (DRY_MASK & 32) { ph_fourier1(k.w, 2 * (half), 2 * (half) + 2, lds, true); } ph_rwkv2(k.r, 2 * (half), 2 * (half) + 2); ph_fourier1(k.w, 2 * (half), 2 * (half) + 2, lds, true); }) \
  PHASE(14 + 3 * (half), { ph_rwkv3<bf16_t>(k.r, 2 * (half), 2 * (half) + 2, f.hb, FD, lds); ph_fourier2<bf16_t>(k.w, 2 * (half), 2 * (half) + 2, f.hb, FD, lds, true); })
  RWKV_HALF(0)
  RWKV_HALF(1)
#if G8_P18
  PHASE(18, { g8::gemm_phase(G8LDS, FD, G8DENSE(f.hb, k.wt_out1, 64, 4, 17), g8::EpiOutProj<1>{&f}); })
#else
  PHASE(18, { ph_outproj(f, k.wt_out1, 1, lds); })
#endif
  PHASE(19, { ph_ffn_router(f, 1, lds); })
#if G8_MOE_L1
  PHASE(20, { g8::gemm_phase(G8LDS, FD, G8MOE(0), g8::EpiGU{&f}); })
#else
  PHASE(20, { ph_moe_gemm<0>(f, lds); })
#endif
#if G8_MOE_L1 && G8_MOED
  PHASE(21, { g8::gemm_phase(G8LDS, 512, G8MOE(1), g8::EpiDown{&f}); })
#else
  PHASE(21, { ph_moe_gemm<1>(f, lds); })
#endif
  PHASE(22, { if (DRY_MASK & 64) { ph_combine<true, true>(f, 1); } ph_combine<true>(f, 1); })
}
static_assert(g8::STAGE_BYTES <= MEGA_LDS - 16 && R1_LDS <= MEGA_LDS && GemmCfg<4, 2>::LDS_BYTES <= MEGA_LDS && F2_LDS <= MEGA_LDS && F1_LDS <= MEGA_LDS && 5 * FD * 4 + 8 * 5 * 64 * 4 <= MEGA_LDS, "LDS budget");

static size_t mega_carve(MK& k, char* base) {
  size_t off = 0; auto take = [&](size_t bytes) { char* r = base ? base + off : nullptr; off += (bytes + 255) & ~(size_t)255; return r; };
  FP& f = k.f;
  k.wt_in0 = (bf16_t*)take((size_t)W0_ROWS * FD * 2); k.wt_in1 = (bf16_t*)take((size_t)W1_ROWS * FD * 2); k.wt_out0 = (bf16_t*)take((size_t)FD * FD * 2); k.wt_out1 = (bf16_t*)take((size_t)FD * FD * 2);
  k.w2T = (bf16_t*)take((size_t)2 * 768 * 64 * 2); k.a2T = (bf16_t*)take((size_t)2 * 768 * 64 * 2); k.g2T = (bf16_t*)take((size_t)768 * 128 * 2);
  k.T64t = (bf16_t*)take(16384); k.DFT2 = (bf16_t*)take(32768); k.DFT3 = (bf16_t*)take(16384);
  f.moe_gu = (bf16_t*)take((size_t)16 * FD * FD * 2); f.moe_d = (bf16_t*)take((size_t)16 * FD * 512 * 2);
  f.p.xc = (float*)take((size_t)FB * FLC * FD * 4); f.p.mod = (float*)take((size_t)2 * 5 * 6 * FD * 4);
  k.bar = (unsigned*)take((size_t)XCD_BAR_WORDS * 4); f.cnt = (int*)take(256); f.list = (int*)take((size_t)16 * FT * 4); f.tok_e = (int*)take((size_t)FT * 8); f.tok_pos = (int*)take((size_t)FT * 8); f.tok_w = (float*)take((size_t)FT * 8);
  f.hb = (bf16_t*)take((size_t)FT * FD * 2);
  char* zreg = take((size_t)FT * Z1_LD * 2); f.zf = (bf16_t*)zreg; f.ymoe = (bf16_t*)zreg;
  const size_t mark = off;
  f.vT = (bf16_t*)take((size_t)FB * 2 * 64 * FS * 2); f.gla_b = (float*)take((size_t)FT * 512 * 4); f.gla_s = (float*)take((size_t)FB * 8 * 2 * 68 * 2048 * 4); f.gla_dec = (float*)take((size_t)FB * 8 * 2 * 68 * 32 * 4);
  const size_t e0 = off; off = mark;
  f.act = (bf16_t*)take((size_t)2 * FT * 512 * 2);
  const size_t e1 = off; off = mark;
  const size_t per = (size_t)2 * 12 * 2 * 68 * 4096 * 2;
  k.r.M = (bf16_t*)take(per); k.r.N = (bf16_t*)take(per); k.r.R2 = (bf16_t*)take(per); k.r.Y0 = (bf16_t*)take(per); k.w.Gp = (bf16_t*)take((size_t)2 * 64 * 2 * 64 * 256 * 2);
  const size_t e2 = off; off = e0 > e1 ? e0 : e1; off = off > e2 ? off : e2;
  return off;
}
extern "C" void kernel_launch(void* const* d_in, const int* in_sizes, int n_in, void* d_out, int out_size, void* d_ws, size_t ws_size, hipStream_t stream) {
  static MK k; static int grid_blocks = 0;
  memset(&k, 0, sizeof(k));
  if (n_in != 34 || out_size != FB * FL * FD) { fprintf(stderr, "kernel_launch: unexpected n_in %d / out_size %d\n", n_in, out_size); return; }
  NP& p = k.f.p; np_set_dims(p, FB, FL, FLC, FD); np_set_inputs(p, d_in); p.out = (float*)d_out;
  const size_t need = mega_carve(k, nullptr);
  if (need > ws_size) { fprintf(stderr, "kernel_launch: ws too small: need %zu have %zu\n", need, ws_size); return; }
  mega_carve(k, (char*)d_ws);
  RW& r = k.r; r.z = k.f.zf; r.w2T = k.w2T; r.a2T = k.a2T; r.g2T = k.g2T; r.mu = p.rwkv_mu; r.w0 = p.rwkv_w0; r.a0 = p.rwkv_a0; r.kk_scale = p.rwkv_kk_scale; r.k_a = p.rwkv_k_a; r.r_k = p.rwkv_r_k; r.ln_g = p.rwkv_ln_g; r.ln_b = p.rwkv_ln_b;
  k.w.z = k.f.zf; k.w.T64t = k.T64t; k.w.DFT2 = k.DFT2; k.w.DFT3 = k.DFT3;
  k.ph_lo = 0; k.ph_hi = N_PHASES;
  if (!grid_blocks) {
    int dev = 0, cus = 0, per_cu = 0; hipGetDevice(&dev); hipDeviceGetAttribute(&cus, hipDeviceAttributeMultiprocessorCount, dev);
    hipFuncSetAttribute((const void*)mega_k, hipFuncAttributeMaxDynamicSharedMemorySize, MEGA_LDS);
    hipOccupancyMaxActiveBlocksPerMultiprocessor(&per_cu, mega_k, NT, MEGA_LDS);
    if (per_cu < 1) fprintf(stderr, "kernel_launch: occupancy query says %d blocks/CU\n", per_cu);
    grid_blocks = cus;
    fprintf(stderr, "kernel_launch: cus %d per_cu %d grid %d ws need %zu MB of %zu MB\n", cus, per_cu, grid_blocks, need >> 20, ws_size >> 20);
  }
  hipMemsetAsync(k.bar, 0, (size_t)XCD_BAR_WORDS * 4, stream);
#if MEGA_MULTI_LAUNCH
  for (int ph = 0; ph < N_PHASES; ++ph) { k.ph_lo = ph; k.ph_hi = ph + 1; void* args[] = {&k}; hipLaunchCooperativeKernel((void*)mega_k, dim3(grid_blocks), dim3(NT), args, MEGA_LDS, stream); }
#else
  void* args[] = {&k};
  hipError_t e = hipLaunchCooperativeKernel((void*)mega_k, dim3(grid_blocks), dim3(NT), args, MEGA_LDS, stream);
#ifdef RERUN_LO
  { static MK k2; k2 = k; k2.ph_lo = RERUN_LO; k2.ph_hi = RERUN_HI; void* args2[] = {&k2}; hipMemsetAsync(k.bar, 0, (size_t)XCD_BAR_WORDS * 4, stream);
    hipLaunchCooperativeKernel((void*)mega_k, dim3(grid_blocks), dim3(NT), args2, MEGA_LDS, stream); }
#endif
  if (e != hipSuccess) fprintf(stderr, "cooperative launch failed: %s (grid %d)\n", hipGetErrorString(e), grid_blocks);
#endif
}
```

```cpp
#include <hip/hip_runtime.h>
#include <cstdio>
#include <cstring>
constexpr int FB = 4, FL = 4096, FLC = 256, FS = 4352, FT = 17408, FD = 1024;
constexpr int Z0_GQ = 0, Z0_GK = 256, Z0_GV = 512, Z0_GG = 1024, Z0_AQ = 1536, Z0_AK = 2048, Z0_AV = 2176, Z0_GDEC = 2304, Z0_N = 2336, Z0_LD = 2432;
constexpr int Z1_N = 2944, Z1_LD = 2944;
constexpr int W0_ROWS = 2560, W1_ROWS = 3072;
constexpr int SRC_GDEC = 1536, SRC_AQ = 1568;
__host__ __device__ __forceinline__ int z0_dst_of_src(int n) { return n < SRC_GDEC ? n : (n < SRC_AQ ? Z0_GDEC + (n - SRC_GDEC) : n - 32); }
__host__ __device__ __forceinline__ int z0_src_of_dst(int d) { return d < Z0_AQ ? d : (d < Z0_GDEC ? d + 32 : (d < Z0_N ? SRC_GDEC + (d - Z0_GDEC) : -1)); }
#include <math.h>
#include <stdint.h>
#ifdef HOST_TEST
#define HD
#define FAST_SIN sinf
#define FAST_COS cosf
#define MEMBAR()
#else
#define HD __host__ __device__ __forceinline__
#define FAST_SIN __sinf
#define FAST_COS __cosf
#define MEMBAR() asm volatile("" ::: "memory")
#endif

struct NP {
  int B, L, LC, S, T, D, GW;
  int GH, GC, AH, AKV, FW, FG, RD, RH, DE, E;
  int EC, OC, RC, NZ;
  int e_gq, e_gk, e_gv, e_gg, e_gdec, e_aq, e_ak, e_av;
  int layer, b0, dir, which, pad0;
  const float *x, *c, *ctx, *c_ctx, *ada_w, *ada_b, *norm_mix, *norm_ffn, *even_w_in, *even_w_out, *gla_dec_w, *gla_dec_b,
      *gla_out_norm, *att_q_norm, *att_k_norm, *att_sink, *odd_w_in, *odd_w_out, *rwkv_mu, *rwkv_w0, *rwkv_w2, *rwkv_a0,
      *rwkv_a2, *rwkv_g2, *rwkv_kk_scale, *rwkv_k_a, *rwkv_r_k, *rwkv_ln_g, *rwkv_ln_b, *router_w, *router_b, *moe_w_gate,
      *moe_w_up, *moe_w_down;
  float *out;
  float *xc;
  float *mod;
  float *rinv;
  float *hbuf;
  float *zb;
  float *lad;
  float *ogla;
  float *kkb;
  float *rsb, *vsb;
  float *decb, *ab, *kdb;
  float *yb;
  float *fa, *fb;
  float *cosT, *sinT;
  int *re;
  float *rw;
  float *act;
};

HD float sigm(float x) { return 1.f / (1.f + expf(-x)); }
HD float siluf_(float x) { return x * sigm(x); }
HD float softplusf_(float x) { return x > 0.f ? x + log1pf(expf(-x)) : log1pf(expf(x)); }
HD float logsigm(float x) { return -softplusf_(-x); }
HD float* xs_row(const NP& p, int t) { int b = t / p.S, s = t % p.S; return s < p.LC ? p.xc + ((size_t)b * p.LC + s) * p.D : p.out + ((size_t)b * p.L + (s - p.LC)) * p.D; }
HD const float* modrow(const NP& p, int layer, int t) { int b = t / p.S, s = t % p.S; int r = s < p.LC ? p.B : b; return p.mod + ((size_t)layer * (p.B + 1) + r) * 6 * p.D; }
HD float zs_at(const NP& p, int s, int c) {
  const float* z = p.zb + (size_t)s * p.NZ + p.FW + c;
  int seg0 = s < p.LC ? 0 : p.LC, seg1 = s < p.LC ? p.LC : p.S;
  float zc = z[0], pv = s > seg0 ? z[-p.NZ] : 0.f, nx = s < seg1 - 1 ? z[p.NZ] : 0.f;
  return zc + p.rwkv_mu[c] * (0.5f * (pv + nx) - zc);
}

static inline void np_set_dims(NP& p, int B, int L, int LC, int D) {
  p.B = B; p.L = L; p.LC = LC; p.S = L + LC; p.T = B * p.S; p.D = D; p.GW = 64;
  p.GH = (D / 2) / 64; p.GC = p.GH * 32; p.AH = (D / 2) / 64; p.AKV = p.AH / 4; p.FW = D / 4; p.FG = p.FW / 64; p.RD = D - p.FW; p.RH = p.RD / 64;
  p.DE = D == 1024 ? 512 : D / 2; p.E = 16;
  p.e_gq = 0; p.e_gk = p.e_gq + p.GH * 32; p.e_gv = p.e_gk + p.GH * 32; p.e_gg = p.e_gv + p.GH * 64; p.e_gdec = p.e_gg + p.GH * 64; p.e_aq = p.e_gdec + 32;
  p.e_ak = p.e_aq + p.AH * 64; p.e_av = p.e_ak + p.AKV * 64; p.EC = p.e_av + p.AKV * 64;
  p.RC = 3 * p.RD + 128 + 128 + 128; p.OC = p.FW + p.RC; p.NZ = p.OC > p.EC ? p.OC : p.EC;
}
static inline void np_set_inputs(NP& p, void* const* d_in) {
  const float** f = (const float**)&p.x; for (int i = 0; i < 34; ++i) f[i] = (const float*)d_in[i];
}
typedef unsigned short bf16_t;
typedef short bf16x8 __attribute__((ext_vector_type(8)));
typedef float f32x4 __attribute__((ext_vector_type(4)));
typedef float f32x2 __attribute__((ext_vector_type(2)));
typedef unsigned u32x4 __attribute__((ext_vector_type(4)));
typedef unsigned u32x2 __attribute__((ext_vector_type(2)));
typedef __bf16 bf16v2 __attribute__((ext_vector_type(2)));
#define NT 512
#define NBLK_MAX 256

__device__ __forceinline__ int tid_opaque() { int t = threadIdx.x; asm volatile("" : "+v"(t)); return t; }
#define TIDX tid_opaque()
__device__ __forceinline__ unsigned pk2(float a, float b) { bf16v2 r = __builtin_convertvector((f32x2){a, b}, bf16v2); return __builtin_bit_cast(unsigned, r); }
__device__ __forceinline__ bf16_t f2bf(float a) { return (bf16_t)(pk2(a, 0.f) & 0xffffu); }
__device__ __forceinline__ float bf2f(bf16_t v) { return __uint_as_float((unsigned)v << 16); }
__device__ __forceinline__ float bflo(unsigned u) { return __uint_as_float(u << 16); }
__device__ __forceinline__ float bfhi(unsigned u) { return __uint_as_float(u & 0xffff0000u); }
__device__ __forceinline__ float wave_sum(float v) {
#pragma unroll
  for (int o = 1; o < 64; o <<= 1) v += __shfl_xor(v, o);
  return v;
}
template <int CTRL, int ROW_MASK = 0xf>
__device__ __forceinline__ float dppmov(float v) { return __int_as_float(__builtin_amdgcn_update_dpp(0, __float_as_int(v), CTRL, ROW_MASK, 0xf, true)); }
__device__ __forceinline__ float wave_sum_dpp(float v) {
  v += dppmov<0x128>(v); v += dppmov<0x124>(v); v += dppmov<0x122>(v); v += dppmov<0x121>(v);
  v += dppmov<0x142, 0xa>(v); v += dppmov<0x143, 0xc>(v);
  return __int_as_float(__builtin_amdgcn_readlane(__float_as_int(v), 63));
}
__device__ __forceinline__ bf16x8 pack8(const float (&v)[8]) { u32x4 u; u.x = pk2(v[0], v[1]); u.y = pk2(v[2], v[3]); u.z = pk2(v[4], v[5]); u.w = pk2(v[6], v[7]); return __builtin_bit_cast(bf16x8, u); }
__device__ __forceinline__ float fsigm(float x) { return __builtin_amdgcn_rcpf(1.f + __expf(-x)); }
__device__ __forceinline__ float fsilu(float x) { return x * fsigm(x); }

template <int WM, int WN> struct GemmCfg { static constexpr int BM = WM * 64, BN = WN * 64, STAGE = (BM + BN) * 128, LDS_BYTES = 2 * STAGE; };

template <int WM, int WN, class ARow, class Epi>
__device__ __forceinline__ void gemm_tile(const ARow& arow, const bf16_t* __restrict__ Bt, int ldb, int K, int m0, int n0, char* lds, const Epi& epi) {
  constexpr int BM = WM * 64, BN = WN * 64, STAGE = (BM + BN) * 128;
  const int tid = TIDX, lane = tid & 63, wave = tid >> 6, wm = wave / WN, wn = wave % WN;
  const int crow = tid >> 3, kc = tid & 7;
  const bf16_t* ap[WM]; const bf16_t* bp[WN];
#pragma unroll
  for (int i = 0; i < WM; ++i) ap[i] = arow(m0 + crow + 64 * i) + kc * 8;
#pragma unroll
  for (int i = 0; i < WN; ++i) bp[i] = Bt + (size_t)(n0 + crow + 64 * i) * ldb + kc * 8;
  const int wofs = crow * 128 + ((kc ^ (crow & 7)) << 4);
  u32x4 ra[WM], rb[WN];
  f32x4 acc[4][4];
#pragma unroll
  for (int i = 0; i < 4; ++i)
#pragma unroll
    for (int j = 0; j < 4; ++j) acc[i][j] = (f32x4){0.f, 0.f, 0.f, 0.f};
  const int nk = K / 64;
#pragma unroll
  for (int i = 0; i < WM; ++i) ra[i] = *(const u32x4*)(ap[i]);
#pragma unroll
  for (int i = 0; i < WN; ++i) rb[i] = *(const u32x4*)(bp[i]);
  __syncthreads();
#pragma unroll
  for (int i = 0; i < WM; ++i) *(u32x4*)(lds + wofs + i * 8192) = ra[i];
#pragma unroll
  for (int i = 0; i < WN; ++i) *(u32x4*)(lds + BM * 128 + wofs + i * 8192) = rb[i];
  __syncthreads();
  const int fr = lane & 15, fg = lane >> 4;
  for (int kt = 0; kt < nk; ++kt) {
    char* cur = lds + (kt & 1) * STAGE; char* nxt = lds + ((kt + 1) & 1) * STAGE;
    if (kt + 1 < nk) {
#pragma unroll
      for (int i = 0; i < WM; ++i) ra[i] = *(const u32x4*)(ap[i] + (kt + 1) * 64);
#pragma unroll
      for (int i = 0; i < WN; ++i) rb[i] = *(const u32x4*)(bp[i] + (kt + 1) * 64);
    }
    const char* As = cur + (wm * 64) * 128; const char* Bs = cur + BM * 128 + (wn * 64) * 128;
#pragma unroll
    for (int kh = 0; kh < 2; ++kh) {
      bf16x8 af[4], bfr[4];
      const int ch = kh * 4 + fg;
#pragma unroll
      for (int t = 0; t < 4; ++t) { const int r = t * 16 + fr; const int o = r * 128 + ((ch ^ (r & 7)) << 4); af[t] = *(const bf16x8*)(As + o); bfr[t] = *(const bf16x8*)(Bs + o); }
#pragma unroll
      for (int mt = 0; mt < 4; ++mt)
#pragma unroll
        for (int nt = 0; nt < 4; ++nt) acc[mt][nt] = __builtin_amdgcn_mfma_f32_16x16x32_bf16(bfr[nt], af[mt], acc[mt][nt], 0, 0, 0);
    }
    if (kt + 1 < nk) {
#pragma unroll
      for (int i = 0; i < WM; ++i) *(u32x4*)(nxt + wofs + i * 8192) = ra[i];
#pragma unroll
      for (int i = 0; i < WN; ++i) *(u32x4*)(nxt + BM * 128 + wofs + i * 8192) = rb[i];
    }
    __syncthreads();
  }
  epi(acc, m0 + wm * 64, n0 + wn * 64, lane);
}

template <class RowMap>
__device__ __forceinline__ void prep_tile(const float* __restrict__ W, int K, int N, bf16_t* __restrict__ Wt, int k0, int n0, const RowMap& rm, char* lds) {
  float* tile = (float*)lds; const int tid = TIDX;
  __syncthreads();
  { const int k = tid >> 3, n8 = (tid & 7) * 8; const float* src = W + (size_t)(k0 + k) * N + n0 + n8;
#pragma unroll
    for (int j = 0; j < 8; ++j) tile[k * 65 + n8 + j] = (n0 + n8 + j < N) ? src[j] : 0.f; }
  __syncthreads();
  { const int n = tid >> 3, k8 = (tid & 7) * 8; const int dr = (n0 + n < N) ? rm(n0 + n) : -1;
    if (dr >= 0) { u32x4 o; const float* s = tile + k8 * 65 + n;
      o.x = pk2(s[0], s[65]); o.y = pk2(s[130], s[195]); o.z = pk2(s[260], s[325]); o.w = pk2(s[390], s[455]);
      *(u32x4*)(Wt + (size_t)dr * K + k0 + k8) = o; } }
}

template <class RowMap>
__device__ __forceinline__ void prep_strip(const float* __restrict__ W, int K, int N, bf16_t* __restrict__ Wt, int k0, int n0, const RowMap& rm, char* lds) {
  float* tile = (float*)lds; const int tid = TIDX;
  __syncthreads();
  { const int k = tid >> 3, n32 = (tid & 7) * 32; const float* src = W + (size_t)(k0 + k) * N + n0 + n32;
#pragma unroll
    for (int q = 0; q < 8; ++q) { const int n = n32 + q * 4; f32x4 v = {0.f, 0.f, 0.f, 0.f}; if (n0 + n + 3 < N) v = *(const f32x4*)(src + q * 4); else {
#pragma unroll
        for (int j = 0; j < 4; ++j) if (n0 + n + j < N) v[j] = src[q * 4 + j]; }
      tile[k * 257 + n] = v.x; tile[k * 257 + n + 1] = v.y; tile[k * 257 + n + 2] = v.z; tile[k * 257 + n + 3] = v.w; } }
  __syncthreads();
#pragma unroll
  for (int q = 0; q < 4; ++q) { const int n = q * 64 + (tid >> 3), k8 = (tid & 7) * 8; const int dr = (n0 + n < N) ? rm(n0 + n) : -1;
    if (dr >= 0) { u32x4 o; const float* s = tile + k8 * 257 + n;
      o.x = pk2(s[0], s[257]); o.y = pk2(s[514], s[771]); o.z = pk2(s[1028], s[1285]); o.w = pk2(s[1542], s[1799]);
      *(u32x4*)(Wt + (size_t)dr * K + k0 + k8) = o; } }
}
#define XB_TMO      128
#define XB_XCNT(j)  (256  + 64 * (j))
#define XB_XSUB(j)  (1280 + 64 * (j))
#define XB_XGEN(j)  (2304 + 64 * (j))
#define XB_TOP      3328
#define XB_TOPGEN   3392
#define XCD_BAR_WORDS 3456
#define XB_SPIN_CAP (1u << 22)
#define LAS __attribute__((address_space(3)))
__device__ __forceinline__ unsigned xb_ld(unsigned* p)              { return __hip_atomic_load(p, __ATOMIC_RELAXED, __HIP_MEMORY_SCOPE_AGENT); }
__device__ __forceinline__ unsigned xb_add(unsigned* p, unsigned v) { return __hip_atomic_fetch_add(p, v, __ATOMIC_RELAXED, __HIP_MEMORY_SCOPE_AGENT); }
__device__ __forceinline__ unsigned xb_xcc_id() { return (unsigned)__builtin_amdgcn_s_getreg((3 << 11) | 20) & 0xFu; }
#define XB_SPIN(cond, bar) do { unsigned _sp = 0; while (cond) { __builtin_amdgcn_s_sleep(1); \
    if ((++_sp & 255u) == 0u) { if (xb_ld(&(bar)[XB_TMO])) break; if (_sp > XB_SPIN_CAP) { atomicAdd(&(bar)[XB_TMO], 1u); break; } } } } while (0)
struct XcdBarrier { unsigned* bar; unsigned x; volatile LAS unsigned* st; };
__device__ __forceinline__ XcdBarrier xcd_barrier_post(unsigned* bar, volatile LAS unsigned* st) {
  XcdBarrier b; b.bar = bar; b.x = xb_xcc_id(); b.st = st;
  if (threadIdx.x == 0) (void)xb_add(&bar[XB_XCNT(b.x)], 1u);
  return b;
}
__device__ __forceinline__ void xcd_barrier_complete(unsigned* bar, unsigned x, unsigned& nloc, unsigned& nx) {
  const unsigned G = gridDim.x * gridDim.y * gridDim.z; unsigned sum, cnt, mine, sp = 0u;
  for (;;) {
    sum = 0u; cnt = 0u; mine = 0u;
#pragma unroll
    for (unsigned j = 0; j < 16; ++j) { const unsigned c = xb_ld(&bar[XB_XCNT(j)]); sum += c; cnt += (c > 0u) ? 1u : 0u; mine = (j == x) ? c : mine; }
    if (sum == G) break;
    __builtin_amdgcn_s_sleep(1);
    if ((++sp & 255u) == 0u) { if (xb_ld(&bar[XB_TMO])) break; if (sp > XB_SPIN_CAP) { atomicAdd(&bar[XB_TMO], 1u); break; } }
  }
  nloc = mine > 0u ? mine : 1u; nx = cnt > 0u ? cnt : 1u;
}
__device__ __forceinline__ void xcd_barrier(const XcdBarrier& b) {
  asm volatile("s_waitcnt vmcnt(0)" ::: "memory");
  __syncthreads();
  if (threadIdx.x == 0) {
    unsigned* bar = b.bar;
    __builtin_amdgcn_s_waitcnt(0);
    unsigned nloc = b.st[0], nx = b.st[1];
    if (nloc == 0u) { xcd_barrier_complete(bar, b.x, nloc, nx); b.st[0] = nloc; b.st[1] = nx; }
    const unsigned old = xb_add(&bar[XB_XSUB(b.x)], 1u);
    const unsigned gen = old / nloc;
    if (old + 1u == (gen + 1u) * nloc) {
      __builtin_amdgcn_fence(__ATOMIC_RELEASE, "agent");
      asm volatile("s_waitcnt vmcnt(0)" ::: "memory");
      const unsigned og = xb_add(&bar[XB_TOP], 1u);
      const unsigned tg = og / nx;
      if (og + 1u == (tg + 1u) * nx) xb_add(&bar[XB_TOPGEN], 1u);
      else XB_SPIN(xb_ld(&bar[XB_TOPGEN]) == tg, bar);
      __builtin_amdgcn_fence(__ATOMIC_ACQUIRE, "agent");
      xb_add(&bar[XB_XGEN(b.x)], 1u);
      asm volatile("s_waitcnt vmcnt(0)" ::: "memory");
    } else {
      XB_SPIN(xb_ld(&bar[XB_XGEN(b.x)]) == gen, bar);
      __builtin_amdgcn_fence(__ATOMIC_ACQUIRE, "agent");
      asm volatile("s_waitcnt vmcnt(0)" ::: "memory");
    }
  }
  __syncthreads();
}
struct RowMapIn0 { __device__ int operator()(int n) const { return z0_dst_of_src(n); } };
struct RowMapId { __device__ int operator()(int n) const { return n; } };
struct ARowPlain { const bf16_t* base; int lda; __device__ const bf16_t* operator()(int m) const { return base + (size_t)m * lda; } };
struct FP {
  NP p;
  bf16_t* hb;
  bf16_t* wt_in;
  bf16_t* wt_out;
  bf16_t* moe_gu;
  bf16_t* moe_d;
  int* cnt;
  int* list;
  int* tok_e;
  int* tok_pos;
  float* tok_w;
  bf16_t* act;
  bf16_t* ymoe;
  bf16_t* zf;
  bf16_t* vT;
  float* gla_b;
  float* gla_s;
  float* gla_dec;
  int layer; int pad1;
};
__device__ __forceinline__ float* f_xs_row(const FP& f, int t) { const int b = t / FS, s = t - b * FS; return s < FLC ? f.p.xc + ((size_t)b * FLC + s) * FD : f.p.out + ((size_t)b * FL + (s - FLC)) * FD; }
__device__ __forceinline__ const float* f_modrow(const FP& f, int layer, int t) { const int b = t / FS, s = t - b * FS; const int r = s < FLC ? FB : b; return f.p.mod + ((size_t)layer * (FB + 1) + r) * 6 * FD; }
__device__ __forceinline__ const float* f_xin_row(const FP& f, int t) { const int b = t / FS, s = t - b * FS; return s < FLC ? f.p.ctx + ((size_t)b * FLC + s) * FD : f.p.x + ((size_t)b * FL + (s - FLC)) * FD; }

struct RowMapGate { __device__ int operator()(int j) const { return (j >> 5) * 64 + (j & 31); } };
struct RowMapUp { __device__ int operator()(int j) const { return (j >> 5) * 64 + 32 + (j & 31); } };
__device__ __forceinline__ void ph_prep_out(const FP& f, int layer, char* lds) {
  const float* W = layer == 0 ? f.p.even_w_out : f.p.odd_w_out;
  for (int t = blockIdx.x; t < 16 * 16; t += gridDim.x) prep_tile(W, FD, FD, f.wt_out, (t & 15) * 64, (t >> 4) * 64, RowMapId(), lds);
}
template <class GateMap = RowMapGate, class UpMap = RowMapUp>
__device__ __forceinline__ void ph_prep_moe(const FP& f, int layer, char* lds) {
  const int per_e = 32 * 3;
  for (int t = blockIdx.x; t < 16 * per_e; t += gridDim.x) {
    const int e = t / per_e, r = t % per_e, which = r / 32, q = r % 32;
    if (which == 0) prep_strip(f.p.moe_w_gate + (size_t)(layer * 16 + e) * FD * 512, FD, 512, f.moe_gu + (size_t)e * FD * FD, (q & 15) * 64, (q >> 4) * 256, GateMap(), lds);
    else if (which == 1) prep_strip(f.p.moe_w_up + (size_t)(layer * 16 + e) * FD * 512, FD, 512, f.moe_gu + (size_t)e * FD * FD, (q & 15) * 64, (q >> 4) * 256, UpMap(), lds);
    else prep_strip(f.p.moe_w_down + (size_t)(layer * 16 + e) * 512 * FD, 512, FD, f.moe_d + (size_t)e * FD * 512, (q & 7) * 64, (q >> 3) * 256, RowMapId(), lds);
  }
}
struct EpiOutProj { const FP* f; int layer;
  __device__ void operator()(const f32x4 (&acc)[4][4], int mb, int nb, int lane) const {
    const int fr = lane & 15, fg = lane >> 4;
#pragma unroll
    for (int mt = 0; mt < 4; ++mt) { const int m = mb + mt * 16 + fr; float* xr = f_xs_row(*f, m); const float* md = f_modrow(*f, layer, m) + 2 * FD;
#pragma unroll
      for (int nt = 0; nt < 4; ++nt) { const int c = nb + nt * 16 + fg * 4; f32x4 x = *(f32x4*)(xr + c); const f32x4 g = *(const f32x4*)(md + c); x += g * acc[mt][nt]; *(f32x4*)(xr + c) = x; } }
  } };
__device__ __forceinline__ void ph_outproj(const FP& f, const bf16_t* wt, int layer, char* lds) {
  ARowPlain ar{f.hb, FD}; EpiOutProj ep{&f, layer};
  for (int t = blockIdx.x; t < 68 * 8; t += gridDim.x) { const int tm = t >> 3, tn = t & 7; if (layer == 1 && (tm % 17) == 0) continue; gemm_tile<4, 2>(ar, wt, FD, FD, tm * 256, tn * 128, lds, ep); }
}
template <bool DRY = false>
__device__ __forceinline__ void ph_ffn_router(const FP& f, int layer, char* lds) {
  const int tid = TIDX, lane = tid & 63, w = tid >> 6;
  f32x4* rwl = (f32x4*)lds; int* lcnt = (int*)(lds + 65536); int* lbase = lcnt + 16; int* rec = lbase + 16;
  __syncthreads();
  for (int idx = tid; idx < 4096; idx += NT) { const int k = idx >> 2, q = idx & 3; const int j = k >> 8, ln = (k & 255) >> 2, i = k & 3; rwl[((j * 4 + i) * 4 + q) * 64 + ln] = *(const f32x4*)(f.p.router_w + (size_t)k * 16 + q * 4); }
  if (tid < 16) lcnt[tid] = 0;
  const int tb = blockIdx.x * 68;
  f32x4* modl = (f32x4*)(lds + 69632);
  { const int set = tid >> 8, q4 = tid & 255; const int rr = set == 0 ? FB : tb / FS; const float* md = f.p.mod + ((size_t)layer * (FB + 1) + rr) * 6 * FD; const int c = q4 * 4;
    const f32x4 g = *(const f32x4*)(f.p.norm_ffn + layer * FD + c), sh = *(const f32x4*)(md + 3 * FD + c), sc = *(const f32x4*)(md + 4 * FD + c);
    modl[set * 512 + q4] = g * (sc + 1.f); modl[set * 512 + 256 + q4] = sh; }
  __syncthreads();
  const float rbl = f.p.router_b[lane & 15];
  f32x4 vn[4];
  { const float* xr0 = f_xs_row(f, tb + w);
#pragma unroll
    for (int j = 0; j < 4; ++j) vn[j] = *(const f32x4*)(xr0 + j * 256 + lane * 4); }
  for (int tl = w; tl < 68; tl += 8) {
    const int t = tb + tl; const int b = t / FS, s = t - b * FS; const bool skip = (layer == 1 && s < FLC) || t >= FT;
    f32x4 v[4];
#pragma unroll
    for (int j = 0; j < 4; ++j) v[j] = vn[j];
    { const float* xrn = f_xs_row(f, tl + 8 < 68 ? t + 8 : t);
#pragma unroll
      for (int j = 0; j < 4; ++j) vn[j] = *(const f32x4*)(xrn + j * 256 + lane * 4); }
    if (skip) { if (lane == 0) rec[tl * 4] = -1; continue; }
    const f32x4* mset = modl + (s < FLC ? 0 : 512);
    float ss = 0.f;
#pragma unroll
    for (int j = 0; j < 4; ++j) { ss += v[j].x * v[j].x + v[j].y * v[j].y + v[j].z * v[j].z + v[j].w * v[j].w; }
    const float ri = __builtin_amdgcn_rsqf(wave_sum_dpp(ss) * (1.f / FD) + 1e-6f);
    float lg[16];
#pragma unroll
    for (int e = 0; e < 16; ++e) lg[e] = 0.f;
#pragma unroll
    for (int j = 0; j < 4; ++j) { const int c = j * 256 + lane * 4; const f32x4 g = mset[j * 64 + lane], sh = mset[256 + j * 64 + lane];
      f32x4 h = v[j] * ri * g + sh; u32x2 o; o.x = pk2(h.x, h.y); o.y = pk2(h.z, h.w); *(u32x2*)(f.hb + (size_t)t * FD + c) = o;
#pragma unroll
      for (int i = 0; i < 4; ++i) { const float hv = h[i];
#pragma unroll
        for (int q = 0; q < 4; ++q) { const f32x4 wv = rwl[((j * 4 + i) * 4 + q) * 64 + lane]; lg[q * 4 + 0] += hv * wv.x; lg[q * 4 + 1] += hv * wv.y; lg[q * 4 + 2] += hv * wv.z; lg[q * 4 + 3] += hv * wv.w; } } }
    { const int c = lane & 15; u32x4 s1 = {0u, 0u, 0u, 0u}, s2 = {0u, 0u, 0u, 0u}; const unsigned one = (c & 1) ? 0x3F800000u : 0x00003F80u; const int dq = (c & 7) >> 1;
      const unsigned o1 = c < 8 ? one : 0u, o2 = c < 8 ? 0u : one;
      s1.x = dq == 0 ? o1 : 0u; s1.y = dq == 1 ? o1 : 0u; s1.z = dq == 2 ? o1 : 0u; s1.w = dq == 3 ? o1 : 0u;
      s2.x = dq == 0 ? o2 : 0u; s2.y = dq == 1 ? o2 : 0u; s2.z = dq == 2 ? o2 : 0u; s2.w = dq == 3 ? o2 : 0u;
      f32x4 d1 = {0.f, 0.f, 0.f, 0.f};
#pragma unroll
      for (int hf = 0; hf < 2; ++hf) { float hi8[8], lo8[8];
#pragma unroll
        for (int e = 0; e < 8; ++e) hi8[e] = lg[hf * 8 + e];
        const bf16x8 ph = pack8(hi8); const u32x4 pu = __builtin_bit_cast(u32x4, ph); const unsigned pw[4] = {pu.x, pu.y, pu.z, pu.w};
#pragma unroll
        for (int e = 0; e < 8; ++e) lo8[e] = hi8[e] - ((e & 1) ? bfhi(pw[e >> 1]) : bflo(pw[e >> 1]));
        const bf16x8 sel = __builtin_bit_cast(bf16x8, hf ? s2 : s1);
        d1 = __builtin_amdgcn_mfma_f32_16x16x32_bf16(ph, sel, d1, 0, 0, 0); d1 = __builtin_amdgcn_mfma_f32_16x16x32_bf16(pack8(lo8), sel, d1, 0, 0, 0); }
      u32x4 bh, bl; bh.x = pk2(d1.x, d1.y); bh.y = pk2(d1.z, d1.w); bh.z = 0u; bh.w = 0u;
      bl.x = pk2(d1.x - bflo(bh.x), d1.y - bfhi(bh.x)); bl.y = pk2(d1.z - bflo(bh.y), d1.w - bfhi(bh.y)); bl.z = 0u; bl.w = 0u;
      const u32x4 on4 = {0x3F803F80u, 0x3F803F80u, 0u, 0u}; f32x4 d2 = {0.f, 0.f, 0.f, 0.f};
      d2 = __builtin_amdgcn_mfma_f32_16x16x32_bf16(__builtin_bit_cast(bf16x8, on4), __builtin_bit_cast(bf16x8, bh), d2, 0, 0, 0);
      d2 = __builtin_amdgcn_mfma_f32_16x16x32_bf16(__builtin_bit_cast(bf16x8, on4), __builtin_bit_cast(bf16x8, bl), d2, 0, 0, 0);
      lg[0] = d2.x; }
    int i0, i1; float s0, s1;
    { const int c = lane & 15; const float scv = __builtin_amdgcn_rcpf(1.f + __expf(-lg[0])); const float selv = scv + rbl;
      const float v1 = dppmov<0xB1>(selv), v2 = dppmov<0x4E>(selv), v3 = dppmov<0x1B>(selv);
      const float hi01 = fmaxf(selv, v1), lo01 = fminf(selv, v1), hi23 = fmaxf(v2, v3), lo23 = fminf(v2, v3);
      float gs = fmaxf(hi01, hi23) + fmaxf(fmaxf(lo01, lo23), fminf(hi01, hi23));
      int gi = c >> 2;
      { const float og = dppmov<0x124>(gs); const int oi = __float_as_int(dppmov<0x124>(__int_as_float(gi))); const bool tk = og > gs || (og == gs && oi < gi); gs = tk ? og : gs; gi = tk ? oi : gi; }
      { const float og = dppmov<0x128>(gs); const int oi = __float_as_int(dppmov<0x128>(__int_as_float(gi))); const bool tk = og > gs || (og == gs && oi < gi); gs = tk ? og : gs; gi = tk ? oi : gi; }
      const int best = __builtin_amdgcn_readfirstlane(gi);
      float x4[4], c4[4];
#pragma unroll
      for (int q = 0; q < 4; ++q) { x4[q] = __int_as_float(__builtin_amdgcn_readlane(__float_as_int(selv), best * 4 + q)); c4[q] = __int_as_float(__builtin_amdgcn_readlane(__float_as_int(scv), best * 4 + q)); }
      i0 = 0; i1 = 0; float w0 = -1e30f, w1 = -1e30f; s0 = 0.f; s1 = 0.f;
#pragma unroll
      for (int q = 0; q < 4; ++q) { const float x = x4[q]; const int eidx = best * 4 + q;
        if (x > w0) { w1 = w0; i1 = i0; s1 = s0; w0 = x; i0 = eidx; s0 = c4[q]; } else if (x > w1) { w1 = x; i1 = eidx; s1 = c4[q]; } } }
    if (lane == 0) {
      const float sum = s0 + s1;
      if (DRY) { asm volatile("" :: "v"(sum), "v"(i0), "v"(i1)); rec[tl * 4] = -1; }
      else { rec[tl * 4] = i0; rec[tl * 4 + 1] = i1; rec[tl * 4 + 2] = atomicAdd(lcnt + i0, 1); rec[tl * 4 + 3] = atomicAdd(lcnt + i1, 1);
        f.tok_e[t * 2] = i0; f.tok_e[t * 2 + 1] = i1; f.tok_w[t * 2] = s0 / sum; f.tok_w[t * 2 + 1] = s1 / sum; }
    }
  }
  __syncthreads();
  if (tid < 16) lbase[tid] = (!DRY && lcnt[tid] > 0) ? atomicAdd(f.cnt + tid, lcnt[tid]) : 0;
  __syncthreads();
  if (tid < 68 && rec[tid * 4] >= 0) { const int t = tb + tid, e0 = rec[tid * 4], e1 = rec[tid * 4 + 1]; const int p0 = lbase[e0] + rec[tid * 4 + 2], p1 = lbase[e1] + rec[tid * 4 + 3];
    f.list[(size_t)e0 * FT + p0] = t; f.list[(size_t)e1 * FT + p1] = t; f.tok_pos[t * 2] = p0; f.tok_pos[t * 2 + 1] = p1; }
}
struct ARowGather { const bf16_t* base; const int* lst; int n; __device__ const bf16_t* operator()(int m) const { const int mm = m < n ? m : n - 1; return base + (size_t)lst[mm] * FD; } };
struct ARowAct { const bf16_t* base; int n; __device__ const bf16_t* operator()(int m) const { const int mm = m < n ? m : n - 1; return base + (size_t)mm * 512; } };
struct EpiGU { bf16_t* act; int n;
  __device__ void operator()(const f32x4 (&acc)[4][4], int mb, int nb, int lane) const {
    const int fr = lane & 15, fg = lane >> 4; const int jg = nb >> 6;
#pragma unroll
    for (int mt = 0; mt < 4; ++mt) { const int m = mb + mt * 16 + fr; if (m < n) {
#pragma unroll
      for (int nt = 0; nt < 2; ++nt) { const f32x4 g = acc[mt][nt], u = acc[mt][nt + 2]; u32x2 o; o.x = pk2(fsilu(g.x) * u.x, fsilu(g.y) * u.y); o.y = pk2(fsilu(g.z) * u.z, fsilu(g.w) * u.w);
        *(u32x2*)(act + (size_t)m * 512 + jg * 32 + nt * 16 + fg * 4) = o; } } }
  } };
struct EpiDown { bf16_t* y; int n;
  __device__ void operator()(const f32x4 (&acc)[4][4], int mb, int nb, int lane) const {
    const int fr = lane & 15, fg = lane >> 4;
#pragma unroll
    for (int mt = 0; mt < 4; ++mt) { const int m = mb + mt * 16 + fr; if (m < n) {
#pragma unroll
      for (int nt = 0; nt < 4; ++nt) { const f32x4 a = acc[mt][nt]; u32x2 o; o.x = pk2(a.x, a.y); o.y = pk2(a.z, a.w); *(u32x2*)(y + (size_t)m * FD + nb + nt * 16 + fg * 4) = o; } } }
  } };
template <int WHICH>
__device__ __forceinline__ void ph_moe_gemm(const FP& f, char* lds) {
  int tbase = 0, offe = 0;
#pragma unroll 1
  for (int e = 0; e < 16; ++e) {
    const int n = f.cnt[e]; const int ntm = (n + 255) >> 8, ntile = ntm * 8;
    int first = (int)blockIdx.x - (tbase % (int)gridDim.x); if (first < 0) first += gridDim.x;
    for (int q = first; q < ntile; q += gridDim.x) {
      const int tm = q >> 3, tn = q & 7;
      if (WHICH == 0) { ARowGather ar{f.hb, f.list + (size_t)e * FT, n}; EpiGU ep{f.act + (size_t)offe * 512, n}; gemm_tile<4, 2>(ar, f.moe_gu + (size_t)e * FD * FD, FD, FD, tm * 256, tn * 128, lds, ep); }
      else { ARowAct ar{f.act + (size_t)offe * 512, n}; EpiDown ep{f.ymoe + (size_t)offe * FD, n}; gemm_tile<4, 2>(ar, f.moe_d + (size_t)e * FD * 512, 512, 512, tm * 256, tn * 128, lds, ep); }
    }
    tbase += ntile; offe += n;
  }
}
__device__ __forceinline__ void ph_moe_combine(const FP& f, int layer) {
  const int lane = TIDX & 63, gw = blockIdx.x * (NT / 64) + (TIDX >> 6), ngw = gridDim.x * (NT / 64);
  int off[17]; off[0] = 0;
#pragma unroll
  for (int e = 0; e < 16; ++e) off[e + 1] = off[e] + f.cnt[e];
  for (int t = gw; t < FT; t += ngw) {
    const int b = t / FS, s = t - b * FS; if (layer == 1 && s < FLC) continue;
    const int e0 = f.tok_e[t * 2], e1 = f.tok_e[t * 2 + 1]; int o0 = 0, o1 = 0;
#pragma unroll
    for (int e = 0; e < 16; ++e) { o0 = e == e0 ? off[e] : o0; o1 = e == e1 ? off[e] : o1; }
    const bf16_t* y0 = f.ymoe + (size_t)(o0 + f.tok_pos[t * 2]) * FD; const bf16_t* y1 = f.ymoe + (size_t)(o1 + f.tok_pos[t * 2 + 1]) * FD;
    const float w0 = f.tok_w[t * 2], w1 = f.tok_w[t * 2 + 1]; float* xr = f_xs_row(f, t); const float* md = f_modrow(f, layer, t) + 5 * FD;
#pragma unroll
    for (int j = 0; j < 4; ++j) { const int c = j * 256 + lane * 4; const u32x2 a = *(const u32x2*)(y0 + c), bq = *(const u32x2*)(y1 + c); f32x4 x = *(f32x4*)(xr + c); const f32x4 g = *(const f32x4*)(md + c);
      x.x += g.x * (w0 * bflo(a.x) + w1 * bflo(bq.x)); x.y += g.y * (w0 * bfhi(a.x) + w1 * bfhi(bq.x)); x.z += g.z * (w0 * bflo(a.y) + w1 * bflo(bq.y)); x.w += g.w * (w0 * bfhi(a.y) + w1 * bfhi(bq.y));
      *(f32x4*)(xr + c) = x; }
  }
}
namespace g8 {
#define G8_LAS __attribute__((address_space(3)))
constexpr int BM = 256, BK = 64, HALF = 128, HTB = HALF * BK * 2, STAGE_BYTES = 8 * HTB;
__host__ __device__ __forceinline__ int lds_byte(int r, int c) { const int st = (r >> 4) * 2 + (c >> 5), rr = r & 15, cc = c & 31, ob = rr * 64 + cc * 2; return st * 1024 + (ob ^ (((ob >> 9) & 1) << 5)); }
__host__ __device__ __forceinline__ void stage_rc(int b, int& R, int& C) { const int st = b / 1024, sb = b % 1024, swz = sb ^ (((sb >> 9) & 1) << 5); R = (st >> 1) * 16 + swz / 64; C = (st & 1) * 32 + (swz % 64) / 2; }
struct Unit { int pm, pn, e, nrows, roff; };
template <class Epi, class Sched>
__device__ __forceinline__ void gemm_phase(G8_LAS unsigned char* lds, const int K, const Sched& S, const Epi& E) {
  const int tid = TIDX, wid = __builtin_amdgcn_readfirstlane(tid >> 6), lane = tid & 63, wr = wid >> 2, wc = wid & 3, fr = lane & 15, fq = lane >> 4;
  const int nt = K / BK;
  unsigned voffB[2];
#pragma unroll
  for (int i = 0; i < 2; ++i) { int R_, C_; stage_rc(tid * 16 + i * 8192, R_, C_); voffB[i] = (unsigned)(R_ * K + C_) * 2u; }
#define G8_AOFF(dst, U) _Pragma("unroll") for (int h = 0; h < 2; ++h) _Pragma("unroll") for (int i = 0; i < 2; ++i) { int R_, C_; stage_rc(tid * 16 + i * 8192, R_, C_); dst[h][i] = S.a_off(U, h * HALF + R_) + (unsigned)C_ * 2u; }
  const size_t kstep = (size_t)(BK * 2); const size_t hstepB = (size_t)HALF * K * 2;
  const unsigned ldsw = (unsigned)wid * 1024u;
  const int aoff = lds_byte(wr * 64 + fr, fq * 8), boff = lds_byte(wc * 32 + fr, fq * 8);
#define G8_SA(b, h) (((b) * 2 + (h)) * HTB)
#define G8_SB(b, h) ((4 + (b) * 2 + (h)) * HTB)
#define G8_STAGEB(bufoff, gbase) do { _Pragma("unroll") for (int _i = 0; _i < 2; ++_i) \
    __builtin_amdgcn_global_load_lds((const unsigned*)((const char*)(gbase) + voffB[_i]), (G8_LAS unsigned*)(lds + (bufoff) + ldsw + _i * 8192), 16, 0, 0); } while (0)
#define G8_STAGEA(bufoff, offs, kb) do { _Pragma("unroll") for (int _i = 0; _i < 2; ++_i) \
    __builtin_amdgcn_global_load_lds((const unsigned*)(abase + (size_t)(offs)[_i] + (kb)), (G8_LAS unsigned*)(lds + (bufoff) + ldsw + _i * 8192), 16, 0, 0); } while (0)
#define G8_LDA(dst, b, h) do { _Pragma("unroll") for (int m = 0; m < 4; ++m) _Pragma("unroll") for (int k = 0; k < 2; ++k) dst[m][k] = *(const G8_LAS bf16x8*)(lds + G8_SA(b, h) + aoff + m * 2048 + k * 1024); } while (0)
#define G8_LDB(dst, b, h) do { _Pragma("unroll") for (int n = 0; n < 2; ++n) _Pragma("unroll") for (int k = 0; k < 2; ++k) dst[n][k] = *(const G8_LAS bf16x8*)(lds + G8_SB(b, h) + boff + n * 2048 + k * 1024); } while (0)
#define G8_MMA(ai, bj, At, Bt) do { __builtin_amdgcn_s_setprio(1); _Pragma("unroll") for (int m = 0; m < 4; ++m) _Pragma("unroll") for (int n = 0; n < 2; ++n) _Pragma("unroll") for (int k = 0; k < 2; ++k) \
    acc[ai][bj][m][n] = __builtin_amdgcn_mfma_f32_16x16x32_bf16(Bt[n][k], At[m][k], acc[ai][bj][m][n], 0, 0, 0); __builtin_amdgcn_s_setprio(0); } while (0)
#define G8_WAIT_V(n) asm volatile("s_waitcnt vmcnt(" #n ")" ::: "memory")
#define G8_WAIT_L(n) asm volatile("s_waitcnt lgkmcnt(" #n ")" ::: "memory")
#define G8_BAR __builtin_amdgcn_s_barrier()
#define G8_SCHED __builtin_amdgcn_sched_barrier(0)
  Unit cur, nxt; int ui = 0;
  if (!S.next(0, cur)) return;
  f32x4 acc[2][2][4][2];
#pragma unroll
  for (int a = 0; a < 2; ++a)
#pragma unroll
    for (int b = 0; b < 2; ++b)
#pragma unroll
      for (int m = 0; m < 4; ++m)
#pragma unroll
        for (int n = 0; n < 2; ++n) acc[a][b][m][n] = (f32x4){0.f, 0.f, 0.f, 0.f};
  bf16x8 At[4][2], B0[2][2], B1[2][2];
  const char* abase = S.a_base();
  unsigned ca[2][2], na[2][2];
  G8_AOFF(ca, cur)
  const char* cB = S.b_rows(cur);
  G8_STAGEB(G8_SB(0, 0), cB); G8_STAGEA(G8_SA(0, 0), ca[0], 0); G8_STAGEB(G8_SB(0, 1), cB + hstepB); G8_STAGEA(G8_SA(0, 1), ca[1], 0);
  if (wr == 1) G8_BAR;
  G8_WAIT_V(4); G8_BAR;
  G8_STAGEB(G8_SB(1, 0), cB + kstep); G8_STAGEA(G8_SA(1, 0), ca[0], kstep); G8_STAGEB(G8_SB(1, 1), cB + hstepB + kstep);
  G8_WAIT_V(6); G8_BAR;
  for (;;) {
    const bool has_next = S.next(ui + 1, nxt);
    const char* nB = has_next ? S.b_rows(nxt) : cB;
    if (!Sched::LAZY_NEXT) { if (has_next) { G8_AOFF(na, nxt) } else {
#pragma unroll
      for (int h = 0; h < 2; ++h)
#pragma unroll
        for (int i = 0; i < 2; ++i) na[h][i] = ca[h][i]; } }
    for (int t = 0; t < nt; t += 2) {
      const bool last = (t == nt - 2);
      const size_t k1 = (size_t)(t + 1) * kstep;
      const size_t k2 = last ? 0 : (size_t)(t + 2) * kstep; const size_t k3 = k2 + kstep;
      const char* b2 = last ? nB : cB + (size_t)(t + 2) * kstep; const char* b3 = b2 + kstep;
      G8_LDB(B0, 0, 0); G8_SCHED; G8_LDA(At, 0, 0); G8_STAGEA(G8_SA(1, 1), ca[1], k1);
      if (last) {
        if (Sched::LAZY_NEXT) { if (has_next) { G8_AOFF(ca, nxt) } }
        else {
#pragma unroll
          for (int h = 0; h < 2; ++h)
#pragma unroll
            for (int i = 0; i < 2; ++i) ca[h][i] = na[h][i]; } }
      G8_WAIT_L(8); G8_BAR; G8_WAIT_L(0); G8_MMA(0, 0, At, B0); G8_BAR; G8_SCHED;
      G8_LDB(B1, 0, 1); G8_STAGEB(G8_SB(0, 0), b2);
      G8_BAR; G8_WAIT_L(0); G8_MMA(0, 1, At, B1); G8_BAR;
      G8_LDA(At, 0, 1); G8_STAGEA(G8_SA(0, 0), ca[0], k2);
      G8_BAR; G8_WAIT_L(0); G8_MMA(1, 0, At, B0); G8_BAR; G8_SCHED;
      G8_STAGEB(G8_SB(0, 1), b2 + hstepB);
      G8_WAIT_V(6); G8_BAR; G8_MMA(1, 1, At, B1); G8_BAR;
      G8_LDB(B0, 1, 0); G8_SCHED; G8_LDA(At, 1, 0); G8_STAGEA(G8_SA(0, 1), ca[1], k2);
      G8_WAIT_L(8); G8_BAR; G8_WAIT_L(0); G8_MMA(0, 0, At, B0); G8_BAR; G8_SCHED;
      G8_LDB(B1, 1, 1); G8_STAGEB(G8_SB(1, 0), b3);
      G8_BAR; G8_WAIT_L(0); G8_MMA(0, 1, At, B1); G8_BAR;
      G8_LDA(At, 1, 1); G8_STAGEA(G8_SA(1, 0), ca[0], k3);
      G8_BAR; G8_WAIT_L(0); G8_MMA(1, 0, At, B0); G8_BAR; G8_SCHED;
      G8_STAGEB(G8_SB(1, 1), b3 + hstepB);
      G8_WAIT_V(6); G8_BAR; G8_MMA(1, 1, At, B1); G8_BAR;
    }
    E(acc, cur, wr, wc, fr, fq);
    if (!has_next) break;
#pragma unroll
    for (int a = 0; a < 2; ++a)
#pragma unroll
      for (int b = 0; b < 2; ++b)
#pragma unroll
        for (int m = 0; m < 4; ++m)
#pragma unroll
          for (int n = 0; n < 2; ++n) acc[a][b][m][n] = (f32x4){0.f, 0.f, 0.f, 0.f};
    cur = nxt; cB = nB; ++ui;
  }
  G8_WAIT_V(0);
  if (wr == 0) G8_BAR;
  G8_BAR;
#undef G8_AOFF
#undef G8_SA
#undef G8_SB
#undef G8_STAGEA
#undef G8_STAGEB
#undef G8_LDA
#undef G8_LDB
#undef G8_MMA
#undef G8_WAIT_V
#undef G8_WAIT_L
#undef G8_BAR
#undef G8_SCHED
}
struct SchedDense { static constexpr bool LAZY_NEXT = true; const char* A; const char* Bt; int K, nM, nN, G, c; int m_skip_mod;
  __device__ bool next(int i, Unit& u) const { const long L = (long)i * G + c; const int total = nM * nN; if (L >= total) return false;
    const int grp = 8 * nN; const int g = (int)L / grp, r = (int)L % grp; const int gsz = (nM - g * 8) < 8 ? (nM - g * 8) : 8; int pm = g * 8 + r % gsz; const int pn = r / gsz;
    if (m_skip_mod > 0) pm = pm + pm / (m_skip_mod - 1) + 1;
    u.pm = pm; u.pn = pn; u.e = 0; u.nrows = 1 << 30; u.roff = 0; return true; }
  __device__ const char* a_base() const { return A; }
  __device__ unsigned a_off(const Unit& u, int row) const { return (unsigned)((size_t)(u.pm * 256 + row) * K * 2); }
  __device__ const char* b_rows(const Unit& u) const { return Bt + (size_t)u.pn * 256 * K * 2; }
};
}
namespace g8 {
template <int WHICH> struct SchedMoE { static constexpr bool LAZY_NEXT = (WHICH == 1); const FP* f; int G, c; const LAS int* lcnt;
  __device__ bool next(int i, Unit& u) const { int L = i * G + c; int roff = 0; bool found = false;
    u.pm = 0; u.pn = 0; u.e = 0; u.nrows = 1; u.roff = 0;
    const LAS u32x4* lc4 = (const LAS u32x4*)lcnt; const u32x4 c0 = lc4[0], c1 = lc4[1], c2 = lc4[2], c3 = lc4[3];
    const unsigned cn[16] = {c0.x, c0.y, c0.z, c0.w, c1.x, c1.y, c1.z, c1.w, c2.x, c2.y, c2.z, c2.w, c3.x, c3.y, c3.z, c3.w};
#pragma unroll
    for (int e = 0; e < 16; ++e) { const int n = __builtin_amdgcn_readfirstlane((int)cn[e]); const int nu = ((n + 255) >> 8) * 4; const bool hit = !found && L < nu;
      if (hit) { u.pm = L >> 2; u.pn = L & 3; u.e = e; u.nrows = n; u.roff = roff; found = true; }
      if (!found) { L -= nu; roff += n; } }
    return found; }
  __device__ const char* a_base() const { return WHICH == 0 ? (const char*)f->hb : (const char*)f->act; }
  __device__ unsigned a_off(const Unit& u, int row) const { int m = u.pm * 256 + row; m = m < u.nrows ? m : u.nrows - 1;
    if (WHICH == 0) return (unsigned)f->list[(size_t)u.e * FT + m] * (unsigned)(FD * 2); else return (unsigned)(u.roff + m) * 1024u; }
  __device__ const char* b_rows(const Unit& u) const { return WHICH == 0 ? (const char*)(f->moe_gu + (size_t)u.e * FD * FD + (size_t)u.pn * 256 * FD) : (const char*)(f->moe_d + (size_t)u.e * FD * 512 + (size_t)u.pn * 256 * 512); }
};
#define G8_ROWS_BEGIN _Pragma("unroll") for (int ai = 0; ai < 2; ++ai) _Pragma("unroll") for (int m = 0; m < 4; ++m) { const int rl = ai * 128 + wr * 64 + m * 16 + fr;
#define G8_ROWS_END }
struct EpiIn0 { const FP* f;
  __device__ void operator()(const f32x4 (&acc)[2][2][4][2], const Unit& u, int wr, int wc, int fr, int fq) const {
#pragma unroll
    for (int bj = 0; bj < 2; ++bj) { const int cb = u.pn * 256 + bj * 128 + wc * 32; if (cb >= Z0_N) continue;
      const float sc = cb < Z0_GK ? 0.17677669529663687f : 1.f; const bool isv = cb >= Z0_AV && cb < Z0_GDEC;
      G8_ROWS_BEGIN { const int row = u.pm * 256 + rl;
        if (isv) { const int b = row / FS, s = row - b * FS; const int kvh = (cb - Z0_AV) >> 6, j0 = ((cb - Z0_AV) & 63) + 4 * fq;
#pragma unroll
          for (int n = 0; n < 2; ++n)
#pragma unroll
            for (int i = 0; i < 4; ++i) f->vT[((size_t)(b * 2 + kvh) * 64 + j0 + n * 16 + i) * FS + s] = f2bf(acc[ai][bj][m][n][i]);
        } else { bf16_t* zr = f->zf + (size_t)row * Z0_LD + cb + 4 * fq;
#pragma unroll
          for (int n = 0; n < 2; ++n) { const f32x4 a = acc[ai][bj][m][n] * sc; u32x2 o; o.x = pk2(a.x, a.y); o.y = pk2(a.z, a.w); *(u32x2*)(zr + n * 16) = o; } } } G8_ROWS_END
    } } };
struct EpiPlain { bf16_t* z; int ld, ncols;
  __device__ void operator()(const f32x4 (&acc)[2][2][4][2], const Unit& u, int wr, int wc, int fr, int fq) const {
#pragma unroll
    for (int bj = 0; bj < 2; ++bj) { const int cb = u.pn * 256 + bj * 128 + wc * 32; if (cb >= ncols) continue;
      G8_ROWS_BEGIN { bf16_t* zr = z + (size_t)(u.pm * 256 + rl) * ld + cb + 4 * fq;
#pragma unroll
        for (int n = 0; n < 2; ++n) { const f32x4 a = acc[ai][bj][m][n]; u32x2 o; o.x = pk2(a.x, a.y); o.y = pk2(a.z, a.w); *(u32x2*)(zr + n * 16) = o; } } G8_ROWS_END
    } } };
template <int LAYER> struct EpiOutProj { const FP* f;
  __device__ void operator()(const f32x4 (&acc)[2][2][4][2], const Unit& u, int wr, int wc, int fr, int fq) const {
    G8_ROWS_BEGIN { const int row = u.pm * 256 + rl; float* xo = f_xs_row(*f, row); const float* xi = LAYER == 0 ? f_xin_row(*f, row) : xo; const float* md = f_modrow(*f, LAYER, row) + 2 * FD;
#pragma unroll
      for (int bj = 0; bj < 2; ++bj)
#pragma unroll
        for (int n = 0; n < 2; ++n) { const int c = u.pn * 256 + bj * 128 + wc * 32 + n * 16 + 4 * fq; const f32x4 x = *(const f32x4*)(xi + c), g = *(const f32x4*)(md + c); *(f32x4*)(xo + c) = x + g * acc[ai][bj][m][n]; } } G8_ROWS_END
  } };
struct EpiGU { const FP* f;
  __device__ void operator()(const f32x4 (&acc)[2][2][4][2], const Unit& u, int wr, int wc, int fr, int fq) const {
    G8_ROWS_BEGIN { const int mrow = u.pm * 256 + rl; if (mrow < u.nrows) { bf16_t* ar = f->act + (size_t)(u.roff + mrow) * 512;
#pragma unroll
      for (int bj = 0; bj < 2; ++bj) { const f32x4 g = acc[ai][bj][m][0], up = acc[ai][bj][m][1]; u32x2 o; o.x = pk2(fsilu(g.x) * up.x, fsilu(g.y) * up.y); o.y = pk2(fsilu(g.z) * up.z, fsilu(g.w) * up.w);
        *(u32x2*)(ar + ((u.pn * 256 + bj * 128 + wc * 32) >> 1) + 4 * fq) = o; } } } G8_ROWS_END
  } };
struct EpiDown { const FP* f;
  __device__ void operator()(const f32x4 (&acc)[2][2][4][2], const Unit& u, int wr, int wc, int fr, int fq) const {
    G8_ROWS_BEGIN { const int mrow = u.pm * 256 + rl; if (mrow < u.nrows) { bf16_t* yr = f->ymoe + (size_t)(u.roff + mrow) * FD;
#pragma unroll
      for (int bj = 0; bj < 2; ++bj)
#pragma unroll
        for (int n = 0; n < 2; ++n) { const f32x4 a = acc[ai][bj][m][n]; u32x2 o; o.x = pk2(a.x, a.y); o.y = pk2(a.z, a.w); *(u32x2*)(yr + u.pn * 256 + bj * 128 + wc * 32 + n * 16 + 4 * fq) = o; } } } G8_ROWS_END
  } };
__device__ __forceinline__ const LAS int* moe_cache_counts(const FP& f, char* lds) { LAS int* lc = (LAS int*)(lds + STAGE_BYTES); __syncthreads();
  if (TIDX < 16) lc[TIDX] = __hip_atomic_load(f.cnt + TIDX, __ATOMIC_RELAXED, __HIP_MEMORY_SCOPE_AGENT);
  __syncthreads(); return lc; }
}
struct RowMapGate8 { __device__ int operator()(int j) const { return (j >> 4) * 32 + (j & 15); } };
struct RowMapUp8 { __device__ int operator()(int j) const { return (j >> 4) * 32 + 16 + (j & 15); } };
constexpr float QK_SCALE_LOG2E = 0.125f * 1.4426950408889634f;
struct EpiIn0 { const FP* f;
  __device__ void operator()(f32x4 (&acc)[4][4], int mb, int nb, int lane) const {
    const int fr = lane & 15, fg = lane >> 4; const FP& F = *f;
    if (nb >= Z0_AQ && nb < Z0_AV) {
      const bool isq = nb < Z0_AK; const float* gn = isq ? F.p.att_q_norm : F.p.att_k_norm; const float osc = isq ? QK_SCALE_LOG2E : 1.f;
      f32x4 g[4];
#pragma unroll
      for (int nt = 0; nt < 4; ++nt) g[nt] = *(const f32x4*)(gn + nt * 16 + fg * 4);
      float inv[4];
#pragma unroll
      for (int r = 0; r < 4; ++r) inv[r] = exp2f(-(float)(fg * 4 + r) * 0.8304820237218406f);
#pragma unroll
      for (int mt = 0; mt < 4; ++mt) {
        const int m = mb + mt * 16 + fr; const int b = m / FS, s = m - b * FS;
        float ss = 0.f;
#pragma unroll
        for (int nt = 0; nt < 4; ++nt) ss += acc[mt][nt].x * acc[mt][nt].x + acc[mt][nt].y * acc[mt][nt].y + acc[mt][nt].z * acc[mt][nt].z + acc[mt][nt].w * acc[mt][nt].w;
        ss += __shfl_xor(ss, 16); ss += __shfl_xor(ss, 32);
        const float ri = __builtin_amdgcn_rsqf(ss * (1.f / 64.f) + 1e-6f);
#pragma unroll
        for (int nt = 0; nt < 4; ++nt) acc[mt][nt] = acc[mt][nt] * ri * g[nt];
        if (s >= FLC) {
          const int pos = s - FLC; const float prow = (float)(pos >> 6), pcol = (float)(pos & 63);
#pragma unroll
          for (int r = 0; r < 4; ++r) {
            float a = prow * inv[r], cs = __cosf(a), sn = __sinf(a); float t1 = acc[mt][0][r], t2 = acc[mt][2][r]; acc[mt][0][r] = t1 * cs - t2 * sn; acc[mt][2][r] = t1 * sn + t2 * cs;
            a = pcol * inv[r]; cs = __cosf(a); sn = __sinf(a); t1 = acc[mt][1][r]; t2 = acc[mt][3][r]; acc[mt][1][r] = t1 * cs - t2 * sn; acc[mt][3][r] = t1 * sn + t2 * cs;
          }
        }
#pragma unroll
        for (int nt = 0; nt < 4; ++nt) acc[mt][nt] = acc[mt][nt] * osc;
      }
    } else if (nb < Z0_GK) {
#pragma unroll
      for (int mt = 0; mt < 4; ++mt)
#pragma unroll
        for (int nt = 0; nt < 4; ++nt) acc[mt][nt] = acc[mt][nt] * 0.17677669529663687f;
    }
    if (nb >= Z0_AV && nb < Z0_GDEC) {
      const int kvh = (nb - Z0_AV) >> 6;
#pragma unroll
      for (int mt = 0; mt < 4; ++mt) { const int m = mb + mt * 16 + fr; const int b = m / FS, s = m - b * FS;
#pragma unroll
        for (int nt = 0; nt < 4; ++nt)
#pragma unroll
          for (int r = 0; r < 4; ++r) F.vT[((size_t)(b * 2 + kvh) * 64 + nt * 16 + fg * 4 + r) * FS + s] = f2bf(acc[mt][nt][r]); }
      return;
    }
#pragma unroll
    for (int mt = 0; mt < 4; ++mt) { bf16_t* zr = F.zf + (size_t)(mb + mt * 16 + fr) * Z0_LD + nb + fg * 4;
#pragma unroll
      for (int nt = 0; nt < 4; ++nt) { u32x2 o; o.x = pk2(acc[mt][nt].x, acc[mt][nt].y); o.y = pk2(acc[mt][nt].z, acc[mt][nt].w); *(u32x2*)(zr + nt * 16) = o; } }
  } };
__device__ __forceinline__ void ph_inproj0(const FP& f, const bf16_t* wt, int tm0, int tm1, char* lds) {
  ARowPlain ar{f.hb, FD}; EpiIn0 ep{&f}; const int ntn = Z0_LD / 128, ntiles = (tm1 - tm0) * ntn;
  for (int t = blockIdx.x; t < ntiles; t += gridDim.x) { const int tm = tm0 + t / ntn, tn = t % ntn; gemm_tile<4, 2>(ar, wt, FD, FD, tm * 256, tn * 128, lds, ep); }
}

__device__ __forceinline__ void store4(float* p, f32x4 v) { *(f32x4*)p = v; }
__device__ __forceinline__ void store4(bf16_t* p, f32x4 v) { u32x2 o; o.x = pk2(v.x, v.y); o.y = pk2(v.z, v.w); *(u32x2*)p = o; }
constexpr int ATT_LDS = 2 * 16384;
__device__ __forceinline__ void qk_fix_q(const FP& f, bf16x8& x0, bf16x8& x1, int fg, bool lat, int pos) {
  const u32x4 u0 = __builtin_bit_cast(u32x4, x0), u1 = __builtin_bit_cast(u32x4, x1); float a[8], c[8];
  a[0] = bflo(u0.x); a[1] = bfhi(u0.x); a[2] = bflo(u0.y); a[3] = bfhi(u0.y); a[4] = bflo(u0.z); a[5] = bfhi(u0.z); a[6] = bflo(u0.w); a[7] = bfhi(u0.w);
  c[0] = bflo(u1.x); c[1] = bfhi(u1.x); c[2] = bflo(u1.y); c[3] = bfhi(u1.y); c[4] = bflo(u1.z); c[5] = bfhi(u1.z); c[6] = bflo(u1.w); c[7] = bfhi(u1.w);
  float ss = 0.f;
#pragma unroll
  for (int j = 0; j < 8; ++j) ss += a[j] * a[j] + c[j] * c[j];
  ss += __shfl_xor(ss, 16); ss += __shfl_xor(ss, 32);
  const float ri = __builtin_amdgcn_rsqf(ss * (1.f / 64.f) + 1e-6f);
  const float p = (fg < 2) ? (float)(pos >> 6) : (float)(pos & 63);
#pragma unroll
  for (int j = 0; j < 8; ++j) { const int d = fg * 8 + j; float t1 = a[j] * ri * f.p.att_q_norm[d], t2 = c[j] * ri * f.p.att_q_norm[32 + d];
    if (lat) { const float ang = p * exp2f(-(float)(d & 15) * 0.8304820237218406f), cs = __cosf(ang), sn = __sinf(ang); const float r1 = t1 * cs - t2 * sn, r2 = t1 * sn + t2 * cs; t1 = r1; t2 = r2; }
    a[j] = t1 * QK_SCALE_LOG2E; c[j] = t2 * QK_SCALE_LOG2E; }
  x0 = pack8(a); x1 = pack8(c);
}
__device__ __forceinline__ void qk_fix_k(const FP& f, u32x4& rk, int lkc, bool lat, int pos) {
  float a[8]; a[0] = bflo(rk.x); a[1] = bfhi(rk.x); a[2] = bflo(rk.y); a[3] = bfhi(rk.y); a[4] = bflo(rk.z); a[5] = bfhi(rk.z); a[6] = bflo(rk.w); a[7] = bfhi(rk.w);
  float ss = 0.f;
#pragma unroll
  for (int j = 0; j < 8; ++j) ss += a[j] * a[j];
  ss += __shfl_xor(ss, 1); ss += __shfl_xor(ss, 2); ss += __shfl_xor(ss, 4);
  const float ri = __builtin_amdgcn_rsqf(ss * (1.f / 64.f) + 1e-6f);
#pragma unroll
  for (int j = 0; j < 8; ++j) a[j] = a[j] * ri * f.p.att_k_norm[lkc * 8 + j];
  if (lat) { const float p = ((lkc & 3) < 2) ? (float)(pos >> 6) : (float)(pos & 63);
#pragma unroll
    for (int j = 0; j < 8; ++j) { const float other = __shfl_xor(a[j], 4); const int d = (lkc & 3) * 8 + j; const float ang = p * exp2f(-(float)(d & 15) * 0.8304820237218406f), cs = __cosf(ang), sn = __sinf(ang);
      a[j] = lkc < 4 ? a[j] * cs - other * sn : other * sn + a[j] * cs; } }
  rk.x = pk2(a[0], a[1]); rk.y = pk2(a[2], a[3]); rk.z = pk2(a[4], a[5]); rk.w = pk2(a[6], a[7]);
}
template <class OutT, bool RAWQK = false>
__device__ __forceinline__ void ph_attn(const FP& f, int b_lo, int b_hi, OutT* cat, int ldc, char* lds, bool rev = false, int blk0 = 0, int nblk = 0) {
  const int tid = TIDX, lane = tid & 63, w = tid >> 6, fr = lane & 15, fg = lane >> 4;
  const int nb_ = b_hi - b_lo; const int n_lat = nb_ * 64 * 2, n_items = n_lat + nb_ * 4 * 2;
  const int lrow = tid >> 3, lkc = tid & 7;
  const int nb_eff = nblk ? nblk : (int)gridDim.x; const int myb = (int)blockIdx.x - blk0; if (myb < 0 || myb >= nb_eff) return;
  for (int item = rev ? nb_eff - 1 - myb : myb; item < n_items; item += nb_eff) {
    int b, kvh, q0; bool is_ctx = false;
    if (item < n_lat) { b = b_lo + item / 128; const int r = item % 128; q0 = (r >> 1) * 64; kvh = r & 1; } else { const int r = item - n_lat; is_ctx = true; b = b_lo + r / 8; q0 = ((r % 8) >> 1) * 64; kvh = r & 1; }
    const int hq = kvh * 4 + (w & 3); const int qw = q0 + 32 * (w >> 2); const int tq0 = b * FS + (is_ctx ? 0 : FLC) + qw;
    bf16x8 qf[2][2];
#pragma unroll
    for (int qt = 0; qt < 2; ++qt)
#pragma unroll
      for (int kh = 0; kh < 2; ++kh) qf[qt][kh] = *(const bf16x8*)(f.zf + (size_t)(tq0 + qt * 16 + fr) * Z0_LD + Z0_AQ + hq * 64 + kh * 32 + fg * 8);
    if (RAWQK) {
#pragma unroll
      for (int qt = 0; qt < 2; ++qt) qk_fix_q(f, qf[qt][0], qf[qt][1], fg, !is_ctx, qw + qt * 16 + fr);
    }
    f32x4 ot[4][2];
#pragma unroll
    for (int i = 0; i < 4; ++i)
#pragma unroll
      for (int j = 0; j < 2; ++j) ot[i][j] = (f32x4){0.f, 0.f, 0.f, 0.f};
    const float sinkl = f.p.att_sink[hq] * 1.4426950408889634f;
    float mrow[2], lsum[2];
#pragma unroll
    for (int qt = 0; qt < 2; ++qt) { mrow[qt] = sinkl; lsum[qt] = fg == 0 ? 1.f : 0.f; }
    u32x4 rk, rv;
    auto tile_valid = [&](int i) -> bool { if (i >= 5) return true; if (is_ctx) return false; const int k0 = q0 - 128 + 64 * i; return k0 >= 0 && k0 < FL; };
    auto tile_tok0 = [&](int i) -> int { return i >= 5 ? 64 * (i - 5) : FLC + q0 - 128 + 64 * i; };
    auto issue = [&](int i) { const int s0 = tile_tok0(i);
      rk = *(const u32x4*)(f.zf + (size_t)(b * FS + s0 + lrow) * Z0_LD + Z0_AK + kvh * 64 + lkc * 8);
      rv = *(const u32x4*)(f.vT + ((size_t)(b * 2 + kvh) * 64 + lrow) * FS + s0 + lkc * 8); };
    auto commit = [&](int buf, int i) { char* kb = lds + buf * 16384; char* vb = kb + 8192;
      if (RAWQK) qk_fix_k(f, rk, lkc, i < 5, tile_tok0(i) - FLC + lrow);
      *(u32x4*)(kb + lrow * 128 + ((lkc ^ (lrow & 7)) << 4)) = rk;
      *(u32x4*)(vb + lrow * 128 + (((2 * lkc) ^ (lrow & 14)) << 3)) = rv; };
    int ifirst = 0; while (!tile_valid(ifirst)) ++ifirst;
    __syncthreads();
    issue(ifirst); commit(0, ifirst);
    __syncthreads();
    int cur = 0;
#pragma unroll 1
    for (int i = ifirst; i < 9; ++i) {
      if (!tile_valid(i)) continue;
      int inext = i + 1; while (inext < 9 && !tile_valid(inext)) ++inext;
      if (inext < 9) issue(inext);
      {
        const char* kb = lds + cur * 16384; const char* vb = kb + 8192;
        f32x4 st[4][2];
#pragma unroll
        for (int a = 0; a < 4; ++a)
#pragma unroll
          for (int c = 0; c < 2; ++c) st[a][c] = (f32x4){0.f, 0.f, 0.f, 0.f};
#pragma unroll
        for (int kh = 0; kh < 2; ++kh) {
          bf16x8 kf[4];
#pragma unroll
          for (int kt = 0; kt < 4; ++kt) { const int row = kt * 16 + fr; kf[kt] = *(const bf16x8*)(kb + row * 128 + (((kh * 4 + fg) ^ (row & 7)) << 4)); }
          __builtin_amdgcn_s_setprio(1);
#pragma unroll
          for (int kt = 0; kt < 4; ++kt)
#pragma unroll
            for (int c = 0; c < 2; ++c) st[kt][c] = __builtin_amdgcn_mfma_f32_16x16x32_bf16(kf[kt], qf[c][kh], st[kt][c], 0, 0, 0);
          __builtin_amdgcn_s_setprio(0);
        }
        if (i == 0 || i == 4) {
          const int k0 = q0 - 128 + 64 * i;
#pragma unroll
          for (int kt = 0; kt < 4; ++kt)
#pragma unroll
            for (int c = 0; c < 2; ++c)
#pragma unroll
              for (int r = 0; r < 4; ++r) { const int dk = (k0 + kt * 16 + fg * 4 + r) - (qw + c * 16 + fr); if (dk > 128 || dk < -128) st[kt][c][r] = -1e30f; }
        }
        bf16x8 pf[2][2];
#pragma unroll
        for (int c = 0; c < 2; ++c) {
          float mx = mrow[c];
#pragma unroll
          for (int kt = 0; kt < 4; ++kt) mx = fmaxf(mx, fmaxf(fmaxf(st[kt][c].x, st[kt][c].y), fmaxf(st[kt][c].z, st[kt][c].w)));
          mx = fmaxf(mx, __shfl_xor(mx, 16)); mx = fmaxf(mx, __shfl_xor(mx, 32));
          const float alpha = __builtin_amdgcn_exp2f(mrow[c] - mx); mrow[c] = mx; float ps = 0.f;
#pragma unroll
          for (int kt = 0; kt < 4; ++kt) { f32x4 p; p.x = __builtin_amdgcn_exp2f(st[kt][c].x - mx); p.y = __builtin_amdgcn_exp2f(st[kt][c].y - mx); p.z = __builtin_amdgcn_exp2f(st[kt][c].z - mx); p.w = __builtin_amdgcn_exp2f(st[kt][c].w - mx); ps += (p.x + p.y) + (p.z + p.w); st[kt][c] = p; }
          lsum[c] = lsum[c] * alpha + ps;
#pragma unroll
          for (int nt = 0; nt < 4; ++nt) ot[nt][c] = ot[nt][c] * alpha;
#pragma unroll
          for (int ks = 0; ks < 2; ++ks) { u32x4 u; u.x = pk2(st[2 * ks][c].x, st[2 * ks][c].y); u.y = pk2(st[2 * ks][c].z, st[2 * ks][c].w); u.z = pk2(st[2 * ks + 1][c].x, st[2 * ks + 1][c].y); u.w = pk2(st[2 * ks + 1][c].z, st[2 * ks + 1][c].w); pf[c][ks] = __builtin_bit_cast(bf16x8, u); }
        }
#pragma unroll
        for (int ks = 0; ks < 2; ++ks) {
          bf16x8 vf[4];
#pragma unroll
          for (int nt = 0; nt < 4; ++nt) { const int row = nt * 16 + fr; const char* rp = vb + row * 128; const int c0 = (8 * ks + fg) ^ (row & 14), c1 = (8 * ks + 4 + fg) ^ (row & 14);
            const u32x2 lo = *(const u32x2*)(rp + (c0 << 3)), hi = *(const u32x2*)(rp + (c1 << 3)); u32x4 u; u.x = lo.x; u.y = lo.y; u.z = hi.x; u.w = hi.y; vf[nt] = __builtin_bit_cast(bf16x8, u); }
          __builtin_amdgcn_s_setprio(1);
#pragma unroll
          for (int nt = 0; nt < 4; ++nt)
#pragma unroll
            for (int c = 0; c < 2; ++c) ot[nt][c] = __builtin_amdgcn_mfma_f32_16x16x32_bf16(vf[nt], pf[c][ks], ot[nt][c], 0, 0, 0);
          __builtin_amdgcn_s_setprio(0);
        }
      }
      if (inext < 9) commit(cur ^ 1, inext);
      __syncthreads();
      cur ^= 1;
    }
#pragma unroll
    for (int c = 0; c < 2; ++c) { float l = lsum[c]; l += __shfl_xor(l, 16); l += __shfl_xor(l, 32); const float il = __builtin_amdgcn_rcpf(l);
      OutT* dst = cat + (size_t)(tq0 + c * 16 + fr) * ldc + 512 + hq * 64 + fg * 4;
#pragma unroll
      for (int nt = 0; nt < 4; ++nt) store4(dst + nt * 16, ot[nt][c] * il); }
  }
}
__device__ __forceinline__ int gswz128(int row, int off) { return row * 128 + (off ^ ((row & 7) << 4)); }
__device__ __forceinline__ int gswz64(int row, int off) { return row * 64 + (off ^ (((row >> 2) & 3) << 4)); }
__device__ __forceinline__ float flogsigm(float x) { return fminf(x, 0.f) - __logf(1.f + __expf(-fabsf(x))); }
constexpr int GLA_A_LDS = 28672 + 256;
constexpr int GA_KBT = 0, GA_VTL = 8192, GA_ZA = 16384, GA_ZK = 20480, GA_WT = 24576, GA_BIAS = 28672;
struct GlaS { u32x4 a, v, w; };
__device__ __forceinline__ void gla_a_stage_load(const FP& f, int b_lo, int item, int tid, GlaS& x) {
  const int b = b_lo + item / (8 * 68), h = (item / 68) % 8, c = item % 68; const int t0 = b * FS + c * 64;
  { const int t = (tid & 255) >> 2, cc = tid & 3; x.a = *(const u32x4*)(f.zf + (size_t)(t0 + t) * Z0_LD + (tid < 256 ? Z0_GDEC : Z0_GK + h * 32) + cc * 8); }
  x.v = *(const u32x4*)(f.zf + (size_t)(t0 + (tid >> 3)) * Z0_LD + Z0_GV + h * 64 + (tid & 7) * 8);
  { const int u = tid & 255, row = u >> 3, cc = u & 7; const bool isb = tid >= 256; const float* src = isb ? f.p.gla_dec_b + ((row & 1) * 256 + h * 32 + cc * 4) : f.p.gla_dec_w + (row * 256 + h * 32 + cc * 4);
    x.w = *(const u32x4*)src; }
}
template <class Dummy = void>
__device__ __forceinline__ void gla_a_item(const FP& f, int b_lo, int item, int nload, int tid0, GlaS& st, char* lds) {
  char* kbt = lds + GA_KBT; char* vtl = lds + GA_VTL;
  int tid = tid0; asm volatile("" : "+v"(tid)); const int lane = tid & 63, w = tid >> 6, fr = lane & 15, fg = lane >> 4;
  const int b = b_lo + item / (8 * 68), h = (item / 68) % 8, c = item % 68; const int t0 = b * FS + c * 64;
  __syncthreads();
  { const int t = (tid & 255) >> 2, cc = tid & 3; *(u32x4*)(lds + GA_ZA + (tid >> 8) * 4096 + ((t & 7) * 8 + (t >> 3)) * 64 + cc * 16) = st.a; }
  if (tid < 272) { const int u = tid & 255; *(u32x4*)(lds + (tid < 256 ? GA_WT : GA_BIAS) + (tid < 256 ? u * 16 : ((u >> 3) * 128 + (u & 7) * 16))) = st.w; }
  { const int t = tid >> 3, e8 = (tid & 7) * 8; const u32x4 u = st.v; const unsigned uu[4] = {u.x, u.y, u.z, u.w};
#pragma unroll
    for (int j = 0; j < 8; ++j) { const int e = e8 + j; const bf16_t val = (bf16_t)((j & 1) ? (uu[j >> 1] >> 16) : (uu[j >> 1] & 0xffffu)); *(bf16_t*)(vtl + e * 128 + ((((t >> 2) ^ (e & 14)) << 3) | ((t & 3) << 1))) = val; } }
  asm volatile("" ::: "memory");
  gla_a_stage_load(f, b_lo, nload, tid, st);
  __syncthreads();
  { const int dir = tid >> 8, d = (tid >> 3) & 31, tg = tid & 7;
    float wv[16];
#pragma unroll
    for (int r = 0; r < 16; ++r) wv[r] = *(const float*)(lds + GA_WT + ((dir * 16 + r) * 32 + d) * 4);
    const float bias = *(const float*)(lds + GA_BIAS + (dir * 32 + d) * 4);
    float la[8];
#pragma unroll
    for (int i = 0; i < 8; ++i) { const char* zd = lds + GA_ZA + (i * 8 + tg) * 64 + dir * 32; const u32x4 u0 = *(const u32x4*)zd, u1 = *(const u32x4*)(zd + 16);
      float a = bias; a += bflo(u0.x) * wv[0] + bfhi(u0.x) * wv[1] + bflo(u0.y) * wv[2] + bfhi(u0.y) * wv[3] + bflo(u0.z) * wv[4] + bfhi(u0.z) * wv[5] + bflo(u0.w) * wv[6] + bfhi(u0.w) * wv[7];
      a += bflo(u1.x) * wv[8] + bfhi(u1.x) * wv[9] + bflo(u1.y) * wv[10] + bfhi(u1.y) * wv[11] + bflo(u1.z) * wv[12] + bfhi(u1.z) * wv[13] + bflo(u1.w) * wv[14] + bfhi(u1.w) * wv[15];
      la[i] = flogsigm(a) * (1.f / 16.f); }
    float tot = 0.f;
    if (dir == 0) {
#pragma unroll
      for (int i = 0; i < 8; ++i) { tot += la[i]; la[i] = tot; }
    } else {
#pragma unroll
      for (int i = 7; i >= 0; --i) { tot += la[i]; la[i] = tot; }
    }
    float pre = 0.f;
    const int lb = (tid & 63) & ~7;
#pragma unroll
    for (int o = 1; o < 8; ++o) { const float v = __shfl(tot, lb | ((tg + (dir == 0 ? -o : o)) & 7)); const bool take = dir == 0 ? (tg - o >= 0) : (tg + o <= 7); pre += take ? v : 0.f; }
    float full = pre + tot;
    const float bC = __shfl(full, lb | (dir == 0 ? 7 : 0));
    float kb8[8];
#pragma unroll
    for (int i = 0; i < 8; ++i) { const int t = tg * 8 + i; const float bb = la[i] + pre; f.gla_b[((size_t)(t0 + t) * 2 + dir) * 256 + h * 32 + d] = bb;
      const float kv = bf2f(*(const bf16_t*)(lds + GA_ZK + (i * 8 + tg) * 64 + d * 2)); kb8[i] = kv * __expf(bC - bb); }
    *(bf16x8*)(kbt + gswz128(dir * 32 + d, tg * 16)) = pack8(kb8);
    if (tg == 0) f.gla_dec[((size_t)((b * 8 + h) * 2 + dir) * 68 + c) * 32 + d] = bC;
  }
  __syncthreads();
  { const int dir = w >> 2, mt = (w >> 1) & 1; float* dst = f.gla_s + ((size_t)((b * 8 + h) * 2 + dir) * 68 + c) * 2048;
    const bf16x8 a0 = *(const bf16x8*)(kbt + gswz128(dir * 32 + mt * 16 + fr, fg * 16)), a1 = *(const bf16x8*)(kbt + gswz128(dir * 32 + mt * 16 + fr, 64 + fg * 16));
#pragma unroll
    for (int q = 0; q < 2; ++q) { const int e = ((w & 1) * 2 + q) * 16 + fr; const char* rp = vtl + e * 128;
      const bf16x8 b0 = *(const bf16x8*)(rp + (((2 * fg) ^ (e & 14)) << 3)), b1 = *(const bf16x8*)(rp + (((8 + 2 * fg) ^ (e & 14)) << 3));
      f32x4 d4 = {0.f, 0.f, 0.f, 0.f}; d4 = __builtin_amdgcn_mfma_f32_16x16x32_bf16(a0, b0, d4, 0, 0, 0); d4 = __builtin_amdgcn_mfma_f32_16x16x32_bf16(a1, b1, d4, 0, 0, 0);
      *(f32x4*)(dst + e * 32 + mt * 16 + fg * 4) = d4; } }
}
__device__ __forceinline__ void ph_gla_a(const FP& f, int b_lo, int b_hi, char* lds) {
  const int tid0 = TIDX; const int nitems = (b_hi - b_lo) * 8 * 68; const int g = blockIdx.x, G = gridDim.x;
  const int count = g < nitems ? (nitems - g + G - 1) / G : 0; if (count == 0) return;
  auto itm = [&](int k) -> int { return g + (k < count ? k : count - 1) * G; };
  GlaS s0, s1, s2;
  gla_a_stage_load(f, b_lo, itm(0), tid0, s0); asm volatile("" ::: "memory"); gla_a_stage_load(f, b_lo, itm(1), tid0, s1); asm volatile("" ::: "memory"); gla_a_stage_load(f, b_lo, itm(2), tid0, s2);
  for (int k = 0; k < count; k += 3) {
    gla_a_item(f, b_lo, itm(k), itm(k + 3), tid0, s0, lds);
    gla_a_item(f, b_lo, itm(k + 1), itm(k + 4), tid0, s1, lds);
    gla_a_item(f, b_lo, itm(k + 2), itm(k + 5), tid0, s2, lds);
  }
}
template <bool DRY = false>
__device__ __forceinline__ void ph_gla_b(const FP& f, int b_lo, int b_hi, int nblk = 0, int blk0 = 0) {
  const int n = (b_hi - b_lo) * 8 * 2 * 2048; const int nb_eff = nblk ? nblk : (int)gridDim.x; const int myb = (int)blockIdx.x - blk0; if (myb < 0 || myb >= nb_eff) return;
  const int nthr = nb_eff * NT;
  for (int i0 = myb * NT + TIDX; i0 < n; i0 += 4 * nthr) {
    float* sb[4]; const float* db[4]; float S[4]; int dirq[4];
#pragma unroll
    for (int q = 0; q < 4; ++q) { const int i = i0 + q * nthr; const int ii = i < n ? i : i0; const int el = ii & 2047, seq = ii >> 11; const int dir = seq & 1, h = (seq >> 1) & 7, b = b_lo + (seq >> 4);
      sb[q] = f.gla_s + (size_t)((b * 8 + h) * 2 + dir) * 68 * 2048 + el; db[q] = f.gla_dec + (size_t)((b * 8 + h) * 2 + dir) * 68 * 32 + (el & 31); S[q] = 0.f; dirq[q] = dir; }
    if (!DRY && i0 + 3 * nthr < n) {
      float kvr[12][4], dcr[12][4];
      auto chk = [&](int q, int step) -> int { const int st_ = step < 68 ? step : 67; return dirq[q] == 0 ? st_ : (st_ < 4 ? 3 - st_ : 71 - st_); };
#pragma unroll
      for (int s = 0; s < 12; ++s)
#pragma unroll
        for (int q = 0; q < 4; ++q) { const int c = chk(q, s); kvr[s][q] = sb[q][(size_t)c * 2048]; dcr[s][q] = db[q][c * 32]; }
#define GLB_STEP(J, step_) do { _Pragma("unroll") for (int q = 0; q < 4; ++q) { const int c = chk(q, (step_)); float kv = kvr[J][q], dc = dcr[J][q]; \
        asm volatile("" : "+v"(kv), "+v"(dc)); \
        { const int cn = chk(q, (step_) + 12); kvr[J][q] = sb[q][(size_t)cn * 2048]; dcr[J][q] = db[q][cn * 32]; } \
        sb[q][(size_t)c * 2048] = S[q]; S[q] = __expf(dc) * S[q] + kv; } } while (0)
#pragma unroll 1
      for (int base = 0; base < 60; base += 12) { GLB_STEP(0, base); GLB_STEP(1, base + 1); GLB_STEP(2, base + 2); GLB_STEP(3, base + 3); GLB_STEP(4, base + 4); GLB_STEP(5, base + 5); GLB_STEP(6, base + 6); GLB_STEP(7, base + 7);
        GLB_STEP(8, base + 8); GLB_STEP(9, base + 9); GLB_STEP(10, base + 10); GLB_STEP(11, base + 11); }
      GLB_STEP(0, 60); GLB_STEP(1, 61); GLB_STEP(2, 62); GLB_STEP(3, 63); GLB_STEP(4, 64); GLB_STEP(5, 65); GLB_STEP(6, 66); GLB_STEP(7, 67);
#undef GLB_STEP
    } else {
#pragma unroll 2
    for (int step = 0; step < 68; ++step) {
#pragma unroll
      for (int q = 0; q < 4; ++q) { const int c = dirq[q] == 0 ? step : (step < 4 ? 3 - step : 71 - step); const float kv = sb[q][(size_t)c * 2048]; const float dc = db[q][c * 32];
        if (!DRY && i0 + q * nthr < n) sb[q][(size_t)c * 2048] = S[q]; S[q] = __expf(dc) * S[q] + kv; } }
    }
    if (DRY) asm volatile("" :: "v"(S[0]), "v"(S[1]), "v"(S[2]), "v"(S[3]));
  }
}
constexpr int GC_QT = 0, GC_KH = 8192, GC_VT = 16384, GC_SS = 24576, GC_ST = 25088;
struct GlaC { u32x2 q, k, g[2]; f32x4 bb[2], s[2]; u32x4 v; };
__device__ __forceinline__ void gla_c_load(const FP& f, int b_lo, int item, int tid, GlaC& x) {
  const int b = b_lo + item / (8 * 68), h = (item / 68) % 8, c = item % 68; const int t0 = b * FS + c * 64;
  const int lane = tid & 63, w = tid >> 6, fr = lane & 15, fg = lane >> 4, it = w & 3, eh = w >> 2;
  { const int t = tid >> 3, d4 = (tid & 7) * 4; const bf16_t* zr = f.zf + (size_t)(t0 + t) * Z0_LD; x.q = *(const u32x2*)(zr + Z0_GQ + h * 32 + d4); x.k = *(const u32x2*)(zr + Z0_GK + h * 32 + d4);
#pragma unroll
    for (int dir = 0; dir < 2; ++dir) x.bb[dir] = *(const f32x4*)(f.gla_b + ((size_t)(t0 + t) * 2 + dir) * 256 + h * 32 + d4);
    x.v = *(const u32x4*)(zr + Z0_GV + h * 64 + (tid & 7) * 8); }
  { const float* Sg = f.gla_s + ((size_t)((b * 8 + h) * 2) * 68 + c) * 2048;
#pragma unroll
    for (int q = 0; q < 2; ++q) { const int ci = q * 512 + tid; const int dir = ci >> 9, u = ci & 511; x.s[q] = *(const f32x4*)(Sg + (size_t)dir * 68 * 2048 + u * 4); } }
  { const int t = t0 + it * 16 + fr;
#pragma unroll
    for (int n2 = 0; n2 < 2; ++n2) x.g[n2] = *(const u32x2*)(f.zf + (size_t)t * Z0_LD + Z0_GG + h * 64 + (eh * 2 + n2) * 16 + fg * 4); }
}
template <class OutT>
__device__ __forceinline__ void gla_c_item(const FP& f, int b_lo, int item, int nload, int tid0, GlaC& st, const f32x4 (&gn)[2], OutT* cat, int ldc, char* lds) {
  char* qtl = lds + GC_QT; char* khl = lds + GC_KH; char* vtl = lds + GC_VT; float* ssq = (float*)(lds + GC_SS); char* stl = lds + GC_ST;
  int tid = tid0; asm volatile("" : "+v"(tid)); const int lane = tid & 63, w = tid >> 6, fr = lane & 15, fg = lane >> 4, it = w & 3, eh = w >> 2;
  const int b = b_lo + item / (8 * 68), h = (item / 68) % 8, c = item % 68; const int t0 = b * FS + c * 64;
  __syncthreads();
  { const int t = tid >> 3, d4 = (tid & 7) * 4; const u32x2 qu = st.q, ku = st.k;
    const float q[4] = {bflo(qu.x), bfhi(qu.x), bflo(qu.y), bfhi(qu.y)}, k[4] = {bflo(ku.x), bfhi(ku.x), bflo(ku.y), bfhi(ku.y)};
#pragma unroll
    for (int dir = 0; dir < 2; ++dir) { const f32x4 bb = st.bb[dir];
      u32x2 qo, ko; qo.x = pk2(q[0] * __expf(bb.x), q[1] * __expf(bb.y)); qo.y = pk2(q[2] * __expf(bb.z), q[3] * __expf(bb.w)); ko.x = pk2(k[0] * __expf(-bb.x), k[1] * __expf(-bb.y)); ko.y = pk2(k[2] * __expf(-bb.z), k[3] * __expf(-bb.w));
      *(u32x2*)(qtl + dir * 4096 + gswz64(t, d4 * 2)) = qo; *(u32x2*)(khl + dir * 4096 + gswz64(t, d4 * 2)) = ko; }
    const int e8 = (tid & 7) * 8; const u32x4 u = st.v; const unsigned uu[4] = {u.x, u.y, u.z, u.w};
#pragma unroll
    for (int j = 0; j < 8; ++j) { const int e = e8 + j; const bf16_t val = (bf16_t)((j & 1) ? (uu[j >> 1] >> 16) : (uu[j >> 1] & 0xffffu)); *(bf16_t*)(vtl + e * 128 + ((((t >> 2) ^ (e & 14)) << 3) | ((t & 3) << 1))) = val; } }
#pragma unroll
  for (int q = 0; q < 2; ++q) { const int ci = q * 512 + tid; const int dir = ci >> 9, u = ci & 511, row = u >> 3, cc = u & 7; *(f32x4*)(stl + dir * 8192 + row * 128 + ((cc ^ (row & 7)) << 4)) = st.s[q]; }
  u32x2 gq[2] = {st.g[0], st.g[1]};
  asm volatile("" : "+v"(gq[0].x), "+v"(gq[0].y), "+v"(gq[1].x), "+v"(gq[1].y) :: "memory");
  gla_c_load(f, b_lo, nload, tid, st);
  __syncthreads();
  f32x4 ot[2]; ot[0] = (f32x4){0.f, 0.f, 0.f, 0.f}; ot[1] = ot[0];
#pragma unroll
  for (int dir = 0; dir < 2; ++dir) {
    const bf16x8 qfr = *(const bf16x8*)(qtl + dir * 4096 + gswz64(it * 16 + fr, fg * 16));
    f32x4 sc_[4];
#pragma unroll
    for (int jt = 0; jt < 4; ++jt) { const bf16x8 kfr = *(const bf16x8*)(khl + dir * 4096 + gswz64(jt * 16 + fr, fg * 16)); sc_[jt] = __builtin_amdgcn_mfma_f32_16x16x32_bf16(kfr, qfr, (f32x4){0.f, 0.f, 0.f, 0.f}, 0, 0, 0); }
#pragma unroll
    for (int jt = 0; jt < 4; ++jt)
#pragma unroll
      for (int r = 0; r < 4; ++r) { const int j = jt * 16 + fg * 4 + r, i = it * 16 + fr; const bool keep = dir == 0 ? (j <= i) : (j >= i); if (!keep) sc_[jt][r] = 0.f; }
    bf16x8 pf[2];
#pragma unroll
    for (int ks = 0; ks < 2; ++ks) { u32x4 u; u.x = pk2(sc_[2 * ks].x, sc_[2 * ks].y); u.y = pk2(sc_[2 * ks].z, sc_[2 * ks].w); u.z = pk2(sc_[2 * ks + 1].x, sc_[2 * ks + 1].y); u.w = pk2(sc_[2 * ks + 1].z, sc_[2 * ks + 1].w); pf[ks] = __builtin_bit_cast(bf16x8, u); }
#pragma unroll
    for (int n2 = 0; n2 < 2; ++n2) { const int row = (eh * 2 + n2) * 16 + fr;
#pragma unroll
      for (int ks = 0; ks < 2; ++ks) { const char* rp = vtl + row * 128; const int c0 = (8 * ks + fg) ^ (row & 14), c1 = (8 * ks + 4 + fg) ^ (row & 14);
        const u32x2 lo = *(const u32x2*)(rp + (c0 << 3)), hi = *(const u32x2*)(rp + (c1 << 3)); u32x4 u; u.x = lo.x; u.y = lo.y; u.z = hi.x; u.w = hi.y;
        ot[n2] = __builtin_amdgcn_mfma_f32_16x16x32_bf16(__builtin_bit_cast(bf16x8, u), pf[ks], ot[n2], 0, 0, 0); }
      const char* sr = stl + dir * 8192 + row * 128; const f32x4 s0 = *(const f32x4*)(sr + (((2 * fg) ^ (row & 7)) << 4)), s1 = *(const f32x4*)(sr + (((2 * fg + 1) ^ (row & 7)) << 4));
      u32x4 su; su.x = pk2(s0.x, s0.y); su.y = pk2(s0.z, s0.w); su.z = pk2(s1.x, s1.y); su.w = pk2(s1.z, s1.w);
      ot[n2] = __builtin_amdgcn_mfma_f32_16x16x32_bf16(__builtin_bit_cast(bf16x8, su), qfr, ot[n2], 0, 0, 0); }
  }
  float ss = 0.f;
#pragma unroll
  for (int n2 = 0; n2 < 2; ++n2) ss += ot[n2].x * ot[n2].x + ot[n2].y * ot[n2].y + ot[n2].z * ot[n2].z + ot[n2].w * ot[n2].w;
  ss += __shfl_xor(ss, 16); ss += __shfl_xor(ss, 32);
  const int par = (item & 1) * 128;
  (void)par;
  if (fg == 0) ssq[eh * 64 + it * 16 + fr] = ss;
  __syncthreads();
  const float ri = __builtin_amdgcn_rsqf((ssq[it * 16 + fr] + ssq[64 + it * 16 + fr]) * (1.f / 64.f) + 1e-6f);
  const int t = t0 + it * 16 + fr;
#pragma unroll
  for (int n2 = 0; n2 < 2; ++n2) { const int e = (eh * 2 + n2) * 16 + fg * 4; const u32x2 gu = gq[n2];
    f32x4 o = ot[n2] * ri * gn[n2]; o.x *= fsilu(bflo(gu.x)); o.y *= fsilu(bfhi(gu.x)); o.z *= fsilu(bflo(gu.y)); o.w *= fsilu(bfhi(gu.y));
    store4(cat + (size_t)t * ldc + h * 64 + e, o); }
}
template <class OutT>
__device__ __forceinline__ void ph_gla_c2(const FP& f, int b_lo, int b_hi, OutT* cat, int ldc, char* lds) {
  const int tid0 = TIDX; const int nitems = (b_hi - b_lo) * 8 * 68; const int g = blockIdx.x, G = gridDim.x;
  const int count = g < nitems ? (nitems - g + G - 1) / G : 0; if (count == 0) return;
  auto itm = [&](int k) -> int { return g + (k < count ? k : count - 1) * G; };
  f32x4 gn[2];
  { const int lane = tid0 & 63, w = tid0 >> 6, fg = lane >> 4, eh = w >> 2;
#pragma unroll
    for (int n2 = 0; n2 < 2; ++n2) gn[n2] = *(const f32x4*)(f.p.gla_out_norm + (eh * 2 + n2) * 16 + fg * 4); }
  GlaC s0, s1, s2;
  gla_c_load(f, b_lo, itm(0), tid0, s0); asm volatile("" ::: "memory"); gla_c_load(f, b_lo, itm(1), tid0, s1); asm volatile("" ::: "memory"); gla_c_load(f, b_lo, itm(2), tid0, s2);
  for (int k = 0; k < count; k += 3) {
    gla_c_item(f, b_lo, itm(k), itm(k + 3), tid0, s0, gn, cat, ldc, lds);
    gla_c_item(f, b_lo, itm(k + 1), itm(k + 4), tid0, s1, gn, cat, ldc, lds);
    gla_c_item(f, b_lo, itm(k + 2), itm(k + 5), tid0, s2, gn, cat, ldc, lds);
  }
}
constexpr int GLA_C_LDS = 2 * 4096 * 2 + 8192 + 512;
template <class OutT>
__device__ __forceinline__ void ph_gla_c(const FP& f, int b_lo, int b_hi, OutT* cat, int ldc, char* lds) {
  bf16_t* qtl = (bf16_t*)lds; bf16_t* khl = qtl + 2 * 2048; char* vtl = lds + 16384; float* ssq = (float*)(lds + 16384 + 8192);
  const int tid = TIDX, lane = tid & 63, w = tid >> 6, fr = lane & 15, fg = lane >> 4, it = w & 3, eh = w >> 2;
  const int nitems = (b_hi - b_lo) * 8 * 68;
  for (int item = blockIdx.x; item < nitems; item += gridDim.x) {
    const int b = b_lo + item / (8 * 68), h = (item / 68) % 8, c = item % 68; const int t0 = b * FS + c * 64;
    __syncthreads();
    { const int t = tid >> 3, d4 = (tid & 7) * 4; const bf16_t* zr = f.zf + (size_t)(t0 + t) * Z0_LD; const u32x2 qu = *(const u32x2*)(zr + Z0_GQ + h * 32 + d4), ku = *(const u32x2*)(zr + Z0_GK + h * 32 + d4);
      const float q[4] = {bflo(qu.x), bfhi(qu.x), bflo(qu.y), bfhi(qu.y)}, k[4] = {bflo(ku.x), bfhi(ku.x), bflo(ku.y), bfhi(ku.y)};
#pragma unroll
      for (int dir = 0; dir < 2; ++dir) { const f32x4 bb = *(const f32x4*)(f.gla_b + ((size_t)(t0 + t) * 2 + dir) * 256 + h * 32 + d4);
        u32x2 qo, ko; qo.x = pk2(q[0] * __expf(bb.x), q[1] * __expf(bb.y)); qo.y = pk2(q[2] * __expf(bb.z), q[3] * __expf(bb.w)); ko.x = pk2(k[0] * __expf(-bb.x), k[1] * __expf(-bb.y)); ko.y = pk2(k[2] * __expf(-bb.z), k[3] * __expf(-bb.w));
        *(u32x2*)((char*)qtl + dir * 4096 + gswz64(t, d4 * 2)) = qo; *(u32x2*)((char*)khl + dir * 4096 + gswz64(t, d4 * 2)) = ko; } }
    { const int t = tid >> 3, e8 = (tid & 7) * 8; const u32x4 u = *(const u32x4*)(f.zf + (size_t)(t0 + t) * Z0_LD + Z0_GV + h * 64 + e8); const unsigned uu[4] = {u.x, u.y, u.z, u.w};
#pragma unroll
      for (int j = 0; j < 8; ++j) { const int e = e8 + j; const bf16_t val = (bf16_t)((j & 1) ? (uu[j >> 1] >> 16) : (uu[j >> 1] & 0xffffu)); *(bf16_t*)(vtl + e * 128 + ((((t >> 2) ^ (e & 14)) << 3) | ((t & 3) << 1))) = val; } }
    __syncthreads();
    f32x4 ot[2]; ot[0] = (f32x4){0.f, 0.f, 0.f, 0.f}; ot[1] = ot[0];
#pragma unroll
    for (int dir = 0; dir < 2; ++dir) {
      const bf16x8 qfr = *(const bf16x8*)((const char*)qtl + dir * 4096 + gswz64(it * 16 + fr, fg * 16));
      f32x4 st[4];
#pragma unroll
      for (int jt = 0; jt < 4; ++jt) { const bf16x8 kfr = *(const bf16x8*)((const char*)khl + dir * 4096 + gswz64(jt * 16 + fr, fg * 16)); st[jt] = __builtin_amdgcn_mfma_f32_16x16x32_bf16(kfr, qfr, (f32x4){0.f, 0.f, 0.f, 0.f}, 0, 0, 0); }
#pragma unroll
      for (int jt = 0; jt < 4; ++jt)
#pragma unroll
        for (int r = 0; r < 4; ++r) { const int j = jt * 16 + fg * 4 + r, i = it * 16 + fr; const bool keep = dir == 0 ? (j <= i) : (j >= i); if (!keep) st[jt][r] = 0.f; }
      bf16x8 pf[2];
#pragma unroll
      for (int ks = 0; ks < 2; ++ks) { u32x4 u; u.x = pk2(st[2 * ks].x, st[2 * ks].y); u.y = pk2(st[2 * ks].z, st[2 * ks].w); u.z = pk2(st[2 * ks + 1].x, st[2 * ks + 1].y); u.w = pk2(st[2 * ks + 1].z, st[2 * ks + 1].w); pf[ks] = __builtin_bit_cast(bf16x8, u); }
      const float* Sg = f.gla_s + ((size_t)((b * 8 + h) * 2 + dir) * 68 + c) * 2048;
#pragma unroll
      for (int n2 = 0; n2 < 2; ++n2) { const int row = (eh * 2 + n2) * 16 + fr;
#pragma unroll
        for (int ks = 0; ks < 2; ++ks) { const char* rp = vtl + row * 128; const int c0 = (8 * ks + fg) ^ (row & 14), c1 = (8 * ks + 4 + fg) ^ (row & 14);
          const u32x2 lo = *(const u32x2*)(rp + (c0 << 3)), hi = *(const u32x2*)(rp + (c1 << 3)); u32x4 u; u.x = lo.x; u.y = lo.y; u.z = hi.x; u.w = hi.y;
          ot[n2] = __builtin_amdgcn_mfma_f32_16x16x32_bf16(__builtin_bit_cast(bf16x8, u), pf[ks], ot[n2], 0, 0, 0); }
        const f32x4 s0 = *(const f32x4*)(Sg + row * 32 + fg * 8), s1 = *(const f32x4*)(Sg + row * 32 + fg * 8 + 4); u32x4 su; su.x = pk2(s0.x, s0.y); su.y = pk2(s0.z, s0.w); su.z = pk2(s1.x, s1.y); su.w = pk2(s1.z, s1.w);
        ot[n2] = __builtin_amdgcn_mfma_f32_16x16x32_bf16(__builtin_bit_cast(bf16x8, su), qfr, ot[n2], 0, 0, 0); }
    }
    float ss = 0.f;
#pragma unroll
    for (int n2 = 0; n2 < 2; ++n2) ss += ot[n2].x * ot[n2].x + ot[n2].y * ot[n2].y + ot[n2].z * ot[n2].z + ot[n2].w * ot[n2].w;
    ss += __shfl_xor(ss, 16); ss += __shfl_xor(ss, 32);
    if (fg == 0) ssq[eh * 64 + it * 16 + fr] = ss;
    __syncthreads();
    const float ri = __builtin_amdgcn_rsqf((ssq[it * 16 + fr] + ssq[64 + it * 16 + fr]) * (1.f / 64.f) + 1e-6f);
    const int t = t0 + it * 16 + fr;
#pragma unroll
    for (int n2 = 0; n2 < 2; ++n2) { const int e = (eh * 2 + n2) * 16 + fg * 4; const u32x2 gu = *(const u32x2*)(f.zf + (size_t)t * Z0_LD + Z0_GG + h * 64 + e); const f32x4 gn = *(const f32x4*)(f.p.gla_out_norm + e);
      f32x4 o = ot[n2] * ri * gn; o.x *= fsilu(bflo(gu.x)); o.y *= fsilu(bfhi(gu.x)); o.z *= fsilu(bflo(gu.y)); o.w *= fsilu(bfhi(gu.y));
      store4(cat + (size_t)t * ldc + h * 64 + e, o); }
  }
}
struct RW {
  const bf16_t* z; int b_lo, b_hi;
  const bf16_t *w2T, *a2T, *g2T;
  bf16_t *M, *N, *R2, *Y0;
  bf16_t* sg;
  const float *mu, *w0, *a0, *kk_scale, *k_a, *r_k, *ln_g, *ln_b;
};
#ifndef R1_REP
#define R1_REP 0
#endif
#define R1_LOOP(sn) if (!((skipmask >> ((sn) - 1)) & 1)) for (int rp_ = 0; rp_ <= ((R1_REP >> ((sn) - 1)) & 1); ++rp_)
constexpr int RC_R = 256, RC_K = 1024, RC_V = 1792, RC_ZW = 2560, RC_ZA = 2688, RC_ZG = 2816;
__device__ __forceinline__ int rw_q(int b, int h, int dir, int c) { return ((b * 12 + h) * 2 + dir) * 68 + c; }
__device__ __forceinline__ float fsoftplus(float x) { return fmaxf(x, 0.f) + __logf(1.f + __expf(-fabsf(x))); }
__device__ __forceinline__ float ftanh(float x) { return 1.f - 2.f * __builtin_amdgcn_rcpf(__expf(2.f * x) + 1.f); }
__device__ __forceinline__ float zsm1(const RW& a, int tk, int col, bool hp, bool hn) {
  const bf16_t* p = a.z + (size_t)tk * Z1_LD + col; const float zc = bf2f(p[0]), pv = bf2f(p[hp ? -Z1_LD : 0]), nx = bf2f(p[hn ? Z1_LD : 0]);
  return zc + a.mu[col - 256] * (0.5f * ((hp ? pv : 0.f) + (hn ? nx : 0.f)) - zc);
}
__device__ __forceinline__ void zsm8(const RW& a, int tk, int col, bool hp, bool hn, float (&o)[8]) {
  const bf16_t* p = a.z + (size_t)tk * Z1_LD + col; const u32x4 c = *(const u32x4*)p; const u32x4 pv = *(const u32x4*)(p + (hp ? -Z1_LD : 0)), nx = *(const u32x4*)(p + (hn ? Z1_LD : 0));
  const float fp = hp ? 0.5f : 0.f, fn = hn ? 0.5f : 0.f;
  const f32x4 m0 = *(const f32x4*)(a.mu + col - 256), m1 = *(const f32x4*)(a.mu + col - 256 + 4);
  const unsigned cc[4] = {c.x, c.y, c.z, c.w}, pp[4] = {pv.x, pv.y, pv.z, pv.w}, nn[4] = {nx.x, nx.y, nx.z, nx.w}; const float mm[8] = {m0.x, m0.y, m0.z, m0.w, m1.x, m1.y, m1.z, m1.w};
#pragma unroll
  for (int j = 0; j < 4; ++j) { float zc = bflo(cc[j]); o[2 * j] = zc + mm[2 * j] * (fp * bflo(pp[j]) + fn * bflo(nn[j]) - zc); zc = bfhi(cc[j]); o[2 * j + 1] = zc + mm[2 * j + 1] * (fp * bfhi(pp[j]) + fn * bfhi(nn[j]) - zc); }
}
#define MFMA16(a, b, c) __builtin_amdgcn_mfma_f32_16x16x32_bf16(a, b, c, 0, 0, 0)

constexpr int R1_PW = 0, R1_PA = 16640, R1_LP = 0, R1_XF = 16384;
constexpr int R1_KT = 33280, R1_BH = R1_KT + 8192, R1_KH = R1_BH + 8192, R1_RT = R1_KH + 8192;
constexpr int R1_BBT = R1_RT + 8192, R1_KBT = R1_BBT + 8192, R1_VT = R1_KBT + 8192;
constexpr int R1_AAK = R1_VT + 8192, R1_ARB = R1_AAK + 8192, R1_ARK = R1_ARB + 8192;
constexpr int R1_WT = R1_ARK + 8192, R1_U0T = R1_WT + 8192;
constexpr int R1_MISC = R1_U0T + 8192;
constexpr int R1_LB = R1_MISC + (8 * 64 + 64 + 64) * 4;
constexpr int R1_TB = R1_LB + 8192;
constexpr int R1_LDS = R1_TB + 2048;
struct Z8Raw { u32x4 c, pv, nx; };
__device__ __forceinline__ void zsm8_load(const RW& a, int tk, int col, bool hp, bool hn, Z8Raw& x) {
  const bf16_t* p = a.z + (size_t)tk * Z1_LD + col; x.c = *(const u32x4*)p; x.pv = *(const u32x4*)(p + (hp ? -Z1_LD : 0)); x.nx = *(const u32x4*)(p + (hn ? Z1_LD : 0));
}
__device__ __forceinline__ void zsm8_calc(const RW& a, int col, bool hp, bool hn, const Z8Raw& x, float (&o)[8]) {
  const float fp = hp ? 0.5f : 0.f, fn = hn ? 0.5f : 0.f;
  const f32x4 m0 = *(const f32x4*)(a.mu + col - 256), m1 = *(const f32x4*)(a.mu + col - 256 + 4);
  const unsigned cc[4] = {x.c.x, x.c.y, x.c.z, x.c.w}, pp[4] = {x.pv.x, x.pv.y, x.pv.z, x.pv.w}, nn[4] = {x.nx.x, x.nx.y, x.nx.z, x.nx.w}; const float mm[8] = {m0.x, m0.y, m0.z, m0.w, m1.x, m1.y, m1.z, m1.w};
#pragma unroll
  for (int j = 0; j < 4; ++j) { float zc = bflo(cc[j]); o[2 * j] = zc + mm[2 * j] * (fp * bflo(pp[j]) + fn * bflo(nn[j]) - zc); zc = bfhi(cc[j]); o[2 * j + 1] = zc + mm[2 * j + 1] * (fp * bfhi(pp[j]) + fn * bfhi(nn[j]) - zc); }
}
struct R1A { Z8Raw z[2]; bf16x8 wt[4][2]; };
struct R1B { unsigned r[10], k[10], v[10]; float w0, a0, kks, ka, rk, mur, muk, muv; };
__device__ __forceinline__ void r1_load_a(const RW& a, int b_lo, int item, int w, int lane, R1A& x) {
  const int fr = lane & 15, fg = lane >> 4;
  const int b = b_lo + item / (12 * 2 * 68), h = (item / (2 * 68)) % 12, dir = (item / 68) & 1, c = item % 68; const int t0 = b * FS + c * 64;
  const bool first_chunk = (c == 0 || c == 4), last_chunk = (c == 3 || c == 67);
  const int mat = w >> 2, mt = w & 3; const int i = mt * 16 + fr; const int ti = dir ? 63 - i : i; const bool hp = !(first_chunk && ti == 0), hn = !(last_chunk && ti == 63);
#pragma unroll
  for (int ks = 0; ks < 2; ++ks) { const int col = (mat ? RC_ZA : RC_ZW) + dir * 64 + ks * 32 + fg * 8; zsm8_load(a, t0 + ti, col, hp, hn, x.z[ks]); }
  const bf16_t* WT = (mat ? a.a2T : a.w2T) + ((size_t)dir * 768 + h * 64) * 64;
#pragma unroll
  for (int nt = 0; nt < 4; ++nt)
#pragma unroll
    for (int ks = 0; ks < 2; ++ks) x.wt[nt][ks] = *(const bf16x8*)(WT + (size_t)(nt * 16 + fr) * 64 + ks * 32 + fg * 8);
}
__device__ __forceinline__ void r1_load_b(const RW& a, int b_lo, int item, int w, int lane, R1B& x) {
  const int b = b_lo + item / (12 * 2 * 68), h = (item / (2 * 68)) % 12, dir = (item / 68) & 1, c = item % 68; const int t0 = b * FS + c * 64;
  const bool first_chunk = (c == 0 || c == 4), last_chunk = (c == 3 || c == 67);
  const int tlo = dir ? 56 - 8 * w : 8 * w; const int ch = h * 64 + lane;
#pragma unroll
  for (int j = 0; j < 10; ++j) { int tt = dir ? tlo + 8 - j : tlo - 1 + j;        const bool ok = !(first_chunk && tt < 0) && !(last_chunk && tt > 63); tt = ok ? tt : (tt < 0 ? 0 : 63);
    const bf16_t* p = a.z + (size_t)(t0 + tt) * Z1_LD + (ch & ~1); x.r[j] = *(const unsigned*)(p + RC_R); x.k[j] = *(const unsigned*)(p + RC_K); x.v[j] = *(const unsigned*)(p + RC_V); }
  x.w0 = a.w0[dir * 768 + ch]; x.a0 = a.a0[dir * 768 + ch]; x.kks = a.kk_scale[ch]; x.ka = a.k_a[ch]; x.rk = a.r_k[ch]; x.mur = a.mu[ch]; x.muk = a.mu[768 + ch]; x.muv = a.mu[1536 + ch];
}
__device__ __forceinline__ void zsm8_calc_mu(const f32x4 m0, const f32x4 m1, bool hp, bool hn, const Z8Raw& x, float (&o)[8]) {
  const float fp = hp ? 0.5f : 0.f, fn = hn ? 0.5f : 0.f;
  const unsigned cc[4] = {x.c.x, x.c.y, x.c.z, x.c.w}, pp[4] = {x.pv.x, x.pv.y, x.pv.z, x.pv.w}, nn[4] = {x.nx.x, x.nx.y, x.nx.z, x.nx.w}; const float mm[8] = {m0.x, m0.y, m0.z, m0.w, m1.x, m1.y, m1.z, m1.w};
#pragma unroll
  for (int j = 0; j < 4; ++j) { float zc = bflo(cc[j]); o[2 * j] = zc + mm[2 * j] * (fp * bflo(pp[j]) + fn * bflo(nn[j]) - zc); zc = bfhi(cc[j]); o[2 * j + 1] = zc + mm[2 * j + 1] * (fp * bfhi(pp[j]) + fn * bfhi(nn[j]) - zc); }
}
__device__ __forceinline__ int swz(int row, int off) { return row * 128 + (off ^ ((row & 7) << 4)); }
__device__ __forceinline__ int swz256(int row, int off) { return row * 256 + (off ^ ((row & 15) << 4)); }
__device__ __forceinline__ bf16x8 ldfrag(const char* base, int rt, int ks, int fr, int fg) { return *(const bf16x8*)(base + swz(rt * 16 + fr, ks * 64 + fg * 16)); }

__device__ __forceinline__ void ph_rwkv1(const RW& a, int b_lo, int b_hi, char* lds, int skipmask = 0) {
  const int tid0 = TIDX, w = __builtin_amdgcn_readfirstlane(tid0 >> 6);
  float* pw = (float*)(lds + R1_PW); float* pa = (float*)(lds + R1_PA); float* Lp = (float*)(lds + R1_LP); float* Xf = (float*)(lds + R1_XF);
  float* segsum = (float*)(lds + R1_MISC); float* gC = segsum + 512; float* bon = gC + 64;
  const int nitems = (b_hi - b_lo) * 12 * 2 * 68; const int q_lo = rw_q(b_lo, 0, 0, 0);
  R1A pa_; R1B pb_;
  f32x4 mu1[2][2][2];
  { const int fg0 = (tid0 & 63) >> 4;
#pragma unroll
    for (int d = 0; d < 2; ++d)
#pragma unroll
      for (int ks = 0; ks < 2; ++ks) { const int col = ((w >> 2) ? RC_ZA : RC_ZW) + d * 64 + ks * 32 + fg0 * 8; mu1[d][ks][0] = *(const f32x4*)(a.mu + col - 256); mu1[d][ks][1] = *(const f32x4*)(a.mu + col - 256 + 4); } }
  __syncthreads();
  { const u32x4 z4 = {0u, 0u, 0u, 0u}; for (int i = tid0; i < 2048; i += NT) { const int m = i >> 9, o = (i & 511) * 16; *(u32x4*)(lds + (m == 0 ? R1_AAK : m == 1 ? R1_ARB : m == 2 ? R1_ARK : R1_LB) + o) = z4; } }
  { const int it0 = (int)blockIdx.x < nitems ? (int)blockIdx.x : 0;
    r1_load_a(a, b_lo, it0, w, tid0 & 63, pa_); asm volatile("" ::: "memory"); r1_load_b(a, b_lo, it0, w, tid0 & 63, pb_); }
  for (int item = blockIdx.x; item < nitems; item += gridDim.x) {
    const int b = b_lo + item / (12 * 2 * 68), h = (item / (2 * 68)) % 12, dir = (item / 68) & 1, c = item % 68; const int t0 = b * FS + c * 64;
    const size_t qo = (size_t)(rw_q(b, h, dir, c) - q_lo) * 4096;
    const bool first_chunk = (c == 0 || c == 4), last_chunk = (c == 3 || c == 67);
    int tid = tid0; asm volatile("" : "+v"(tid)); const int lane = tid & 63, fr = lane & 15, fg = lane >> 4;
    R1_LOOP(1) { const int mat = w >> 2, mt = w & 3; const int i = mt * 16 + fr; const int ti = dir ? 63 - i : i; const int tk = t0 + ti; const bool hp = !(first_chunk && ti == 0), hn = !(last_chunk && ti == 63);
      bf16x8 af[2];
#pragma unroll
      for (int ks = 0; ks < 2; ++ks) { float v[8]; zsm8_calc_mu(dir ? mu1[1][ks][0] : mu1[0][ks][0], dir ? mu1[1][ks][1] : mu1[0][ks][1], hp, hn, pa_.z[ks], v); if (!mat) {
#pragma unroll
          for (int j = 0; j < 8; ++j) v[j] = ftanh(v[j]); }
        af[ks] = pack8(v); }
      float* dst = mat ? pa : pw;
#pragma unroll
      for (int nt = 0; nt < 4; ++nt) { f32x4 acc = {0.f, 0.f, 0.f, 0.f};
#pragma unroll
        for (int ks = 0; ks < 2; ++ks) acc = MFMA16(af[ks], pa_.wt[nt][ks], acc);
        { float* dp = dst + (nt * 16 + fr) * 65 + mt * 16 + fg * 4; dp[0] = acc.x; dp[1] = acc.y; dp[2] = acc.z; dp[3] = acc.w; } }
    }
    const int nitem = item + (int)gridDim.x < nitems ? item + (int)gridDim.x : item;
    r1_load_a(a, b_lo, nitem, w, lane, pa_);
    __syncthreads();
    R1_LOOP(2) { const int k = lane, ch = h * 64 + k;
      const float w0 = pb_.w0, a0 = pb_.a0, kks = pb_.kks, ka = pb_.ka, rk = pb_.rk;
      float rr[8], kd[8], kap[8], bet[8], vv[8], lw[8];
      const float mur = pb_.mur, muk = pb_.muk, muv = pb_.muv;
      float pr[10], pk[10], pv[10];
      { const unsigned sh = (k & 1) ? 0u : 16u;
#pragma unroll
        for (int j = 0; j < 10; ++j) { pr[j] = __uint_as_float((pb_.r[j] << sh) & 0xffff0000u); pk[j] = __uint_as_float((pb_.k[j] << sh) & 0xffff0000u); pv[j] = __uint_as_float((pb_.v[j] << sh) & 0xffff0000u); }
#pragma unroll
        for (int j = 0; j < 10; j += 9) { const int tlo = dir ? 56 - 8 * w : 8 * w; const int tt = dir ? tlo + 8 - j : tlo - 1 + j; const bool ok = !(first_chunk && tt < 0) && !(last_chunk && tt > 63); const float m_ = ok ? 1.f : 0.f;
          pr[j] *= m_; pk[j] *= m_; pv[j] *= m_; } }
      float ksv[8], avv[8], ksq[8], bnp[8];
#pragma unroll
      for (int ii = 0; ii < 8; ++ii) { const int i = 8 * w + ii; const int jj = 1 + ii;
        const float r = pr[jj] + mur * (0.5f * (pr[jj - 1] + pr[jj + 1]) - pr[jj]), kx = pk[jj] + muk * (0.5f * (pk[jj - 1] + pk[jj + 1]) - pk[jj]), v = pv[jj] + muv * (0.5f * (pv[jj - 1] + pv[jj + 1]) - pv[jj]);
        const float aw = w0 + pw[k * 65 + i]; lw[ii] = -0.60653066f * fsigm(aw);
        const float av = fsigm(a0 + pa[k * 65 + i]); kd[ii] = kx * (1.f + (av - 1.f) * ka);
        const float ks_ = kx * kks; ksv[ii] = ks_; avv[ii] = av; ksq[ii] = ks_ * ks_; bnp[ii] = r * kd[ii] * rk; rr[ii] = r; vv[ii] = v; }
      { const int c = lane & 15; u32x4 s1 = {0u, 0u, 0u, 0u}, s2 = {0u, 0u, 0u, 0u}; const unsigned one = (c & 1) ? 0x3F800000u : 0x00003F80u; const int dq = (c & 7) >> 1;
        const unsigned o1 = c < 8 ? one : 0u, o2 = c < 8 ? 0u : one;
        s1.x = dq == 0 ? o1 : 0u; s1.y = dq == 1 ? o1 : 0u; s1.z = dq == 2 ? o1 : 0u; s1.w = dq == 3 ? o1 : 0u;
        s2.x = dq == 0 ? o2 : 0u; s2.y = dq == 1 ? o2 : 0u; s2.z = dq == 2 ? o2 : 0u; s2.w = dq == 3 ? o2 : 0u;
        f32x4 d1 = {0.f, 0.f, 0.f, 0.f};
        d1 = MFMA16(pack8(ksq), __builtin_bit_cast(bf16x8, s1), d1); d1 = MFMA16(pack8(bnp), __builtin_bit_cast(bf16x8, s2), d1);
        u32x4 bu; bu.x = pk2(d1.x, d1.y); bu.y = pk2(d1.z, d1.w); bu.z = 0u; bu.w = 0u;
        const u32x4 on4 = {0x3F803F80u, 0x3F803F80u, 0u, 0u}; const f32x4 z4 = {0.f, 0.f, 0.f, 0.f};
        const f32x4 d2 = MFMA16(__builtin_bit_cast(bf16x8, on4), __builtin_bit_cast(bf16x8, bu), z4);
        if (lane >= 8 && lane < 16) bon[8 * w + lane - 8] = d2.x;
#pragma unroll
        for (int ii = 0; ii < 8; ++ii) { const float nrm = __int_as_float(__builtin_amdgcn_readlane(__float_as_int(d2.x), ii)); kap[ii] = ksv[ii] * __builtin_amdgcn_rsqf(nrm + 1e-12f); bet[ii] = kap[ii] * avv[ii]; } }
      float run = 0.f;
#pragma unroll
      for (int ii = 0; ii < 8; ++ii) run += lw[ii];
      segsum[w * 64 + k] = run;
#pragma unroll
      for (int ii = 0; ii < 8; ++ii) asm volatile("" : "+v"(vv[ii]), "+v"(rr[ii]), "+v"(kd[ii]), "+v"(kap[ii]) :: "memory");
      r1_load_b(a, b_lo, nitem, w, lane, pb_);
      __syncthreads();
      float pre = 0.f, total = 0.f;
#pragma unroll
      for (int s = 0; s < 8; ++s) { const float v = segsum[s * 64 + k]; total += v; pre += s < w ? v : 0.f; }
      const float Etot = __expf(total);
      if (w == 0) gC[k] = Etot;
      float bb8[8], kb8[8]; float E = __expf(pre);
#pragma unroll
      for (int ii = 0; ii < 8; ++ii) { const int i = 8 * w + ii; const float Eprev = E; E = E * __expf(lw[ii]); const float En = __builtin_amdgcn_rcpf(E);
        *(bf16_t*)(lds + R1_KT + swz(i, k * 2)) = f2bf(kap[ii] * Eprev); *(bf16_t*)(lds + R1_BH + swz(i, k * 2)) = f2bf(bet[ii] * En);
        *(bf16_t*)(lds + R1_KH + swz(i, k * 2)) = f2bf(kd[ii] * En); *(bf16_t*)(lds + R1_RT + swz(i, k * 2)) = f2bf(rr[ii] * E);
        const float etc = Etot * En; bb8[ii] = bet[ii] * etc; kb8[ii] = kd[ii] * etc; }
      *(bf16x8*)(lds + R1_BBT + swz(k, w * 16)) = pack8(bb8); *(bf16x8*)(lds + R1_KBT + swz(k, w * 16)) = pack8(kb8); *(bf16x8*)(lds + R1_VT + swz(k, w * 16)) = pack8(vv);
    }
    __syncthreads();
    R1_LOOP(3) { const int half = w >> 2, it = half ? 3 - (w & 3) : (w & 3); const char* Xb = lds + (half ? R1_RT : R1_KT);
      const bf16x8 x0 = ldfrag(Xb, it, 0, fr, fg), x1 = ldfrag(Xb, it, 1, fr, fg); const int i = it * 16 + fr;
#pragma unroll
      for (int jt = 0; jt < 4; ++jt) {
        if (jt > it) continue;
        f32x4 d0 = {0.f, 0.f, 0.f, 0.f}, d1 = {0.f, 0.f, 0.f, 0.f};
        d0 = MFMA16(ldfrag(lds + R1_BH, jt, 0, fr, fg), x0, d0); d0 = MFMA16(ldfrag(lds + R1_BH, jt, 1, fr, fg), x1, d0);
        d1 = MFMA16(ldfrag(lds + R1_KH, jt, 0, fr, fg), x0, d1); d1 = MFMA16(ldfrag(lds + R1_KH, jt, 1, fr, fg), x1, d1);
        if (jt == it) {
#pragma unroll
        for (int r = 0; r < 4; ++r) { const int j = jt * 16 + fg * 4 + r; const bool keep = half ? (j <= i) : (j < i); if (!keep) { d0[r] = 0.f; d1[r] = 0.f; } } }
        if (half == 0) {
          if (jt == it) {
#pragma unroll
            for (int r = 0; r < 4; ++r) Lp[i * 64 + r * 16 + jt * 4 + fg] = d0[r]; }
          { u32x2 ol; ol.x = pk2(-d0.x, -d0.y); ol.y = pk2(-d0.z, -d0.w); *(u32x2*)(lds + R1_LB + swz(i, (jt * 16 + fg * 4) * 2)) = ol; }
          u32x2 o; o.x = pk2(d1.x, d1.y); o.y = pk2(d1.z, d1.w); *(u32x2*)(lds + R1_AAK + swz(i, (jt * 16 + fg * 4) * 2)) = o;
        } else {
          u32x2 o; o.x = pk2(d0.x, d0.y); o.y = pk2(d0.z, d0.w); *(u32x2*)(lds + R1_ARB + swz(i, (jt * 16 + fg * 4) * 2)) = o;
          o.x = pk2(d1.x, d1.y); o.y = pk2(d1.z, d1.w); *(u32x2*)(lds + R1_ARK + swz(i, (jt * 16 + fg * 4) * 2)) = o;
        }
      }
    }
    __syncthreads();
    R1_LOOP(4) {
      if (w < 4) { const int it = w; const bf16x8 b0 = ldfrag(lds + R1_AAK, it, 0, fr, fg), b1 = ldfrag(lds + R1_AAK, it, 1, fr, fg);
#pragma unroll
        for (int et = 0; et < 4; ++et) { f32x4 d = {0.f, 0.f, 0.f, 0.f};
          d = MFMA16(ldfrag(lds + R1_VT, et, 0, fr, fg), b0, d); d = MFMA16(ldfrag(lds + R1_VT, et, 1, fr, fg), b1, d);
          *(f32x4*)(Xf + (it * 16 + fr) * 64 + et * 16 + fg * 4) = d; } }
      else if (w == 4) { const int bb = lane >> 4, c = lane & 15; float t[16];
#pragma unroll
        for (int i = 0; i < 16; ++i) t[i] = 0.f;
        f32x4 ga[2][4], gb[2][4];
#define R1_TB_LD(G, DST) _Pragma("unroll") for (int q_ = 0; q_ < 2; ++q_) _Pragma("unroll") for (int r_ = 0; r_ < 4; ++r_) DST[q_][r_] = *(const f32x4*)(Lp + (16 * bb + 2 * (G) + q_) * 64 + r_ * 16 + bb * 4)
#define R1_TB_DO(G, SRC) _Pragma("unroll") for (int q_ = 0; q_ < 2; ++q_) { const int i_ = 2 * (G) + q_; float p0 = 0.f, p1 = 0.f, p2 = 0.f, p3 = 0.f; \
          p0 = SRC[q_][0].x * t[0] + SRC[q_][0].y * t[4] + SRC[q_][0].z * t[8] + SRC[q_][0].w * t[12]; p1 = SRC[q_][1].x * t[1] + SRC[q_][1].y * t[5] + SRC[q_][1].z * t[9] + SRC[q_][1].w * t[13]; \
          p2 = SRC[q_][2].x * t[2] + SRC[q_][2].y * t[6] + SRC[q_][2].z * t[10] + SRC[q_][2].w * t[14]; p3 = SRC[q_][3].x * t[3] + SRC[q_][3].y * t[7] + SRC[q_][3].z * t[11] + SRC[q_][3].w * t[15]; \
          t[i_] = ((i_ == c) ? 1.f : 0.f) - ((p0 + p1) + (p2 + p3)); }
        R1_TB_LD(0, ga); asm volatile("" ::: "memory");
        R1_TB_LD(1, gb); R1_TB_DO(0, ga); asm volatile("" ::: "memory");
        R1_TB_LD(2, ga); R1_TB_DO(1, gb); asm volatile("" ::: "memory");
        R1_TB_LD(3, gb); R1_TB_DO(2, ga); asm volatile("" ::: "memory");
        R1_TB_LD(4, ga); R1_TB_DO(3, gb); asm volatile("" ::: "memory");
        R1_TB_LD(5, gb); R1_TB_DO(4, ga); asm volatile("" ::: "memory");
        R1_TB_LD(6, ga); R1_TB_DO(5, gb); asm volatile("" ::: "memory");
        R1_TB_LD(7, gb); R1_TB_DO(6, ga); asm volatile("" ::: "memory");
        R1_TB_DO(7, gb);
#undef R1_TB_LD
#undef R1_TB_DO
#pragma unroll
        for (int i = 0; i < 16; ++i) *(bf16_t*)(lds + R1_TB + ((bb * 16 + i) * 16 + c) * 2) = f2bf(t[i]); }
    }
    __syncthreads();
    R1_LOOP(5) { const int col = (w & 3) * 16 + fr; u32x2 solp[4];
      const u32x2 z2 = {0u, 0u};
      f32x4 rhs[4]; u32x2 la[3][3], tb[4];
#pragma unroll
      for (int b = 0; b < 4; ++b) {
#pragma unroll
        for (int rr = 0; rr < 4; ++rr) { const int i = 16 * b + 4 * fg + rr; rhs[b][rr] = w < 4 ? -bf2f(*(const bf16_t*)(lds + R1_KT + swz(i, col * 2))) : -Xf[i * 64 + col]; }
        tb[b] = *(const u32x2*)(lds + R1_TB + ((b * 16 + fr) * 16 + 4 * fg) * 2);
        if (b >= 1) { const char* lb_ = lds + R1_LB; const int lrow = 16 * b + fr;
#pragma unroll
          for (int cb = 0; cb < 3; ++cb) la[b - 1][cb] = cb < b ? *(const u32x2*)(lb_ + swz(lrow, cb * 32 + fg * 8)) : z2; } }
#pragma unroll
      for (int b = 0; b < 4; ++b) {
        f32x4 acc = rhs[b];
        if (b >= 1) { u32x4 au, bu; au.x = la[b - 1][0].x; au.y = la[b - 1][0].y; au.z = la[b - 1][1].x; au.w = la[b - 1][1].y;
          const u32x2 bhi = b >= 2 ? solp[1] : z2; bu.x = solp[0].x; bu.y = solp[0].y; bu.z = bhi.x; bu.w = bhi.y;
          acc = MFMA16(__builtin_bit_cast(bf16x8, au), __builtin_bit_cast(bf16x8, bu), acc);
          if (b == 3) { au.x = la[2][2].x; au.y = la[2][2].y; au.z = 0u; au.w = 0u; bu.x = solp[2].x; bu.y = solp[2].y; bu.z = 0u; bu.w = 0u;
            acc = MFMA16(__builtin_bit_cast(bf16x8, au), __builtin_bit_cast(bf16x8, bu), acc); } }
        { u32x4 au, bu; au.x = tb[b].x; au.y = tb[b].y; au.z = 0u; au.w = 0u;
          bu.x = pk2(acc.x, acc.y); bu.y = pk2(acc.z, acc.w); bu.z = 0u; bu.w = 0u;
          const f32x4 zero4 = {0.f, 0.f, 0.f, 0.f}; const f32x4 s = MFMA16(__builtin_bit_cast(bf16x8, au), __builtin_bit_cast(bf16x8, bu), zero4);
          solp[b].x = pk2(s.x, s.y); solp[b].y = pk2(s.z, s.w); }
        *(u32x2*)(lds + (w < 4 ? R1_WT : R1_U0T) + swz(col, (16 * b + 4 * fg) * 2)) = solp[b];
      }
    }
    __syncthreads();
    R1_LOOP(6) { const int tt = w & 3, half = w >> 2;
      if (half == 0) {
        const bf16x8 b0 = ldfrag(lds + R1_ARB, tt, 0, fr, fg), b1 = ldfrag(lds + R1_ARB, tt, 1, fr, fg); const int i = tt * 16 + fr;
#pragma unroll 2
        for (int kt = 0; kt < 4; ++kt) { f32x4 d = {0.f, 0.f, 0.f, 0.f}; d = MFMA16(ldfrag(lds + R1_WT, kt, 0, fr, fg), b0, d); d = MFMA16(ldfrag(lds + R1_WT, kt, 1, fr, fg), b1, d);
          const u32x2 ru = *(const u32x2*)(lds + R1_RT + swz(i, (kt * 16 + fg * 4) * 2)); u32x2 o; o.x = pk2(d.x + bflo(ru.x), d.y + bfhi(ru.x)); o.y = pk2(d.z + bflo(ru.y), d.w + bfhi(ru.y));
          *(u32x2*)(a.R2 + qo + i * 64 + kt * 16 + fg * 4) = o; }
        const bf16x8 c0 = ldfrag(lds + R1_BBT, tt, 0, fr, fg), c1 = ldfrag(lds + R1_BBT, tt, 1, fr, fg); const int k2 = tt * 16 + fr;
#pragma unroll 2
        for (int kt = 0; kt < 4; ++kt) { f32x4 d = {0.f, 0.f, 0.f, 0.f}; d = MFMA16(ldfrag(lds + R1_WT, kt, 0, fr, fg), c0, d); d = MFMA16(ldfrag(lds + R1_WT, kt, 1, fr, fg), c1, d);
#pragma unroll
          for (int r = 0; r < 4; ++r) { const int k1 = kt * 16 + fg * 4 + r; if (k1 == k2) d[r] += gC[k1]; }
          u32x2 o; o.x = pk2(d.x, d.y); o.y = pk2(d.z, d.w); *(u32x2*)(a.M + qo + (((tt * 2 + (kt >> 1)) * 64 + fg * 16 + fr) * 8 + 4 * (kt & 1))) = o; }
      } else {
        const bf16x8 b0 = ldfrag(lds + R1_ARB, tt, 0, fr, fg), b1 = ldfrag(lds + R1_ARB, tt, 1, fr, fg), k0 = ldfrag(lds + R1_ARK, tt, 0, fr, fg), k1 = ldfrag(lds + R1_ARK, tt, 1, fr, fg); const int i = tt * 16 + fr; const float bn = bon[i];
#pragma unroll 2
        for (int et = 0; et < 4; ++et) { f32x4 d = {0.f, 0.f, 0.f, 0.f};
          d = MFMA16(ldfrag(lds + R1_U0T, et, 0, fr, fg), b0, d); d = MFMA16(ldfrag(lds + R1_U0T, et, 1, fr, fg), b1, d); d = MFMA16(ldfrag(lds + R1_VT, et, 0, fr, fg), k0, d); d = MFMA16(ldfrag(lds + R1_VT, et, 1, fr, fg), k1, d);
#pragma unroll
          for (int r = 0; r < 4; ++r) d[r] += bn * bf2f(*(const bf16_t*)(lds + R1_VT + swz(et * 16 + fg * 4 + r, i * 2)));
          u32x2 o; o.x = pk2(d.x, d.y); o.y = pk2(d.z, d.w); *(u32x2*)(a.Y0 + qo + i * 64 + et * 16 + fg * 4) = o; }
        const bf16x8 u0 = ldfrag(lds + R1_U0T, tt, 0, fr, fg), u1 = ldfrag(lds + R1_U0T, tt, 1, fr, fg), v0 = ldfrag(lds + R1_VT, tt, 0, fr, fg), v1 = ldfrag(lds + R1_VT, tt, 1, fr, fg); const int e = tt * 16 + fr;
#pragma unroll 2
        for (int kt = 0; kt < 4; ++kt) { f32x4 d = {0.f, 0.f, 0.f, 0.f};
          d = MFMA16(ldfrag(lds + R1_BBT, kt, 0, fr, fg), u0, d); d = MFMA16(ldfrag(lds + R1_BBT, kt, 1, fr, fg), u1, d); d = MFMA16(ldfrag(lds + R1_KBT, kt, 0, fr, fg), v0, d); d = MFMA16(ldfrag(lds + R1_KBT, kt, 1, fr, fg), v1, d);
          u32x2 o; o.x = pk2(d.x, d.y); o.y = pk2(d.z, d.w); *(u32x2*)(a.N + qo + e * 64 + kt * 16 + fg * 4) = o; }
      }
    }
  }
}
struct R2Regs { u32x2 mlo[4][2], mhi[4][2], nn[4]; };
__device__ __forceinline__ void r2_load(R2Regs& g, const bf16_t* Mt, const bf16_t* Ns, int fr, int fg) {
#pragma unroll
  for (int mt = 0; mt < 4; ++mt) {
#pragma unroll
    for (int s = 0; s < 2; ++s) { const u32x4 mv = *(const u32x4*)(Mt + ((mt * 2 + s) * 64 + fg * 16 + fr) * 8); g.mlo[mt][s] = (u32x2){mv.x, mv.y}; g.mhi[mt][s] = (u32x2){mv.z, mv.w}; }
    g.nn[mt] = *(const u32x2*)(Ns + mt * 16 + fg * 4); }
}
template <bool DRY>
__device__ __forceinline__ void r2_step(const R2Regs& g, f32x4 (&st)[4], bf16_t* Ns, int fg) {
  bf16x8 sb[2]; u32x4 su[2];
#pragma unroll
  for (int s = 0; s < 2; ++s) { su[s].x = pk2(st[2 * s].x, st[2 * s].y); su[s].y = pk2(st[2 * s].z, st[2 * s].w); su[s].z = pk2(st[2 * s + 1].x, st[2 * s + 1].y); su[s].w = pk2(st[2 * s + 1].z, st[2 * s + 1].w); sb[s] = __builtin_bit_cast(bf16x8, su[s]); }
#pragma unroll
  for (int mt = 0; mt < 4; ++mt) { u32x2 o; o.x = (mt & 1) ? su[mt >> 1].z : su[mt >> 1].x; o.y = (mt & 1) ? su[mt >> 1].w : su[mt >> 1].y; if (!DRY) *(u32x2*)(Ns + mt * 16 + fg * 4) = o; }
#pragma unroll
  for (int mt = 0; mt < 4; ++mt) { f32x4 nw = (f32x4){bflo(g.nn[mt].x), bfhi(g.nn[mt].x), bflo(g.nn[mt].y), bfhi(g.nn[mt].y)};
#pragma unroll
    for (int s = 0; s < 2; ++s) { u32x4 u; u.x = g.mlo[mt][s].x; u.y = g.mlo[mt][s].y; u.z = g.mhi[mt][s].x; u.w = g.mhi[mt][s].y; nw = MFMA16(__builtin_bit_cast(bf16x8, u), sb[s], nw); }
    st[mt] = nw; }
}
template <bool DRY = false>
__device__ __forceinline__ void ph_rwkv2(const RW& a, int b_lo, int b_hi) {
  const int lane = TIDX & 63, fr = lane & 15, fg = lane >> 4; const int gw = (TIDX >> 6) >= 2 ? 0x40000000 : (int)blockIdx.x * 2 + (TIDX >> 6), ngw = gridDim.x * 2;
  const int nseq = (b_hi - b_lo) * 12 * 2; const int q_lo = rw_q(b_lo, 0, 0, 0);
  for (int wi = gw; wi < nseq * 4; wi += ngw) {
    const int eg = wi & 3, seq = wi >> 2; const int dir = seq & 1, h = (seq >> 1) % 12, b = b_lo + seq / 24; const int e = eg * 16 + fr;
    f32x4 st[4];
#pragma unroll
    for (int mt = 0; mt < 4; ++mt) st[mt] = (f32x4){0.f, 0.f, 0.f, 0.f};
    auto chunk_of = [&](int step) -> int { return dir == 0 ? step : (step < 4 ? 3 - step : 71 - step); };
    auto qoff = [&](int step) -> size_t { return (size_t)(rw_q(b, h, dir, chunk_of(step)) - q_lo) * 4096; };
    R2Regs g0, g1, g2, g3;
    { size_t qo = qoff(0); r2_load(g0, a.M + qo, a.N + qo + e * 64, fr, fg); qo = qoff(1); r2_load(g1, a.M + qo, a.N + qo + e * 64, fr, fg); qo = qoff(2); r2_load(g2, a.M + qo, a.N + qo + e * 64, fr, fg); }
#pragma unroll 1
    for (int step = 0; step < 68; step += 4) {
      { const size_t qn = qoff(step + 3); r2_load(g3, a.M + qn, a.N + qn + e * 64, fr, fg); }
      r2_step<DRY>(g0, st, a.N + qoff(step) + e * 64, fg);
      if (step + 4 < 68) { const size_t qn = qoff(step + 4); r2_load(g0, a.M + qn, a.N + qn + e * 64, fr, fg); }
      r2_step<DRY>(g1, st, a.N + qoff(step + 1) + e * 64, fg);
      if (step + 5 < 68) { const size_t qn = qoff(step + 5); r2_load(g1, a.M + qn, a.N + qn + e * 64, fr, fg); }
      r2_step<DRY>(g2, st, a.N + qoff(step + 2) + e * 64, fg);
      if (step + 6 < 68) { const size_t qn = qoff(step + 6); r2_load(g2, a.M + qn, a.N + qn + e * 64, fr, fg); }
      r2_step<DRY>(g3, st, a.N + qoff(step + 3) + e * 64, fg);
    }
    if (DRY) { asm volatile("" :: "v"(st[0].x), "v"(st[1].x), "v"(st[2].x), "v"(st[3].x)); }
  }
}
constexpr int R3_LDS = 64 * 128 * 2 + 1024;
__device__ __forceinline__ void ph_rwkv_sg(const RW& a, int b_lo, int b_hi) {
  const int tid = TIDX; if ((int)blockIdx.x < 96) return;
  const int worker = ((int)blockIdx.x - 96) * NT + tid, nworkers = ((int)gridDim.x - 96) * NT; const int ntask = (b_hi - b_lo) * 4096 * 16;
  for (int task = worker; task < ntask; task += nworkers) { const int tok = task >> 4, cg = task & 15; const int bl = tok >> 12, tl = tok & 4095; const int row = (b_lo + bl) * FS + FLC + tl;
    float v[8]; zsm8(a, row, RC_ZG + cg * 8, tl != 0, tl != 4095, v);
#pragma unroll
    for (int j = 0; j < 8; ++j) v[j] = fsigm(v[j]);
    *(bf16x8*)(a.sg + (size_t)tok * 128 + cg * 8) = pack8(v); }
}
constexpr int R3_R2 = 0, R3_N = 16384, R3_Y0 = 32768, R3_SG = 49152, R3_RED = 65536, R3_LDS2 = 65536 + 2048;
struct R3S { u32x4 q[8]; };
__device__ __forceinline__ void r3_stage_load(const RW& a, int b_lo, int q_lo, int item, int tid, R3S& x) {
  const int b = b_lo + item / (12 * 64), h = (item / 64) % 12, c = 4 + item % 64;
  const size_t q0 = (size_t)(rw_q(b, h, 0, c) - q_lo) * 4096, q1 = (size_t)(rw_q(b, h, 1, c) - q_lo) * 4096;
  x.q[0] = *(const u32x4*)(a.R2 + q0 + tid * 8); x.q[1] = *(const u32x4*)(a.R2 + q1 + tid * 8);
  x.q[2] = *(const u32x4*)(a.N + q0 + tid * 8); x.q[3] = *(const u32x4*)(a.N + q1 + tid * 8);
  x.q[4] = *(const u32x4*)(a.Y0 + q0 + tid * 8); x.q[5] = *(const u32x4*)(a.Y0 + q1 + tid * 8);
  const bf16_t* sgr = a.sg + ((size_t)(b - b_lo) * 4096 + (c - 4) * 64) * 128;
  x.q[6] = *(const u32x4*)(sgr + tid * 8); x.q[7] = *(const u32x4*)(sgr + 4096 + tid * 8);
}
__device__ __forceinline__ void r3_stage_store(char* lds, int tid, const R3S& x) {
  const int row = tid >> 3, cc = tid & 7; const int o = swz(row, cc * 16);
#pragma unroll
  for (int q = 0; q < 6; ++q) *(u32x4*)(lds + q * 8192 + o) = x.q[q];
#pragma unroll
  for (int q = 0; q < 2; ++q) { const int ci = q * 512 + tid; *(u32x4*)(lds + R3_SG + swz256(ci >> 4, (ci & 15) * 16)) = x.q[6 + q]; }
}
template <class OutT>
__device__ __forceinline__ void r3_item(const RW& a, int b_lo, int q_lo, int item, int nload, int tid0, R3S& st, const bf16x8 (&gw)[4][2], const f32x4 (&lg)[2], const f32x4 (&lb)[2], OutT* cat, int ldc, char* lds) {
  int tid = tid0; asm volatile("" : "+v"(tid)); const int lane = tid & 63, w = tid >> 6, fr = lane & 15, fg = lane >> 4, it = w & 3, eh = w >> 2, tl = it * 16 + fr;
  const int b = b_lo + item / (12 * 64), h = (item / 64) % 12, c = 4 + item % 64; const int t0 = b * FS + c * 64;
  float* red = (float*)(lds + R3_RED);
  r3_stage_store(lds, tid, st);
  asm volatile("" ::: "memory");
  r3_stage_load(a, b_lo, q_lo, nload, tid, st);
  __syncthreads();
  f32x4 y[2], g[2];
#pragma unroll
  for (int n2 = 0; n2 < 2; ++n2) { y[n2] = (f32x4){0.f, 0.f, 0.f, 0.f}; g[n2] = y[n2]; }
#pragma unroll
  for (int dir = 0; dir < 2; ++dir) { const int i = dir ? 63 - tl : tl;
    const bf16x8 r0 = *(const bf16x8*)(lds + R3_R2 + dir * 8192 + swz(i, fg * 16)), r1 = *(const bf16x8*)(lds + R3_R2 + dir * 8192 + swz(i, 64 + fg * 16));
#pragma unroll
    for (int n2 = 0; n2 < 2; ++n2) { const int et = eh * 2 + n2; const char* Sr = lds + R3_N + dir * 8192;
      y[n2] = MFMA16(*(const bf16x8*)(Sr + swz(et * 16 + fr, fg * 16)), r0, y[n2]); y[n2] = MFMA16(*(const bf16x8*)(Sr + swz(et * 16 + fr, 64 + fg * 16)), r1, y[n2]);
      const u32x2 yu = *(const u32x2*)(lds + R3_Y0 + dir * 8192 + swz(i, (et * 16 + fg * 4) * 2)); y[n2].x += bflo(yu.x); y[n2].y += bfhi(yu.x); y[n2].z += bflo(yu.y); y[n2].w += bfhi(yu.y); } }
#pragma unroll
  for (int ks = 0; ks < 4; ++ks) { const bf16x8 sb = *(const bf16x8*)(lds + R3_SG + swz256(tl, ks * 64 + fg * 16));
#pragma unroll
    for (int n2 = 0; n2 < 2; ++n2) g[n2] = MFMA16(gw[ks][n2], sb, g[n2]); }
  float s1 = 0.f, s2 = 0.f;
#pragma unroll
  for (int n2 = 0; n2 < 2; ++n2) { s1 += (y[n2].x + y[n2].y) + (y[n2].z + y[n2].w); s2 += y[n2].x * y[n2].x + y[n2].y * y[n2].y + y[n2].z * y[n2].z + y[n2].w * y[n2].w; }
  s1 += __shfl_xor(s1, 16); s1 += __shfl_xor(s1, 32); s2 += __shfl_xor(s2, 16); s2 += __shfl_xor(s2, 32);
  const int par = (item & 1) * 256;
  if (fg == 0) { red[par + eh * 128 + tl] = s1; red[par + eh * 128 + 64 + tl] = s2; }
  __syncthreads();
  const float mean = (red[par + tl] + red[par + 128 + tl]) * (1.f / 64.f); const float var = (red[par + 64 + tl] + red[par + 128 + 64 + tl]) * (1.f / 64.f) - mean * mean; const float ri = __builtin_amdgcn_rsqf(var + 64e-5f);
#pragma unroll
  for (int n2 = 0; n2 < 2; ++n2) { const int cch = h * 64 + (eh * 2 + n2) * 16 + fg * 4; const f32x4 o = ((y[n2] - mean) * ri * lg[n2] + lb[n2]) * g[n2]; store4(cat + (size_t)(t0 + tl) * ldc + 256 + cch, o); }
}
template <class OutT>
__device__ __forceinline__ void ph_rwkv3(const RW& a, int b_lo, int b_hi, OutT* cat, int ldc, char* lds, int xmode = 0) {
  const int tid0 = TIDX; (void)xmode;
  const int nitems = (b_hi - b_lo) * 12 * 64; const int q_lo = rw_q(b_lo, 0, 0, 0);
  int first, count; { const int g = blockIdx.x, G = gridDim.x;
    if (G == 256 && nitems == 1536) { first = g < 128 ? g * 8 : 1024 + (g - 128) * 4; count = g < 128 ? 8 : 4; }
    else { const int per = ((nitems + G - 1) / G + 3) & ~3; first = g * per; count = first >= nitems ? 0 : (first + per <= nitems ? per : nitems - first); } }
  int pos = first; const int end = first + count;
  while (pos < end) {
    const int seg_end = (((pos >> 6) + 1) << 6) < end ? (((pos >> 6) + 1) << 6) : end; const int n = seg_end - pos;
    bf16x8 gw[4][2]; f32x4 lg[2], lb[2];
    { const int lane = tid0 & 63, w = tid0 >> 6, fr = lane & 15, fg = lane >> 4, eh = w >> 2; const int h = (pos / 64) % 12;
#pragma unroll
      for (int n2 = 0; n2 < 2; ++n2) { const int cb = h * 64 + (eh * 2 + n2) * 16;
#pragma unroll
        for (int ks = 0; ks < 4; ++ks) gw[ks][n2] = *(const bf16x8*)(a.g2T + (size_t)(cb + fr) * 128 + ks * 32 + fg * 8);
        lg[n2] = *(const f32x4*)(a.ln_g + cb + fg * 4); lb[n2] = *(const f32x4*)(a.ln_b + cb + fg * 4); } }
    R3S s0, s1;
    r3_stage_load(a, b_lo, q_lo, pos, tid0, s0); asm volatile("" ::: "memory"); r3_stage_load(a, b_lo, q_lo, pos + 1 < seg_end ? pos + 1 : pos, tid0, s1);
    __syncthreads();
    for (int j = 0; j < n; j += 2) { const int i0 = pos + j, i1 = i0 + 1 < seg_end ? i0 + 1 : i0;
      r3_item(a, b_lo, q_lo, i0, i0 + 2 < seg_end ? i0 + 2 : seg_end - 1, tid0, s0, gw, lg, lb, cat, ldc, lds);
      r3_item(a, b_lo, q_lo, i1, i0 + 3 < seg_end ? i0 + 3 : seg_end - 1, tid0, s1, gw, lg, lb, cat, ldc, lds); }
    pos = seg_end;
  }
}
struct EpiPlainBf16 { bf16_t* z; int ld;
  __device__ void operator()(const f32x4 (&acc)[4][4], int mb, int nb, int lane) const { const int fr = lane & 15, fg = lane >> 4;
#pragma unroll
    for (int mt = 0; mt < 4; ++mt) { bf16_t* zr = z + (size_t)(mb + mt * 16 + fr) * ld + nb + fg * 4;
#pragma unroll
      for (int nt = 0; nt < 4; ++nt) { u32x2 o; o.x = pk2(acc[mt][nt].x, acc[mt][nt].y); o.y = pk2(acc[mt][nt].z, acc[mt][nt].w); *(u32x2*)(zr + nt * 16) = o; } } } };
__device__ __forceinline__ void ph_inproj1(const FP& f, const bf16_t* wt, int tm0, int tm1, char* lds) {
  ARowPlain ar{f.hb, FD}; EpiPlainBf16 ep{f.zf, Z1_LD}; const int ntn = Z1_LD / 128, ntiles = (tm1 - tm0) * ntn;
  for (int t = blockIdx.x; t < ntiles; t += gridDim.x) { const int tm = tm0 + t / ntn, tn = t % ntn; gemm_tile<4, 2>(ar, wt, FD, FD, tm * 256, tn * 128, lds, ep); }
}
__device__ __forceinline__ void ph_prep_rwkv(const FP& f, bf16_t* w2T, bf16_t* a2T, bf16_t* g2T, char* lds) {
  for (int t = blockIdx.x; t < 24 + 24 + 24; t += gridDim.x) {
    if (t < 24) prep_tile(f.p.rwkv_w2 + (size_t)(t / 12) * 64 * 768, 64, 768, w2T + (size_t)(t / 12) * 768 * 64, 0, (t % 12) * 64, RowMapId(), lds);
    else if (t < 48) { const int u = t - 24; prep_tile(f.p.rwkv_a2 + (size_t)(u / 12) * 64 * 768, 64, 768, a2T + (size_t)(u / 12) * 768 * 64, 0, (u % 12) * 64, RowMapId(), lds); }
    else { const int u = t - 48; prep_tile(f.p.rwkv_g2, 128, 768, g2T, (u / 12) * 64, (u % 12) * 64, RowMapId(), lds); }
  }
}
struct FW { const bf16_t* z; bf16_t* Gp; const bf16_t *T64t, *DFT2, *DFT3; int b_lo, b_hi; };
__device__ __forceinline__ void ph_prep_fourier(bf16_t* T64t, bf16_t* DFT2, bf16_t* DFT3) {
  for (int i = blockIdx.x * NT + TIDX; i < 128 * 64 + 128 * 128 + 64 * 128; i += gridDim.x * NT) {
    if (i < 8192) { const int n = i >> 6, c = i & 63; const float a = (float)(((n & 63) * c) & 63) * (1.f / 32.f); T64t[i] = f2bf(n < 64 ? cospif(a) : -sinpif(a)); }
    else if (i < 8192 + 16384) { const int j = i - 8192, r = j >> 7, K = j & 127; const float a = (float)(((r & 63) * (K & 63)) & 63) * (1.f / 32.f); const float cs = cospif(a), sn = sinpif(a);
      DFT2[j] = f2bf(r < 64 ? (K < 64 ? cs : sn) : (K < 64 ? -sn : cs)); }
    else { const int j = i - 8192 - 16384, r = j >> 7, K = j & 127; const float a = (float)((r * (K & 63)) & 63) * (1.f / 32.f); DFT3[j] = f2bf(K < 64 ? cospif(a) : sinpif(a)); }
  }
}
constexpr int F1_LDS = 512 * 64 * 2;
__device__ __forceinline__ void ph_fourier1(const FW& a, int b_lo, int b_hi, char* lds, bool rev = false) {
  const int tid = TIDX, lane = tid & 63, w = tid >> 6, fr = lane & 15, fg = lane >> 4;
  const int nitems = (b_hi - b_lo) * 64;
  for (int item = rev ? gridDim.x - 1 - blockIdx.x : blockIdx.x; item < nitems; item += gridDim.x) {
    const int b = b_lo + item / 64, l2 = item % 64; const size_t row0 = (size_t)b * FS + FLC + l2;
    __syncthreads();
    {
      const int g = w >> 1, nh = w & 1;
      bf16x8 bt[4][2];
#pragma unroll
      for (int q = 0; q < 4; ++q)
#pragma unroll
        for (int ks = 0; ks < 2; ++ks) bt[q][ks] = *(const bf16x8*)(a.T64t + ((nh * 4 + q) * 16 + fr) * 64 + ks * 32 + fg * 8);
#pragma unroll
      for (int mt = 0; mt < 4; ++mt) { const bf16_t* zr = a.z + (row0 + (size_t)64 * (mt * 16 + fr)) * Z1_LD + g * 64 + fg * 8; const bf16x8 a0 = *(const bf16x8*)zr, a1 = *(const bf16x8*)(zr + 32);
#pragma unroll
        for (int q = 0; q < 4; ++q) { f32x4 d = {0.f, 0.f, 0.f, 0.f}; d = MFMA16(a0, bt[q][0], d); d = MFMA16(a1, bt[q][1], d);
          u32x2 o; o.x = pk2(d.x, d.y); o.y = pk2(d.z, d.w); *(u32x2*)(lds + swz(g * 128 + (nh * 4 + q) * 16 + fr, (mt * 16 + fg * 4) * 2)) = o; } }
    }
    __syncthreads();
#pragma unroll 1
    for (int ct = 0; ct < 2; ++ct) {
      f32x4 acc[8];
#pragma unroll
      for (int nt = 0; nt < 8; ++nt) acc[nt] = (f32x4){0.f, 0.f, 0.f, 0.f};
      const int colt = 2 * w + ct; const int g = colt >> 2, m = (colt & 3) * 16 + fr;
#pragma unroll 1
      for (int ks = 0; ks < 4; ++ks) {
        const bf16x8 af = *(const bf16x8*)(lds + swz(g * 128 + (ks >> 1) * 64 + m, ((ks & 1) * 32 + fg * 8) * 2));
#pragma unroll
        for (int nt = 0; nt < 8; ++nt) { const bf16x8 bf_ = *(const bf16x8*)(a.DFT2 + (nt * 16 + fr) * 128 + ks * 32 + fg * 8); acc[nt] = MFMA16(af, bf_, acc[nt]); }
      }
#pragma unroll
      for (int nt = 0; nt < 4; ++nt) { const int k1 = nt * 16 + fr; const float ang = (float)((k1 * l2) & 4095) * (1.f / 2048.f); const float ct_ = cospif(ang), st_ = sinpif(ang);
        bf16_t* gr = a.Gp + ((((size_t)(b - b_lo) * 64 + k1) * 2 + 0) * 64 + l2) * 256; bf16_t* gi = gr + (size_t)64 * 256;
        const f32x4 R = acc[nt], I = acc[nt + 4]; const f32x4 pr = R * ct_ + I * st_, pi = I * ct_ - R * st_; const int col = colt * 16 + fg * 4;
        u32x2 o; o.x = pk2(pr.x, pr.y); o.y = pk2(pr.z, pr.w); *(u32x2*)(gr + col) = o; o.x = pk2(pi.x, pi.y); o.y = pk2(pi.z, pi.w); *(u32x2*)(gi + col) = o; }
    }
  }
}
constexpr int F2_RS = 272, F2_LDS = 256 * F2_RS;
template <class OutT>
__device__ __forceinline__ void ph_fourier2(const FW& a, int b_lo, int b_hi, OutT* cat, int ldc, char* lds, bool rev = false) {
  const int tid = TIDX, lane = tid & 63, w = tid >> 6, fr = lane & 15, fg = lane >> 4;
  const int nitems = (b_hi - b_lo) * 64;
  for (int item = rev ? gridDim.x - 1 - blockIdx.x : blockIdx.x; item < nitems; item += gridDim.x) {
    const int b = b_lo + item / 64, k1 = item % 64; const bf16_t* src = a.Gp + ((size_t)(b - b_lo) * 64 + k1) * 2 * 64 * 256;
    __syncthreads();
#pragma unroll 4
    for (int itn = 0; itn < 8; ++itn) { const int task = itn * 8 + w; const int K = (task & 1) * 64 + lane, c8 = task >> 1; const u32x4 u = *(const u32x4*)(src + (size_t)K * 256 + c8 * 8); const unsigned uu[4] = {u.x, u.y, u.z, u.w};
#pragma unroll
      for (int j = 0; j < 8; ++j) *(bf16_t*)(lds + (c8 * 8 + j) * F2_RS + K * 2) = (bf16_t)((j & 1) ? (uu[j >> 1] >> 16) : (uu[j >> 1] & 0xffffu)); }
    __syncthreads();
    f32x4 acc[2][4];
#pragma unroll
    for (int ct = 0; ct < 2; ++ct)
#pragma unroll
      for (int nt = 0; nt < 4; ++nt) acc[ct][nt] = (f32x4){0.f, 0.f, 0.f, 0.f};
#pragma unroll
    for (int ks = 0; ks < 4; ++ks) {
      bf16x8 af[2];
#pragma unroll
      for (int ct = 0; ct < 2; ++ct) af[ct] = *(const bf16x8*)(lds + ((2 * w + ct) * 16 + fr) * F2_RS + ks * 64 + fg * 16);
#pragma unroll
      for (int nt = 0; nt < 4; ++nt) { const bf16x8 bf_ = *(const bf16x8*)(a.DFT3 + (nt * 16 + fr) * 128 + ks * 32 + fg * 8);
#pragma unroll
        for (int ct = 0; ct < 2; ++ct) acc[ct][nt] = MFMA16(af[ct], bf_, acc[ct][nt]); }
    }
#pragma unroll
    for (int nt = 0; nt < 4; ++nt) { const int k2 = nt * 16 + fr; OutT* dst = cat + ((size_t)b * FS + FLC + k1 + 64 * k2) * ldc;
#pragma unroll
      for (int ct = 0; ct < 2; ++ct) store4(dst + (2 * w + ct) * 16 + fg * 4, acc[ct][nt] * (1.f / 512.f)); }
  }
}
#include <hip/hip_cooperative_groups.h>
namespace cg = cooperative_groups;
#ifndef R1_SKIP
#define R1_SKIP 0
#endif
#ifndef R3_XMODE
#define R3_XMODE 0
#endif
#ifndef RERUN_SKIP
#define RERUN_SKIP 0
#endif
#ifndef DRY_MASK
#define DRY_MASK 0
#endif
#ifndef USE_G8
#define USE_G8 1
#endif
#ifndef G8_P2
#define G8_P2 USE_G8
#endif
#ifndef G8_P6
#define G8_P6 USE_G8
#endif
#ifndef G8_MOE
#define G8_MOE USE_G8
#endif
#ifndef G8_MOED
#define G8_MOED G8_MOE
#endif
#ifndef G8_MOE_L0
#define G8_MOE_L0 G8_MOE
#endif
#ifndef G8_MOE_L1
#define G8_MOE_L1 G8_MOE
#endif
#ifndef G8_P11
#define G8_P11 USE_G8
#endif
#ifndef G8_P18
#define G8_P18 USE_G8
#endif
#if G8_MOE_L1
#define PREP_MOE1() ph_prep_moe<RowMapGate8, RowMapUp8>(f, 1, lds)
#else
#define PREP_MOE1() ph_prep_moe(f, 1, lds)
#endif
struct MK { FP f; RW r; FW w; bf16_t *moe_d1; bf16_t *wt_in0, *wt_in1, *wt_out0, *wt_out1, *w2T, *a2T, *g2T, *T64t, *DFT2, *DFT3; unsigned* bar; int ph_lo, ph_hi; };

__device__ __forceinline__ void ph_mod(const FP& f, char* lds) {
  float* sc = (float*)lds; float* red = sc + 5 * FD;
  const int tid = TIDX;
  for (int i = tid; i < 5 * FD; i += NT) { const int r = i / FD, k = i - r * FD; const float v = r < FB ? f.p.c[r * FD + k] : f.p.c_ctx[k]; sc[i] = v / (1.f + expf(-v)); }
  __syncthreads();
  const int col = tid & 63, kq = tid >> 6;
  for (int item = blockIdx.x; item < 2 * 96; item += gridDim.x) {
    const int layer = item / 96, j = (item % 96) * 64 + col; const float* W = f.p.ada_w + (size_t)layer * FD * 6 * FD + j;
    float a[5] = {0.f, 0.f, 0.f, 0.f, 0.f};
#pragma unroll 8
    for (int kk = 0; kk < 128; ++kk) { const int k = kq * 128 + kk; const float w = W[(size_t)k * 6 * FD];
#pragma unroll
      for (int r = 0; r < 5; ++r) a[r] += sc[r * FD + k] * w; }
#pragma unroll
    for (int r = 0; r < 5; ++r) red[(kq * 5 + r) * 64 + col] = a[r];
    __syncthreads();
    if (tid < 320) { const int r = tid >> 6; float s = f.p.ada_b[layer * 6 * FD + (item % 96) * 64 + col];
#pragma unroll
      for (int q = 0; q < 8; ++q) s += red[(q * 5 + r) * 64 + col];
      f.p.mod[((size_t)layer * 5 + r) * 6 * FD + (item % 96) * 64 + col] = s; }
    __syncthreads();
  }
}
template <bool FIRST>
__device__ __forceinline__ void norm_h_row(const FP& f, int layer, int t, int lane, const f32x4 (&v)[4]) {
  float ss = 0.f;
#pragma unroll
  for (int j = 0; j < 4; ++j) ss += v[j].x * v[j].x + v[j].y * v[j].y + v[j].z * v[j].z + v[j].w * v[j].w;
  const float ri = __builtin_amdgcn_rsqf(wave_sum(ss) * (1.f / FD) + 1e-6f); const float* md = f_modrow(f, layer, t); const float* gn = f.p.norm_mix + layer * FD;
#pragma unroll
  for (int j = 0; j < 4; ++j) { const int c = j * 256 + lane * 4; const f32x4 g = *(const f32x4*)(gn + c), sh = *(const f32x4*)(md + c), sc = *(const f32x4*)(md + FD + c);
    const f32x4 h = v[j] * ri * g * (sc + 1.f) + sh; u32x2 o; o.x = pk2(h.x, h.y); o.y = pk2(h.z, h.w); *(u32x2*)(f.hb + (size_t)t * FD + c) = o; }
}
__device__ __forceinline__ void ph_norm_h0(const FP& f) {
  const int lane = TIDX & 63, gw = blockIdx.x * (NT / 64) + (TIDX >> 6), ngw = gridDim.x * (NT / 64);
  for (int t = gw; t < FT; t += ngw) { const float* xr = f_xin_row(f, t); f32x4 v[4];
#pragma unroll
    for (int j = 0; j < 4; ++j) v[j] = *(const f32x4*)(xr + j * 256 + lane * 4);
    norm_h_row<true>(f, 0, t, lane, v); }
}
struct EpiOutProj0 { const FP* f;
  __device__ void operator()(const f32x4 (&acc)[4][4], int mb, int nb, int lane) const {
    const int fr = lane & 15, fg = lane >> 4;
#pragma unroll
    for (int mt = 0; mt < 4; ++mt) { const int m = mb + mt * 16 + fr; float* xo = f_xs_row(*f, m); const float* xi = f_xin_row(*f, m); const float* md = f_modrow(*f, 0, m) + 2 * FD;
#pragma unroll
      for (int nt = 0; nt < 4; ++nt) { const int c = nb + nt * 16 + fg * 4; const f32x4 x = *(const f32x4*)(xi + c), g = *(const f32x4*)(md + c); *(f32x4*)(xo + c) = x + g * acc[mt][nt]; } }
  } };
__device__ __forceinline__ void ph_outproj0(const FP& f, const bf16_t* wt, char* lds) {
  ARowPlain ar{f.hb, FD}; EpiOutProj0 ep{&f};
  for (int t = blockIdx.x; t < 68 * 8; t += gridDim.x) gemm_tile<4, 2>(ar, wt, FD, FD, (t >> 3) * 256, (t & 7) * 128, lds, ep);
}
template <bool LAST, bool DRY = false>
__device__ __forceinline__ void ph_combine(const FP& f, int layer) {
  const int lane = TIDX & 63, gw = blockIdx.x * (NT / 64) + (TIDX >> 6), ngw = gridDim.x * (NT / 64);
  int off[17]; off[0] = 0;
#pragma unroll
  for (int e = 0; e < 16; ++e) off[e + 1] = off[e] + f.cnt[e];
  for (int t = gw; t < FT; t += ngw) {
    const int b = t / FS, s = t - b * FS; if (LAST && s < FLC) continue;
    const int e0 = f.tok_e[t * 2], e1 = f.tok_e[t * 2 + 1]; int o0 = 0, o1 = 0;
#pragma unroll
    for (int e = 0; e < 16; ++e) { o0 = e == e0 ? off[e] : o0; o1 = e == e1 ? off[e] : o1; }
    const bf16_t* y0 = f.ymoe + (size_t)(o0 + f.tok_pos[t * 2]) * FD; const bf16_t* y1 = f.ymoe + (size_t)(o1 + f.tok_pos[t * 2 + 1]) * FD;
    const float w0 = f.tok_w[t * 2], w1 = f.tok_w[t * 2 + 1]; float* xr = f_xs_row(f, t); const float* md = f_modrow(f, layer, t) + 5 * FD;
    f32x4 v[4];
#pragma unroll
    for (int j = 0; j < 4; ++j) { const int c = j * 256 + lane * 4; const u32x2 a = *(const u32x2*)(y0 + c), bq = *(const u32x2*)(y1 + c); f32x4 x = *(f32x4*)(xr + c); const f32x4 g = *(const f32x4*)(md + c);
      x.x += g.x * (w0 * bflo(a.x) + w1 * bflo(bq.x)); x.y += g.y * (w0 * bfhi(a.x) + w1 * bfhi(bq.x)); x.z += g.z * (w0 * bflo(a.y) + w1 * bflo(bq.y)); x.w += g.w * (w0 * bfhi(a.y) + w1 * bfhi(bq.y));
      if (!DRY) *(f32x4*)(xr + c) = x; v[j] = x; }
    if (DRY) { asm volatile("" :: "v"(v[0].x), "v"(v[1].y), "v"(v[2].z), "v"(v[3].w)); continue; }
    if (!LAST) norm_h_row<false>(f, layer + 1, t, lane, v);
  }
}
struct CbMeta { int e0, e1, p0, p1; float w0, w1; };
struct CbRow { u32x2 a[4], b[4]; f32x4 x[4]; float w0, w1; };
template <bool LAST>
__device__ __forceinline__ int cb_token(int u) { return LAST ? (u / FL) * FS + FLC + u % FL : u; }
__device__ __forceinline__ void cb_load_meta(const FP& f, int t, CbMeta& m) { m.e0 = f.tok_e[t * 2]; m.e1 = f.tok_e[t * 2 + 1]; m.p0 = f.tok_pos[t * 2]; m.p1 = f.tok_pos[t * 2 + 1]; m.w0 = f.tok_w[t * 2]; m.w1 = f.tok_w[t * 2 + 1]; }
__device__ __forceinline__ void cb_load_row(const FP& f, const int (&off)[17], int t, int lane, const CbMeta& m, CbRow& rw) {
  int o0 = 0, o1 = 0;
#pragma unroll
  for (int e = 0; e < 16; ++e) { o0 = e == m.e0 ? off[e] : o0; o1 = e == m.e1 ? off[e] : o1; }
  const bf16_t* y0 = f.ymoe + (size_t)(o0 + m.p0) * FD; const bf16_t* y1 = f.ymoe + (size_t)(o1 + m.p1) * FD; const float* xr = f_xs_row(f, t);
#pragma unroll
  for (int j = 0; j < 4; ++j) { const int c = j * 256 + lane * 4; rw.a[j] = *(const u32x2*)(y0 + c); rw.b[j] = *(const u32x2*)(y1 + c); rw.x[j] = *(const f32x4*)(xr + c); }
  rw.w0 = m.w0; rw.w1 = m.w1;
}
template <bool LAST>
__device__ __forceinline__ void cb_finish(const FP& f, int layer, int t, int lane, bool valid, const CbRow& rw, const f32x4* cl) {
  const int b = t / FS, s = t - b * FS; const int rr = s < FLC ? FB : b; f32x4 v[4]; float* xr = f_xs_row(f, t);
#pragma unroll
  for (int j = 0; j < 4; ++j) { const f32x4 g = cl[rr * 256 + j * 64 + lane]; f32x4 x = rw.x[j]; const u32x2 a = rw.a[j], bq = rw.b[j]; const float w0 = rw.w0, w1 = rw.w1;
    x.x += g.x * (w0 * bflo(a.x) + w1 * bflo(bq.x)); x.y += g.y * (w0 * bfhi(a.x) + w1 * bfhi(bq.x)); x.z += g.z * (w0 * bflo(a.y) + w1 * bflo(bq.y)); x.w += g.w * (w0 * bfhi(a.y) + w1 * bfhi(bq.y)); v[j] = x; }
  if (!valid) return;
#pragma unroll
  for (int j = 0; j < 4; ++j) *(f32x4*)(xr + j * 256 + lane * 4) = v[j];
  if (!LAST) { float ss = 0.f;
#pragma unroll
    for (int j = 0; j < 4; ++j) ss += v[j].x * v[j].x + v[j].y * v[j].y + v[j].z * v[j].z + v[j].w * v[j].w;
    const float ri = __builtin_amdgcn_rsqf(wave_sum(ss) * (1.f / FD) + 1e-6f);
#pragma unroll
    for (int j = 0; j < 4; ++j) { const int c = j * 256 + lane * 4; const f32x4 G = cl[1280 + rr * 256 + j * 64 + lane], S = cl[2560 + rr * 256 + j * 64 + lane];
      const f32x4 h = v[j] * ri * G + S; u32x2 o; o.x = pk2(h.x, h.y); o.y = pk2(h.z, h.w); *(u32x2*)(f.hb + (size_t)t * FD + c) = o; } }
}
template <bool LAST>
__device__ __forceinline__ void ph_combine2(const FP& f, int layer, char* lds) {
  const int tid = TIDX, lane = tid & 63, gw = blockIdx.x * (NT / 64) + (tid >> 6), ngw = gridDim.x * (NT / 64);
  f32x4* cl = (f32x4*)lds;
  __syncthreads();
  for (int i = tid; i < 1280; i += NT) { const int rr = i >> 8, q4 = i & 255, c = q4 * 4; const float* md = f.p.mod + ((size_t)layer * (FB + 1) + rr) * 6 * FD; cl[i] = *(const f32x4*)(md + 5 * FD + c);
    if (!LAST) { const float* md1 = f.p.mod + ((size_t)(layer + 1) * (FB + 1) + rr) * 6 * FD; const f32x4 g = *(const f32x4*)(f.p.norm_mix + (layer + 1) * FD + c), sh = *(const f32x4*)(md1 + c), sc = *(const f32x4*)(md1 + FD + c);
      cl[1280 + i] = g * (sc + 1.f); cl[2560 + i] = sh; } }
  int off[17]; off[0] = 0;
#pragma unroll
  for (int e = 0; e < 16; ++e) off[e + 1] = off[e] + f.cnt[e];
  __syncthreads();
  const int ntok = LAST ? FB * FL : FT; const int count = gw < ntok ? (ntok - gw + ngw - 1) / ngw : 0; if (count == 0) return;
  auto tk = [&](int k) -> int { return cb_token<LAST>(gw + (k < count ? k : count - 1) * ngw); };
  CbMeta ma, mb; CbRow ra, rb;
  cb_load_meta(f, tk(0), ma); asm volatile("" ::: "memory"); cb_load_meta(f, tk(1), mb); asm volatile("" ::: "memory");
  cb_load_row(f, off, tk(0), lane, ma, ra);
  for (int k = 0; k < count; k += 2) {
    cb_load_row(f, off, tk(k + 1), lane, mb, rb); asm volatile("" ::: "memory"); cb_load_meta(f, tk(k + 2), ma);
    cb_finish<LAST>(f, layer, tk(k), lane, true, ra, cl);
    cb_load_row(f, off, tk(k + 2), lane, ma, ra); asm volatile("" ::: "memory"); cb_load_meta(f, tk(k + 3), mb);
    cb_finish<LAST>(f, layer, tk(k + 1), lane, k + 1 < count, rb, cl);
  }
}
__device__ __forceinline__ void prep_moe_one(const FP& f, int layer, int t, char* lds, bf16_t* dsel = nullptr) {
  const int e = t / 96, r = t % 96, which = r / 32, q = r % 32;
#if G8_MOE_L0
  if (which == 0) prep_strip(f.p.moe_w_gate + (size_t)(layer * 16 + e) * FD * 512, FD, 512, f.moe_gu + (size_t)e * FD * FD, (q & 15) * 64, (q >> 4) * 256, RowMapGate8(), lds);
  else if (which == 1) prep_strip(f.p.moe_w_up + (size_t)(layer * 16 + e) * FD * 512, FD, 512, f.moe_gu + (size_t)e * FD * FD, (q & 15) * 64, (q >> 4) * 256, RowMapUp8(), lds);
#else
  if (which == 0) prep_strip(f.p.moe_w_gate + (size_t)(layer * 16 + e) * FD * 512, FD, 512, f.moe_gu + (size_t)e * FD * FD, (q & 15) * 64, (q >> 4) * 256, RowMapGate(), lds);
  else if (which == 1) prep_strip(f.p.moe_w_up + (size_t)(layer * 16 + e) * FD * 512, FD, 512, f.moe_gu + (size_t)e * FD * FD, (q & 15) * 64, (q >> 4) * 256, RowMapUp(), lds);
#endif
  else prep_strip(f.p.moe_w_down + (size_t)(layer * 16 + e) * 512 * FD, 512, FD, (dsel ? dsel : f.moe_d) + (size_t)e * FD * 512, (q & 7) * 64, (q >> 3) * 256, RowMapId(), lds);
}
__device__ __forceinline__ void prep_l1_a(const MK& k, int t, char* lds) { const FP& f = k.f;
  if (t < 192) prep_strip(f.p.odd_w_in, FD, Z1_N, k.wt_in1, (t & 15) * 64, (t >> 4) * 256, RowMapId(), lds);
  else { const int u = t - 192; prep_strip(f.p.odd_w_out, FD, FD, k.wt_out1, (u & 15) * 64, (u >> 4) * 256, RowMapId(), lds); } }
__device__ __forceinline__ void prep_l1_b(const MK& k, int s, char* lds) { prep_moe_one(k.f, 1, (s >> 6) * 96 + (s & 63), lds); }
__device__ __forceinline__ void prep_l1_c(const MK& k, int s, char* lds) { prep_moe_one(k.f, 1, (s >> 5) * 96 + 64 + (s & 31), lds, k.moe_d1); }
__device__ __forceinline__ void prep_l1_ac(const MK& k, int t, char* lds) { if (t < 256) prep_l1_a(k, t, lds); else prep_l1_c(k, t - 256, lds); }
__device__ __forceinline__ int tail_cover(int U, int quota, int avail) { const int G = gridDim.x; const int R = (U + G - 1) / G; const int first_idle = U - (R - 1) * G; const int nidle = (R > 0 && first_idle < G) ? G - first_idle : 0; const int cov = nidle * quota; return cov < avail ? cov : avail; }
template <class Fn>
__device__ __forceinline__ void tail_fill(int U, int quota, int base, int limit, const Fn& fn) { const int G = gridDim.x, c = blockIdx.x; const int R = (U + G - 1) / G; if (R == 0) return; const int first_idle = U - (R - 1) * G; if (c < first_idle) return;
  const int rank = c - first_idle, nidle = G - first_idle;
  for (int j = 0; j < quota; ++j) { const int idx = base + rank + nidle * j; if (idx < limit) fn(idx); } }
__device__ __forceinline__ int moe_units(const FP& f) { int U = 0;
#pragma unroll
  for (int e = 0; e < 16; ++e) { const int n = __builtin_amdgcn_readfirstlane(__hip_atomic_load(f.cnt + e, __ATOMIC_RELAXED, __HIP_MEMORY_SCOPE_AGENT)); U += ((n + 255) >> 8) * 4; } return U; }
constexpr int FILL_Q2 = 5, FILL_Q6 = 5, FILL_Q8 = 3, FILL_Q9 = 3;
constexpr int L0_STRIPS = 64 + 1536;
__device__ __forceinline__ void prep_l0_one(const MK& k, int t, char* lds) { if (t < 64) prep_strip(k.f.p.even_w_out, FD, FD, k.wt_out0, (t & 15) * 64, (t >> 4) * 256, RowMapId(), lds); else prep_moe_one(k.f, 0, t - 64, lds); }
__device__ __forceinline__ void ph_prep_all0(const MK& k, char* lds) {
  const FP& f = k.f;
  for (int t = blockIdx.x; t < 16 * 10; t += gridDim.x) prep_strip(f.p.even_w_in, FD, Z0_N, k.wt_in0, (t & 15) * 64, (t >> 4) * 256, RowMapIn0(), lds);
  { u32x4 z = {0u, 0u, 0u, 0u}; u32x4* dst = (u32x4*)(k.wt_in0 + (size_t)Z0_N * FD); const int n16 = (W0_ROWS - Z0_N) * FD / 8; for (int i = blockIdx.x * NT + TIDX; i < n16; i += gridDim.x * NT) dst[i] = z;
    u32x4* dst1 = (u32x4*)(k.wt_in1 + (size_t)Z1_N * FD); const int n16b = (W1_ROWS - Z1_N) * FD / 8; for (int i = blockIdx.x * NT + TIDX; i < n16b; i += gridDim.x * NT) dst1[i] = z; }
  ph_prep_rwkv(f, k.w2T, k.a2T, k.g2T, lds);
  ph_prep_fourier(k.T64t, k.DFT2, k.DFT3);
  if (blockIdx.x == 0 && TIDX < 64) f.cnt[TIDX] = 0;
}

#define AS1 __attribute__((address_space(1)))
#define AS4 __attribute__((address_space(4)))
template <class T> __device__ __forceinline__ T* glob(T* p) { return (T*)(AS1 T*)p; }
__device__ __forceinline__ void globalize(MK& o, const AS4 MK& i) {
  o.ph_lo = i.ph_lo; o.ph_hi = i.ph_hi; o.f.layer = 0; o.f.pad1 = 0; o.r.b_lo = 0; o.r.b_hi = 0; o.w.b_lo = 0; o.w.b_hi = 0;
  o.f.p.x = glob(i.f.p.x);
  o.f.p.c = glob(i.f.p.c);
  o.f.p.ctx = glob(i.f.p.ctx);
  o.f.p.c_ctx = glob(i.f.p.c_ctx);
  o.f.p.ada_w = glob(i.f.p.ada_w);
  o.f.p.ada_b = glob(i.f.p.ada_b);
  o.f.p.norm_mix = glob(i.f.p.norm_mix);
  o.f.p.norm_ffn = glob(i.f.p.norm_ffn);
  o.f.p.even_w_in = glob(i.f.p.even_w_in);
  o.f.p.even_w_out = glob(i.f.p.even_w_out);
  o.f.p.gla_dec_w = glob(i.f.p.gla_dec_w);
  o.f.p.gla_dec_b = glob(i.f.p.gla_dec_b);
  o.f.p.gla_out_norm = glob(i.f.p.gla_out_norm);
  o.f.p.att_q_norm = glob(i.f.p.att_q_norm);
  o.f.p.att_k_norm = glob(i.f.p.att_k_norm);
  o.f.p.att_sink = glob(i.f.p.att_sink);
  o.f.p.odd_w_in = glob(i.f.p.odd_w_in);
  o.f.p.odd_w_out = glob(i.f.p.odd_w_out);
  o.f.p.rwkv_mu = glob(i.f.p.rwkv_mu);
  o.f.p.rwkv_w0 = glob(i.f.p.rwkv_w0);
  o.f.p.rwkv_w2 = glob(i.f.p.rwkv_w2);
  o.f.p.rwkv_a0 = glob(i.f.p.rwkv_a0);
  o.f.p.rwkv_a2 = glob(i.f.p.rwkv_a2);
  o.f.p.rwkv_g2 = glob(i.f.p.rwkv_g2);
  o.f.p.rwkv_kk_scale = glob(i.f.p.rwkv_kk_scale);
  o.f.p.rwkv_k_a = glob(i.f.p.rwkv_k_a);
  o.f.p.rwkv_r_k = glob(i.f.p.rwkv_r_k);
  o.f.p.rwkv_ln_g = glob(i.f.p.rwkv_ln_g);
  o.f.p.rwkv_ln_b = glob(i.f.p.rwkv_ln_b);
  o.f.p.router_w = glob(i.f.p.router_w);
  o.f.p.router_b = glob(i.f.p.router_b);
  o.f.p.moe_w_gate = glob(i.f.p.moe_w_gate);
  o.f.p.moe_w_up = glob(i.f.p.moe_w_up);
  o.f.p.moe_w_down = glob(i.f.p.moe_w_down);
  o.f.p.out = glob(i.f.p.out);
  o.f.p.xc = glob(i.f.p.xc);
  o.f.p.mod = glob(i.f.p.mod);
  o.f.p.rinv = glob(i.f.p.rinv);
  o.f.p.hbuf = glob(i.f.p.hbuf);
  o.f.p.zb = glob(i.f.p.zb);
  o.f.p.lad = glob(i.f.p.lad);
  o.f.p.ogla = glob(i.f.p.ogla);
  o.f.p.kkb = glob(i.f.p.kkb);
  o.f.p.rsb = glob(i.f.p.rsb);
  o.f.p.vsb = glob(i.f.p.vsb);
  o.f.p.decb = glob(i.f.p.decb);
  o.f.p.ab = glob(i.f.p.ab);
  o.f.p.kdb = glob(i.f.p.kdb);
  o.f.p.yb = glob(i.f.p.yb);
  o.f.p.fa = glob(i.f.p.fa);
  o.f.p.fb = glob(i.f.p.fb);
  o.f.p.cosT = glob(i.f.p.cosT);
  o.f.p.sinT = glob(i.f.p.sinT);
  o.f.p.re = glob(i.f.p.re);
  o.f.p.rw = glob(i.f.p.rw);
  o.f.p.act = glob(i.f.p.act);
  o.f.hb = glob(i.f.hb);
  o.f.wt_in = glob(i.f.wt_in);
  o.f.wt_out = glob(i.f.wt_out);
  o.f.moe_gu = glob(i.f.moe_gu);
  o.f.moe_d = glob(i.f.moe_d);
  o.f.cnt = glob(i.f.cnt);
  o.f.list = glob(i.f.list);
  o.f.tok_e = glob(i.f.tok_e);
  o.f.tok_pos = glob(i.f.tok_pos);
  o.f.tok_w = glob(i.f.tok_w);
  o.f.act = glob(i.f.act);
  o.f.ymoe = glob(i.f.ymoe);
  o.f.zf = glob(i.f.zf);
  o.f.vT = glob(i.f.vT);
  o.f.gla_b = glob(i.f.gla_b);
  o.f.gla_s = glob(i.f.gla_s);
  o.f.gla_dec = glob(i.f.gla_dec);
  o.r.z = glob(i.r.z);
  o.r.w2T = glob(i.r.w2T);
  o.r.a2T = glob(i.r.a2T);
  o.r.g2T = glob(i.r.g2T);
  o.r.M = glob(i.r.M);
  o.r.N = glob(i.r.N);
  o.r.R2 = glob(i.r.R2);
  o.r.Y0 = glob(i.r.Y0);
  o.r.sg = glob(i.r.sg);
  o.r.mu = glob(i.r.mu);
  o.r.w0 = glob(i.r.w0);
  o.r.a0 = glob(i.r.a0);
  o.r.kk_scale = glob(i.r.kk_scale);
  o.r.k_a = glob(i.r.k_a);
  o.r.r_k = glob(i.r.r_k);
  o.r.ln_g = glob(i.r.ln_g);
  o.r.ln_b = glob(i.r.ln_b);
  o.w.z = glob(i.w.z);
  o.w.Gp = glob(i.w.Gp);
  o.w.T64t = glob(i.w.T64t);
  o.w.DFT2 = glob(i.w.DFT2);
  o.w.DFT3 = glob(i.w.DFT3);
  o.wt_in0 = glob(i.wt_in0);
  o.wt_in1 = glob(i.wt_in1);
  o.wt_out0 = glob(i.wt_out0);
  o.wt_out1 = glob(i.wt_out1);
  o.moe_d1 = glob(i.moe_d1);
  o.w2T = glob(i.w2T);
  o.a2T = glob(i.a2T);
  o.g2T = glob(i.g2T);
  o.T64t = glob(i.T64t);
  o.DFT2 = glob(i.DFT2);
  o.DFT3 = glob(i.DFT3);
  o.bar = glob(i.bar);
}
#ifndef PH_MASK
#define PH_MASK 0xffffffffu
#endif
#ifndef USE_XCD_BARRIER
#define USE_XCD_BARRIER 1
#endif
constexpr int N_PHASES = 23;
constexpr int MEGA_LDS = 147456;
__global__ void __launch_bounds__(NT) mega_k(MK karg) {
  extern __shared__ __attribute__((aligned(16))) char lds[];
  cg::grid_group grid = cg::this_grid();
  const AS4 MK* kp0 = (const AS4 MK*)__builtin_amdgcn_kernarg_segment_ptr();
  const int ph_lo = kp0->ph_lo, ph_hi = kp0->ph_hi;
#if USE_XCD_BARRIER
  if (TIDX == 0) { volatile LAS unsigned* xbst = (volatile LAS unsigned*)(lds + MEGA_LDS - 16); xbst[0] = 0u; xbst[1] = 0u; }
  __syncthreads();
  (void)xcd_barrier_post(glob((unsigned*)kp0->bar), (volatile LAS unsigned*)(lds + MEGA_LDS - 16));
#define GRID_SYNC_ID(id) do { { XcdBarrier xb_; xb_.bar = glob((unsigned*)kp0->bar); xb_.x = xb_xcc_id(); xb_.st = (volatile LAS unsigned*)(lds + MEGA_LDS - 16); xcd_barrier(xb_); } } while (0)
#else
#define GRID_SYNC_ID(id) grid.sync()
#endif
#define KARGS() __builtin_amdgcn_s_waitcnt(0x0F70); const AS4 MK* kp = kp0; asm volatile("" : "+s"(kp)); MK k; globalize(k, *kp); const FP& f = k.f; (void)f;
#define PHCODE(id) ((id) > 14 ? (id) - 3 : (id))
#ifndef REP_MASK
#define REP_MASK 0u
#endif
#ifndef SYNC_REP
#define SYNC_REP 1
#endif
#ifndef POISON_ID
#define POISON_ID -1
#endif
#ifndef POISON_VAL
#define POISON_VAL 0x7fc07fc0u
#endif
#define POISON_HOOK(id) if ((id) == POISON_ID) { unsigned* l32 = (unsigned*)lds; for (int i = TIDX; i < 131072 / 4; i += NT) l32[i] = POISON_VAL; __syncthreads(); }
#define PHASE(id, ...) POISON_HOOK(id) if (((PH_MASK >> PHCODE(id)) & 1u) && ph_lo <= (id) && (id) < ph_hi) { for (int rep_ = 0; rep_ <= (int)((REP_MASK >> (id)) & 1u); ++rep_) { KARGS() __VA_ARGS__; if (rep_ < (int)((REP_MASK >> (id)) & 1u)) GRID_SYNC_ID(1); } } if (ph_lo <= (id) && (id) + 1 < ph_hi && (id) + 1 < N_PHASES) { for (int sr_ = 0; sr_ < SYNC_REP; ++sr_) GRID_SYNC_ID(id); }
  PHASE(0, { ph_mod(f, lds); ph_prep_all0(k, lds); })
  PHASE(1, { ph_norm_h0(f); })
#define G8LDS ((G8_LAS unsigned char*)lds)
#define G8DENSE(A_, B_, nM_, nN_, skip_) g8::SchedDense{(const char*)(A_), (const char*)(B_), FD, nM_, nN_, (int)gridDim.x, (int)blockIdx.x, skip_}
#ifdef MOE1_SHIFT
#define G8MOE(W_) g8::SchedMoE<W_>{&f, (int)gridDim.x, (W_) ? (int)((blockIdx.x + 37u) % gridDim.x) : (int)blockIdx.x, g8::moe_cache_counts(f, lds)}
#else
#define G8MOE(W_) g8::SchedMoE<W_>{&f, (int)gridDim.x, (int)blockIdx.x, g8::moe_cache_counts(f, lds)}
#endif
#if G8_P2

  PHASE(2, { g8::gemm_phase(G8LDS, FD, G8DENSE(f.hb, k.wt_in0, 68, 10, 0), g8::EpiIn0{&f}); tail_fill(680, FILL_Q2, 0, L0_STRIPS, [&](int t) { prep_l0_one(k, t, lds); }); })
#else
  PHASE(2, { ph_inproj0(f, k.wt_in0, 0, 68, lds); })
#endif
  PHASE(3, { ph_gla_a(f, 0, FB, lds); })
  PHASE(4, { if (!(RERUN_SKIP & 64) || ph_lo == 0) ph_gla_b(f, 0, FB, 64, 192); if (!(RERUN_SKIP & 128) || ph_lo == 0) ph_attn<bf16_t, G8_P2 != 0>(f, 0, FB, f.hb, FD, lds, false, 0, 0); })
  PHASE(5, { ph_gla_c2<bf16_t>(f, 0, FB, f.hb, FD, lds); { const int c2 = tail_cover(680, FILL_Q2, L0_STRIPS); for (int t = c2 + blockIdx.x; t < 64; t += gridDim.x) prep_l0_one(k, t, lds); }        })
#if G8_P6
  PHASE(6, { g8::gemm_phase(G8LDS, FD, G8DENSE(f.hb, k.wt_out0, 68, 4, 0), g8::EpiOutProj<0>{&f}); tail_fill(272, FILL_Q6, tail_cover(680, FILL_Q2, L0_STRIPS), L0_STRIPS, [&](int t) { prep_l0_one(k, t, lds); }); })
#else
  PHASE(6, { ph_outproj0(f, k.wt_out0, lds); })
#endif
  PHASE(7, { { const int c2 = tail_cover(680, FILL_Q2, L0_STRIPS); const int done = c2 + tail_cover(272, FILL_Q6, L0_STRIPS - c2); for (int t = done + blockIdx.x; t < L0_STRIPS; t += gridDim.x) prep_l0_one(k, t, lds); }        if (DRY_MASK & 2) { ph_ffn_router<true>(f, 0, lds); } ph_ffn_router(f, 0, lds); })
#if G8_MOE_L0
  PHASE(8, { g8::gemm_phase(G8LDS, FD, G8MOE(0), g8::EpiGU{&f}); { const int U = moe_units(f); tail_fill(U, FILL_Q8, 0, 768, [&](int t) { prep_l1_ac(k, t, lds); }); } })
#else
  PHASE(8, { ph_moe_gemm<0>(f, lds); })
#endif
#ifdef EXTRA_SYNC8
  GRID_SYNC_ID(1); GRID_SYNC_ID(1);
#endif
#ifdef SYNC_ONLY9
  __syncthreads();
#endif
#ifdef POISON_LDS9
  { unsigned* l32 = (unsigned*)lds; for (int i = TIDX; i < 131072 / 4; i += NT) l32[i] = POISON_LDS9; __syncthreads(); }
#endif
#ifdef COPY_ACT
  { KARGS() u32x4* src = (u32x4*)f.act; u32x4* dst = (u32x4*)((char*)f.act + (size_t)40 * 1024 * 1024); const long n16 = (long)2 * FT * 512 * 2 / 16; for (long i = blockIdx.x * (long)NT + TIDX; i < n16; i += (long)gridDim.x * NT) dst[i] = src[i]; } GRID_SYNC_ID(1);
  { KARGS() u32x4* dst = (u32x4*)f.act; u32x4* src = (u32x4*)((char*)f.act + (size_t)40 * 1024 * 1024); const long n16 = (long)2 * FT * 512 * 2 / 16; for (long i = blockIdx.x * (long)NT + TIDX; i < n16; i += (long)gridDim.x * NT) dst[i] = src[i]; } GRID_SYNC_ID(1);
#endif
#ifdef EXTRA_OLD9
  { KARGS() ph_moe_gemm<1>(f, lds); } GRID_SYNC_ID(1);
#endif
#if G8_MOE_L0 && G8_MOED
  PHASE(9, { g8::gemm_phase(G8LDS, 512, G8MOE(1), g8::EpiDown{&f}); { const int U = moe_units(f); tail_fill(U, FILL_Q9, 0, 1024, [&](int t) { prep_l1_b(k, t, lds); }); } })
#else
  PHASE(9, { ph_moe_gemm<1>(f, lds); })
#endif
#ifdef OLD9_AFTER
#ifdef REDO8
  { KARGS() g8::gemm_phase(G8LDS, FD, G8MOE(0), g8::EpiGU{&f}); } GRID_SYNC_ID(1);
#endif
  { KARGS() ph_moe_gemm<1>(f, lds); } GRID_SYNC_ID(1);
#endif
  PHASE(10, { if (DRY_MASK & 4) { ph_combine<false, true>(f, 0); } ph_combine2<false>(f, 0, lds); { const int U = moe_units(f); const int ca = tail_cover(U, FILL_Q8, 768), cb = tail_cover(U, FILL_Q9, 1024); const int na = 768 - ca, nb = 1024 - cb;        for (int t = blockIdx.x; t < na + nb; t += gridDim.x) { if (t < na) prep_l1_ac(k, ca + t, lds); else prep_l1_b(k, cb + t - na, lds); } } })
#if G8_P11
  PHASE(11, { g8::gemm_phase(G8LDS, FD, G8DENSE(f.hb, k.wt_in1, 68, 12, 0), g8::EpiPlain{f.zf, Z1_LD, Z1_N}); if (blockIdx.x == 0 && TIDX < 64) f.cnt[TIDX] = 0; })
#else
  PHASE(11, { ph_inproj1(f, k.wt_in1, 0, 68, lds); if (blockIdx.x == 0 && TIDX < 64) f.cnt[TIDX] = 0; })
#endif
#define RWKV_HALF(half) \
  PHASE(12 + 3 * (half), { ph_rwkv1(k.r, 2 * (half), 2 * (half) + 2, lds, ph_lo > 0 ? R1_SKIP : 0); }) \
  PHASE(13 + 3 * (half), { if (DRY_MASK & 16) { ph_rwkv2<true>(k.r, 2 * (half), 2 * (half) + 2); } if (DRY_MASK & 32) { ph_fourier1(k.w, 2 * (half), 2 * (half) + 2, lds, true); } if (!(RERUN_SKIP & 1) || ph_lo == 0) ph_rwkv2(k.r, 2 * (half), 2 * (half) + 2); ph_rwkv_sg(k.r, 2 * (half), 2 * (half) + 2); if (!(RERUN_SKIP & 2) || ph_lo == 0) ph_fourier1(k.w, 2 * (half), 2 * (half) + 2, lds, true); }) \
  PHASE(14 + 3 * (half), { if (!(RERUN_SKIP & 16) || ph_lo == 0) ph_rwkv3<bf16_t>(k.r, 2 * (half), 2 * (half) + 2, f.hb, FD, lds, ph_lo > 0 ? R3_XMODE : 0); if (!(RERUN_SKIP & 32) || ph_lo == 0) ph_fourier2<bf16_t>(k.w, 2 * (half), 2 * (half) + 2, f.hb, FD, lds, true); })
  RWKV_HALF(0)
  RWKV_HALF(1)
#if G8_P18
  PHASE(18, { g8::gemm_phase(G8LDS, FD, G8DENSE(f.hb, k.wt_out1, 64, 4, 17), g8::EpiOutProj<1>{&f}); })
#else
  PHASE(18, { ph_outproj(f, k.wt_out1, 1, lds); })
#endif
  PHASE(19, { ph_ffn_router(f, 1, lds); })
#if G8_MOE_L1
  PHASE(20, { g8::gemm_phase(G8LDS, FD, G8MOE(0), g8::EpiGU{&f}); })
#else
  PHASE(20, { ph_moe_gemm<0>(f, lds); })
#endif
#if G8_MOE_L1 && G8_MOED
  PHASE(21, { k.f.moe_d = k.moe_d1; g8::gemm_phase(G8LDS, 512, G8MOE(1), g8::EpiDown{&f}); })
#else
  PHASE(21, { ph_moe_gemm<1>(f, lds); })
#endif
  PHASE(22, { if (DRY_MASK & 64) { ph_combine<true, true>(f, 1); } ph_combine2<true>(f, 1, lds); })
}
static_assert(g8::STAGE_BYTES <= MEGA_LDS - 16 && R1_LDS <= MEGA_LDS && GemmCfg<4, 2>::LDS_BYTES <= MEGA_LDS && F2_LDS <= MEGA_LDS && F1_LDS <= MEGA_LDS && 5 * FD * 4 + 8 * 5 * 64 * 4 <= MEGA_LDS, "LDS budget");

static size_t mega_carve(MK& k, char* base) {
  size_t off = 0; auto take = [&](size_t bytes) { char* r = base ? base + off : nullptr; off += (bytes + 255) & ~(size_t)255; return r; };
  FP& f = k.f;
  k.wt_in0 = (bf16_t*)take((size_t)W0_ROWS * FD * 2); k.wt_in1 = (bf16_t*)take((size_t)W1_ROWS * FD * 2); k.wt_out0 = (bf16_t*)take((size_t)FD * FD * 2); k.wt_out1 = (bf16_t*)take((size_t)FD * FD * 2);
  k.w2T = (bf16_t*)take((size_t)2 * 768 * 64 * 2); k.a2T = (bf16_t*)take((size_t)2 * 768 * 64 * 2); k.g2T = (bf16_t*)take((size_t)768 * 128 * 2);
  k.T64t = (bf16_t*)take(16384); k.DFT2 = (bf16_t*)take(32768); k.DFT3 = (bf16_t*)take(16384);
  f.moe_gu = (bf16_t*)take((size_t)16 * FD * FD * 2); f.moe_d = (bf16_t*)take((size_t)16 * FD * 512 * 2); k.moe_d1 = (bf16_t*)take((size_t)16 * FD * 512 * 2);
  f.p.xc = (float*)take((size_t)FB * FLC * FD * 4); f.p.mod = (float*)take((size_t)2 * 5 * 6 * FD * 4);
  k.bar = (unsigned*)take((size_t)XCD_BAR_WORDS * 4); f.cnt = (int*)take(256); f.list = (int*)take((size_t)16 * FT * 4); f.tok_e = (int*)take((size_t)FT * 8); f.tok_pos = (int*)take((size_t)FT * 8); f.tok_w = (float*)take((size_t)FT * 8);
  f.hb = (bf16_t*)take((size_t)FT * FD * 2);
  char* zreg = take((size_t)FT * Z1_LD * 2); f.zf = (bf16_t*)zreg; f.ymoe = (bf16_t*)zreg;
  const size_t mark = off;
  f.vT = (bf16_t*)take((size_t)FB * 2 * 64 * FS * 2); f.gla_b = (float*)take((size_t)FT * 512 * 4); f.gla_s = (float*)take((size_t)FB * 8 * 2 * 68 * 2048 * 4); f.gla_dec = (float*)take((size_t)FB * 8 * 2 * 68 * 32 * 4);
  const size_t e0 = off; off = mark;
  f.act = (bf16_t*)take((size_t)2 * FT * 512 * 2);
  const size_t e1 = off; off = mark;
  const size_t per = (size_t)2 * 12 * 2 * 68 * 4096 * 2;
  k.r.M = (bf16_t*)take(per); k.r.N = (bf16_t*)take(per); k.r.R2 = (bf16_t*)take(per); k.r.Y0 = (bf16_t*)take(per); k.w.Gp = (bf16_t*)take((size_t)2 * 64 * 2 * 64 * 256 * 2); k.r.sg = (bf16_t*)take((size_t)2 * 4096 * 128 * 2);
  const size_t e2 = off; off = e0 > e1 ? e0 : e1; off = off > e2 ? off : e2;
  return off;
}
extern "C" void kernel_launch(void* const* d_in, const int* in_sizes, int n_in, void* d_out, int out_size, void* d_ws, size_t ws_size, hipStream_t stream) {
  static MK k; static int grid_blocks = 0;
  memset(&k, 0, sizeof(k));
  if (n_in != 34 || out_size != FB * FL * FD) { fprintf(stderr, "kernel_launch: unexpected n_in %d / out_size %d\n", n_in, out_size); return; }
  NP& p = k.f.p; np_set_dims(p, FB, FL, FLC, FD); np_set_inputs(p, d_in); p.out = (float*)d_out;
  const size_t need = mega_carve(k, nullptr);
  if (need > ws_size) { fprintf(stderr, "kernel_launch: ws too small: need %zu have %zu\n", need, ws_size); return; }
  mega_carve(k, (char*)d_ws);
  RW& r = k.r; r.z = k.f.zf; r.w2T = k.w2T; r.a2T = k.a2T; r.g2T = k.g2T; r.mu = p.rwkv_mu; r.w0 = p.rwkv_w0; r.a0 = p.rwkv_a0; r.kk_scale = p.rwkv_kk_scale; r.k_a = p.rwkv_k_a; r.r_k = p.rwkv_r_k; r.ln_g = p.rwkv_ln_g; r.ln_b = p.rwkv_ln_b;
  k.w.z = k.f.zf; k.w.T64t = k.T64t; k.w.DFT2 = k.DFT2; k.w.DFT3 = k.DFT3;
  k.ph_lo = 0; k.ph_hi = N_PHASES;
  if (!grid_blocks) {
    int dev = 0, cus = 0, per_cu = 0; hipGetDevice(&dev); hipDeviceGetAttribute(&cus, hipDeviceAttributeMultiprocessorCount, dev);
    hipFuncSetAttribute((const void*)mega_k, hipFuncAttributeMaxDynamicSharedMemorySize, MEGA_LDS);
    hipOccupancyMaxActiveBlocksPerMultiprocessor(&per_cu, mega_k, NT, MEGA_LDS);
    if (per_cu < 1) fprintf(stderr, "kernel_launch: occupancy query says %d blocks/CU\n", per_cu);
    grid_blocks = cus;
    fprintf(stderr, "kernel_launch: cus %d per_cu %d grid %d ws need %zu MB of %zu MB\n", cus, per_cu, grid_blocks, need >> 20, ws_size >> 20);
  }
  hipMemsetAsync(k.bar, 0, (size_t)XCD_BAR_WORDS * 4, stream);
#if MEGA_MULTI_LAUNCH
  for (int ph = 0; ph < N_PHASES; ++ph) { k.ph_lo = ph; k.ph_hi = ph + 1; void* args[] = {&k}; hipLaunchCooperativeKernel((void*)mega_k, dim3(grid_blocks), dim3(NT), args, MEGA_LDS, stream); }
#else
  void* args[] = {&k};
  hipError_t e = hipLaunchCooperativeKernel((void*)mega_k, dim3(grid_blocks), dim3(NT), args, MEGA_LDS, stream);
#ifdef RERUN_LO
  { static MK k2; k2 = k; k2.ph_lo = RERUN_LO; k2.ph_hi = RERUN_HI; void* args2[] = {&k2}; hipMemsetAsync(k.bar, 0, (size_t)XCD_BAR_WORDS * 4, stream);
    hipLaunchCooperativeKernel((void*)mega_k, dim3(grid_blocks), dim3(NT), args2, MEGA_LDS, stream);
#ifdef RERUN_TWICE
    hipMemsetAsync(k.bar, 0, (size_t)XCD_BAR_WORDS * 4, stream);
    hipLaunchCooperativeKernel((void*)mega_k, dim3(grid_blocks), dim3(NT), args2, MEGA_LDS, stream);
#endif
  }
#endif
  if (e != hipSuccess) fprintf(stderr, "cooperative launch failed: %s (grid %d)\n", hipGetErrorString(e), grid_blocks);
#endif
}
```
